# Optimizing an MI355X kernel written in HIP

```python
import math
import jax
import jax.numpy as jnp
from jax import lax
import numpy as np

D_MODEL = 1024
BATCH = 2
SEQ = 16384
DEPTH = 4

CHUNK = 64
N_MIXERS = 2
N_ATTN_LAYERS = (DEPTH + 1) // 2
N_HGRN_LAYERS = DEPTH // 2

A_HEADS = 8
A_HEAD_DIM = D_MODEL // (2 * A_HEADS)
A_QK_WIDTH = A_HEADS * 2 * A_HEAD_DIM
A_V_WIDTH = A_HEADS * 2 * A_HEAD_DIM
Q_BLOCK = 128
ROT_DIM = A_HEAD_DIM // 4
ROPE_THETA = 500000.0

H_EXPAND = 128
H_HEADS = D_MODEL // H_EXPAND
H_WIDTH = H_HEADS * H_EXPAND
H_VDIM = H_WIDTH // H_HEADS

N_EXPERTS = 64
N_GROUPS = 8
TOPK_GROUP = 4
TOP_K = 8
EXPERT_FF = D_MODEL // 4
ROUTED_SCALE = 2.5
MOE_BLOCK = 256

ALPHA = (2 * DEPTH) ** 0.25
BETA = (8 * DEPTH) ** -0.25
LN_EPS = 1e-5

kernel_name = "hybrid_diffattn_hgrn2_moe_deepnorm"


def layer_norm(x, g, b):
    xf = x.astype(jnp.float32)
    mu = jnp.mean(xf, axis=-1, keepdims=True)
    var = jnp.mean(jnp.square(xf - mu), axis=-1, keepdims=True)
    y = (xf - mu) * lax.rsqrt(var + LN_EPS) * g.astype(jnp.float32) + b.astype(jnp.float32)
    return y.astype(x.dtype)


def rms_norm(x, g):
    xf = x.astype(jnp.float32)
    y = xf * lax.rsqrt(jnp.mean(jnp.square(xf), axis=-1, keepdims=True) + LN_EPS)
    return y * g.astype(jnp.float32)


def rotary_tables(seq):
    pos = jnp.arange(seq, dtype=jnp.float32)
    inv_freq = ROPE_THETA ** (-jnp.arange(0, ROT_DIM, 2, dtype=jnp.float32) / ROT_DIM)
    ang = pos[:, None] * inv_freq[None, :]
    return jnp.cos(ang), jnp.sin(ang)


def partial_rotary(x, cos, sin):
    half = ROT_DIM // 2
    c = cos[None, :, None, :].astype(x.dtype)
    s = sin[None, :, None, :].astype(x.dtype)
    x1, x2, rest = x[..., :half], x[..., half:ROT_DIM], x[..., ROT_DIM:]
    return jnp.concatenate([x1 * c - x2 * s, x2 * c + x1 * s, rest], axis=-1)


def diff_attention(x, w_in, w_out, lam_params, subln_g, lambda_init, cos, sin):
    B, S, _ = x.shape
    nqb = S // Q_BLOCK
    q, k, v = jnp.split(x @ w_in, [A_QK_WIDTH, 2 * A_QK_WIDTH], axis=-1)
    q = partial_rotary(q.reshape(B, S, A_HEADS * 2, A_HEAD_DIM), cos, sin)
    k = partial_rotary(k.reshape(B, S, A_HEADS * 2, A_HEAD_DIM), cos, sin)
    q = q.reshape(B, nqb, Q_BLOCK, A_HEADS, 2, A_HEAD_DIM).transpose(1, 4, 0, 3, 2, 5)
    k = k.reshape(B, S, A_HEADS, 2, A_HEAD_DIM).transpose(3, 0, 2, 1, 4)
    v = v.reshape(B, S, A_HEADS, 2 * A_HEAD_DIM).transpose(0, 2, 1, 3)
    lp = lam_params.astype(jnp.float32)
    lam = jnp.exp(jnp.sum(lp[0] * lp[1])) - jnp.exp(jnp.sum(lp[2] * lp[3])) + lambda_init
    scale = A_HEAD_DIM ** -0.5
    key_chunk = jnp.arange(S) // CHUNK

    def attend(args):
        qb, bi = args
        q_chunk = (bi * Q_BLOCK + jnp.arange(Q_BLOCK)) // CHUNK
        mask = key_chunk[None, :] <= q_chunk[:, None]
        s = jnp.einsum("mbhqd,mbhkd->mbhqk", qb, k).astype(jnp.float32) * scale
        p = jax.nn.softmax(jnp.where(mask, s, -jnp.inf), axis=-1)
        a = (p[0] - lam * p[1]).astype(v.dtype)
        return jnp.einsum("bhqk,bhkd->bhqd", a, v)

    o = lax.map(attend, (q, jnp.arange(nqb)))
    o = o.transpose(1, 0, 3, 2, 4).reshape(B, S, A_HEADS, 2 * A_HEAD_DIM)
    o = rms_norm(o, subln_g) * (1.0 - lambda_init)
    return o.astype(x.dtype).reshape(B, S, A_V_WIDTH) @ w_out


def hgrn2(x, w_in, w_out, lower_bound, norm_g):
    B, S, _ = x.shape
    nc = S // CHUNK
    q, f, i, g = jnp.split(x @ w_in, 4, axis=-1)
    forget = lower_bound + (1.0 - lower_bound) * jax.nn.sigmoid(f.astype(jnp.float32))
    log_f = jnp.log(forget)
    k_in = 1.0 - forget
    q = jax.nn.silu(q)

    def to_chunks(t):
        d = t.shape[-1] // H_HEADS
        return t.astype(jnp.float32).reshape(B, nc, CHUNK, H_HEADS, d).transpose(1, 0, 3, 2, 4)

    causal = jnp.tril(jnp.ones((CHUNK, CHUNK), dtype=bool))[:, :, None]

    def step(state, xs):
        qc, kc, vc, gc = xs
        b = jnp.cumsum(gc, axis=2)
        diff = b[:, :, :, None, :] - b[:, :, None, :, :]
        decay = jnp.exp(jnp.where(causal, diff, -jnp.inf))
        scores = jnp.einsum("bhtd,bhtsd,bhsd->bhts", qc, decay, kc)
        b_last = b[:, :, -1:, :]
        o = jnp.einsum("bhts,bhse->bhte", scores, vc) + jnp.einsum("bhtd,bhde->bhte", qc * jnp.exp(b), state)
        state = jnp.exp(b_last[:, :, 0, :, None]) * state + jnp.einsum("bhsd,bhse->bhde", kc * jnp.exp(b_last - b), vc)
        return state, o

    state0 = jnp.zeros((B, H_HEADS, H_EXPAND, H_VDIM), jnp.float32)
    _, o = lax.scan(step, state0, (to_chunks(q), to_chunks(k_in), to_chunks(i), to_chunks(log_f)))
    o = o.transpose(1, 0, 3, 2, 4).reshape(B, S, H_HEADS, H_VDIM)
    o = rms_norm(o, norm_g).reshape(B, S, H_WIDTH) * jax.nn.silu(g.astype(jnp.float32))
    return o.astype(x.dtype) @ w_out


def swiglu(x, w_gate_up, w_down):
    gate, up = jnp.split(x @ w_gate_up, 2, axis=-1)
    return (jax.nn.silu(gate) * up) @ w_down


def route(xf, w_router, bias):
    T = xf.shape[0]
    scores = jax.nn.sigmoid(xf.astype(jnp.float32) @ w_router.astype(jnp.float32))
    choice = (scores + bias.astype(jnp.float32)).reshape(T, N_GROUPS, N_EXPERTS // N_GROUPS)
    group_score = jnp.sum(lax.top_k(choice, 2)[0], axis=-1)
    _, top_groups = lax.top_k(group_score, TOPK_GROUP)
    group_mask = jnp.any(jax.nn.one_hot(top_groups, N_GROUPS, dtype=jnp.bool_), axis=1)
    choice = jnp.where(group_mask[:, :, None], choice, -jnp.inf).reshape(T, N_EXPERTS)
    _, idx = lax.top_k(choice, TOP_K)
    w = jnp.take_along_axis(scores, idx, axis=-1)
    w = w / (jnp.sum(w, axis=-1, keepdims=True) + 1e-20) * ROUTED_SCALE
    return idx, w


def routed_experts(xf, idx, w, w_gate_up, w_down):
    T, D = xf.shape
    n_assign = T * TOP_K
    n_blocks = -(-n_assign // MOE_BLOCK) + N_EXPERTS
    flat_e = idx.reshape(-1)
    order = jnp.argsort(flat_e)
    sorted_e = flat_e[order]
    counts = jnp.zeros((N_EXPERTS,), jnp.int32).at[flat_e].add(1)
    padded = (counts + MOE_BLOCK - 1) // MOE_BLOCK * MOE_BLOCK
    pad_end = jnp.cumsum(padded)
    pad_start = pad_end - padded
    start = jnp.cumsum(counts) - counts
    dest = pad_start[sorted_e] + jnp.arange(n_assign, dtype=jnp.int32) - start[sorted_e]
    rows = jnp.full((n_blocks * MOE_BLOCK,), T, jnp.int32).at[dest].set((order // TOP_K).astype(jnp.int32))
    gates = jnp.zeros((n_blocks * MOE_BLOCK,), xf.dtype).at[dest].set(w.reshape(-1)[order].astype(xf.dtype))
    block_expert = jnp.minimum(jnp.searchsorted(pad_end // MOE_BLOCK, jnp.arange(n_blocks), side="right"), N_EXPERTS - 1)
    x_pad = jnp.concatenate([xf, jnp.zeros((1, D), xf.dtype)], axis=0)

    def block(acc, xs):
        r, gt, e = xs
        y = swiglu(x_pad[r], w_gate_up[e], w_down[e])
        return acc.at[r].add(gt[:, None] * y), None

    acc, _ = lax.scan(block, jnp.zeros((T + 1, D), xf.dtype),
                      (rows.reshape(n_blocks, MOE_BLOCK), gates.reshape(n_blocks, MOE_BLOCK), block_expert))
    return acc[:T]


def moe(x, w_router, bias, w_gate_up, w_down, ws_gate_up, ws_down):
    B, S, D = x.shape
    xf = x.reshape(B * S, D)
    idx, w = route(xf, w_router, bias)
    y = routed_experts(xf, idx, w, w_gate_up, w_down) + swiglu(xf, ws_gate_up, ws_down)
    return y.reshape(B, S, D)


def setup_inputs(seed: int = 0) -> dict:
    key = jax.random.key(seed)
    ks = jax.random.split(key, 24)

    def nrm(k, shape, scale):
        return jax.random.normal(k, shape, jnp.float32) * scale

    x = nrm(ks[0], (BATCH, SEQ, D_MODEL), 1.0)
    attn_w_in = jnp.concatenate([
        nrm(ks[1], (N_ATTN_LAYERS, D_MODEL, 2 * A_QK_WIDTH), D_MODEL ** -0.5),
        nrm(ks[2], (N_ATTN_LAYERS, D_MODEL, A_V_WIDTH), BETA * D_MODEL ** -0.5)], axis=-1)
    attn_w_out = nrm(ks[3], (N_ATTN_LAYERS, A_V_WIDTH, D_MODEL), BETA * A_V_WIDTH ** -0.5)
    attn_lambda = nrm(ks[4], (N_ATTN_LAYERS, 4, A_HEAD_DIM), 0.1)
    attn_subln = 1.0 + nrm(ks[5], (N_ATTN_LAYERS, 2 * A_HEAD_DIM), 0.02)
    hgrn_w_in = jnp.concatenate([
        nrm(ks[6], (N_HGRN_LAYERS, D_MODEL, 2 * H_WIDTH), D_MODEL ** -0.5),
        nrm(ks[7], (N_HGRN_LAYERS, D_MODEL, H_WIDTH), BETA * D_MODEL ** -0.5),
        nrm(ks[8], (N_HGRN_LAYERS, D_MODEL, H_WIDTH), D_MODEL ** -0.5)], axis=-1)
    hgrn_w_out = nrm(ks[9], (N_HGRN_LAYERS, H_WIDTH, D_MODEL), BETA * H_WIDTH ** -0.5)
    hgrn_lower_bounds = nrm(ks[10], (DEPTH, H_WIDTH), 0.1)
    hgrn_norm = 1.0 + nrm(ks[11], (N_HGRN_LAYERS, H_VDIM), 0.02)
    moe_router = nrm(ks[12], (DEPTH, D_MODEL, N_EXPERTS), D_MODEL ** -0.5)
    moe_router_bias = nrm(ks[13], (DEPTH, N_EXPERTS), 0.01)
    moe_w_gate_up = nrm(ks[14], (DEPTH, N_EXPERTS, D_MODEL, 2 * EXPERT_FF), D_MODEL ** -0.5)
    moe_w_down = nrm(ks[15], (DEPTH, N_EXPERTS, EXPERT_FF, D_MODEL), BETA * EXPERT_FF ** -0.5)
    shared_w_gate_up = nrm(ks[16], (DEPTH, D_MODEL, 2 * EXPERT_FF), D_MODEL ** -0.5)
    shared_w_down = nrm(ks[17], (DEPTH, EXPERT_FF, D_MODEL), BETA * EXPERT_FF ** -0.5)
    ln_gain = 1.0 + nrm(ks[18], (DEPTH, 2, D_MODEL), 0.02)
    ln_bias = nrm(ks[19], (DEPTH, 2, D_MODEL), 0.02)
    return {"x": x, "attn_w_in": attn_w_in, "attn_w_out": attn_w_out, "attn_lambda": attn_lambda,
            "attn_subln": attn_subln, "hgrn_w_in": hgrn_w_in, "hgrn_w_out": hgrn_w_out,
            "hgrn_lower_bounds": hgrn_lower_bounds, "hgrn_norm": hgrn_norm, "moe_router": moe_router,
            "moe_router_bias": moe_router_bias, "moe_w_gate_up": moe_w_gate_up, "moe_w_down": moe_w_down,
            "shared_w_gate_up": shared_w_gate_up, "shared_w_down": shared_w_down,
            "ln_gain": ln_gain, "ln_bias": ln_bias}


def reference(x, attn_w_in, attn_w_out, attn_lambda, attn_subln, hgrn_w_in, hgrn_w_out,
              hgrn_lower_bounds, hgrn_norm, moe_router, moe_router_bias, moe_w_gate_up, moe_w_down,
              shared_w_gate_up, shared_w_down, ln_gain, ln_bias):
    cos, sin = rotary_tables(x.shape[1])
    lb = jax.nn.softmax(hgrn_lower_bounds.astype(jnp.float32), axis=0)
    lb = jnp.cumsum(lb, axis=0) - lb[0]
    for layer in range(DEPTH):
        j = layer // N_MIXERS
        if layer % N_MIXERS == 0:
            lambda_init = 0.8 - 0.6 * math.exp(-0.3 * layer)
            h = diff_attention(x, attn_w_in[j], attn_w_out[j], attn_lambda[j], attn_subln[j], lambda_init, cos, sin)
        else:
            h = hgrn2(x, hgrn_w_in[j], hgrn_w_out[j], lb[layer], hgrn_norm[j])
        x = layer_norm(ALPHA * x + h, ln_gain[layer, 0], ln_bias[layer, 0])
        h = moe(x, moe_router[layer], moe_router_bias[layer], moe_w_gate_up[layer], moe_w_down[layer],
                shared_w_gate_up[layer], shared_w_down[layer])
        x = layer_norm(ALPHA * x + h, ln_gain[layer, 1], ln_bias[layer, 1])
    return x
```

```cpp
#include <hip/hip_runtime.h>
#include <stdint.h>
#include <stdio.h>
#include <math.h>

namespace cfg {
constexpr int D = 1024, NB = 2, SEQ = 16384, T = NB * SEQ, DEPTH = 4;
constexpr int NE = 64, TOPK = 8, EFF = 256;
constexpr int NPAD = T * TOPK + NE * 256;
constexpr float ALPHA = 1.6817928305074290f;
constexpr float LN_EPS = 1e-5f;
constexpr float ROUTED_SCALE = 2.5f;
constexpr float C2 = 0.125f * 1.4426950408889634f;
}
using namespace cfg;

namespace pg8 {
#define PG8_LAS __attribute__((address_space(3)))
typedef unsigned short bf16_t;
typedef short bf16x8 __attribute__((ext_vector_type(8)));
typedef float f32x4 __attribute__((ext_vector_type(4)));
typedef unsigned u32x4 __attribute__((ext_vector_type(4)));
constexpr int BM = 256, BK = 64, HALF = 128, HTB = HALF * BK * 2  , STAGE_BYTES = 8 * HTB, NXCD = 8, WGM = 8;

__host__ __device__ __forceinline__ int lds_byte(int r, int c) { const int st = (r >> 4) * 2 + (c >> 5), rr = r & 15, cc = c & 31, ob = rr * 64 + cc * 2; return st * 1024 + (ob ^ (((ob >> 9) & 1) << 5)); }
__host__ __device__ __forceinline__ void stage_rc(int b, int& R, int& C) { const int st = b / 1024, sb = b % 1024, swz = sb ^ (((sb >> 9) & 1) << 5); R = (st >> 1) * 16 + swz / 64; C = (st & 1) * 32 + (swz % 64) / 2; }
__host__ __device__ __forceinline__ int perm32(int rho) { const int n = rho >> 4, i = rho & 15; return 8 * (i >> 2) + 4 * n + (i & 3); }

struct Unit { int pm, pn, aux, e; };
struct Gemm { const bf16_t* A; const bf16_t* Bt; int M, N, K; };

struct StaticOrder {
    int nM, nN, nwg, G, c;
    __host__ __device__ void init(int M, int N, int G_, int c_) { nM = M / BM; nN = N / BM; nwg = nM * nN; G = G_; c = c_; }
    __host__ __device__ bool next(int i, Unit& u) const {
        const long L = (long)i * G + c; if (L >= nwg) return false;
        int wgid = (int)L; { const int q = nwg / NXCD, r = nwg % NXCD, xcd = wgid % NXCD, off = wgid / NXCD; wgid = (xcd < r ? xcd * (q + 1) : r * (q + 1) + (xcd - r) * q) + off; }
        const int nig = WGM * nN, gid = wgid / nig, fm = gid * WGM, gsz = (nM - fm) < WGM ? (nM - fm) : WGM;
        u.pm = fm + ((wgid % nig) % gsz); u.pn = (wgid % nig) / gsz; return true;
    }
    __device__ __forceinline__ void a_ready(const Unit&) const {}
    __device__ __forceinline__ void done(const Unit&) const {}
};


__device__ __forceinline__ unsigned cvt_pk_bf16(float lo, float hi) { unsigned r; asm volatile("v_cvt_pk_bf16_f32 %0, %1, %2" : "=v"(r) : "v"(lo), "v"(hi)); return r; }
__device__ __forceinline__ float sigm(float x) { return __builtin_amdgcn_rcpf(1.f + __expf(-x)); }

struct EpiQKV {
    static constexpr bool PERM = true, AFTER_DRAIN = false;
    bf16_t* QKV; const float* rot;
    __device__ __forceinline__ void operator()(const f32x4 (&acc)[2][2][4][2], const Unit& u, int wr, int wc, int fr, int fq) const {
        const int sec = u.pn >> 2;
        bf16_t* base = QKV + (size_t)sec * ((size_t)cfg::T * 1024);
        const float sc = sec == 0 ? cfg::C2 : 1.f;
        const bool rotl = (sec < 2) && ((wc & 1) == 0) && (fq < 2);
        const int col0 = (u.pn & 3) * 256 + wc * 32 + 8 * fq;
#pragma unroll
        for (int ai = 0; ai < 2; ++ai)
#pragma unroll
            for (int m = 0; m < 4; ++m) {
                const int row = u.pm * BM + ai * HALF + wr * 64 + m * 16 + fr;
                f32x4 t0 = (f32x4){1.f, 0.f, 1.f, 0.f}, t1 = (f32x4){1.f, 0.f, 1.f, 0.f};
                if (rotl) { const f32x4* rp = (const f32x4*)(rot + ((size_t)(row & (cfg::SEQ - 1)) * 8 + 4 * fq) * 2); t0 = rp[0]; t1 = rp[1]; }
#pragma unroll
                for (int bj = 0; bj < 2; ++bj) {
                    const f32x4 v0 = acc[ai][bj][m][0], v1 = acc[ai][bj][m][1];
                    f32x4 r0, r1;
                    r0[0] = v0[0] * t0[0] - v0[1] * t0[1]; r0[1] = v0[1] * t0[0] + v0[0] * t0[1];
                    r0[2] = v0[2] * t0[2] - v0[3] * t0[3]; r0[3] = v0[3] * t0[2] + v0[2] * t0[3];
                    r1[0] = v1[0] * t1[0] - v1[1] * t1[1]; r1[1] = v1[1] * t1[0] + v1[0] * t1[1];
                    r1[2] = v1[2] * t1[2] - v1[3] * t1[3]; r1[3] = v1[3] * t1[2] + v1[2] * t1[3];
                    r0 = r0 * sc; r1 = r1 * sc;
                    u32x4 w; w.x = cvt_pk_bf16(r0[0], r0[1]); w.y = cvt_pk_bf16(r0[2], r0[3]); w.z = cvt_pk_bf16(r1[0], r1[1]); w.w = cvt_pk_bf16(r1[2], r1[3]);
                    *(u32x4*)(base + (size_t)row * 1024 + col0 + bj * HALF) = w;
                }
                asm volatile("" ::: "memory");
            }
    }
};
struct EpiQK8 {
    static constexpr bool PERM = true, AFTER_DRAIN = false;
    unsigned char* QK; const float* rot;
    __device__ __forceinline__ void operator()(const f32x4 (&acc)[2][2][4][2], const Unit& u, int wr, int wc, int fr, int fq) const {
        const int sec = u.pn >> 2;
        unsigned char* base = QK + (size_t)sec * ((size_t)cfg::T * 1024);
        const float sc = sec == 0 ? cfg::C2 * 4.f : 0.25f;
        const bool rotl = ((wc & 1) == 0) && (fq < 2);
        const int col0 = (u.pn & 3) * 256 + wc * 32 + 8 * fq;
        typedef unsigned u32x2_ __attribute__((ext_vector_type(2)));
#pragma unroll
        for (int ai = 0; ai < 2; ++ai)
#pragma unroll
            for (int m = 0; m < 4; ++m) {
                const int row = u.pm * BM + ai * HALF + wr * 64 + m * 16 + fr;
                f32x4 t0 = (f32x4){1.f, 0.f, 1.f, 0.f}, t1 = (f32x4){1.f, 0.f, 1.f, 0.f};
                if (rotl) { const f32x4* rp = (const f32x4*)(rot + ((size_t)(row & (cfg::SEQ - 1)) * 8 + 4 * fq) * 2); t0 = rp[0]; t1 = rp[1]; }
#pragma unroll
                for (int bj = 0; bj < 2; ++bj) {
                    const f32x4 v0 = acc[ai][bj][m][0], v1 = acc[ai][bj][m][1];
                    f32x4 r0, r1;
                    r0[0] = v0[0] * t0[0] - v0[1] * t0[1]; r0[1] = v0[1] * t0[0] + v0[0] * t0[1];
                    r0[2] = v0[2] * t0[2] - v0[3] * t0[3]; r0[3] = v0[3] * t0[2] + v0[2] * t0[3];
                    r1[0] = v1[0] * t1[0] - v1[1] * t1[1]; r1[1] = v1[1] * t1[0] + v1[0] * t1[1];
                    r1[2] = v1[2] * t1[2] - v1[3] * t1[3]; r1[3] = v1[3] * t1[2] + v1[2] * t1[3];
                    r0 = r0 * sc; r1 = r1 * sc;
#pragma unroll
                    for (int i = 0; i < 4; ++i) { r0[i] = __builtin_amdgcn_fmed3f(r0[i], -448.f, 448.f); r1[i] = __builtin_amdgcn_fmed3f(r1[i], -448.f, 448.f); }
                    int w0 = 0, w1 = 0;
                    w0 = __builtin_amdgcn_cvt_pk_fp8_f32(r0[0], r0[1], w0, false); w0 = __builtin_amdgcn_cvt_pk_fp8_f32(r0[2], r0[3], w0, true);
                    w1 = __builtin_amdgcn_cvt_pk_fp8_f32(r1[0], r1[1], w1, false); w1 = __builtin_amdgcn_cvt_pk_fp8_f32(r1[2], r1[3], w1, true);
                    *(u32x2_*)(base + (size_t)row * 1024 + col0 + bj * HALF) = (u32x2_){(unsigned)w0, (unsigned)w1};
                }
                asm volatile("" ::: "memory");
            }
    }
};
struct EpiVT {
    static constexpr bool PERM = true, AFTER_DRAIN = false;
    unsigned char* VT;
    __device__ __forceinline__ void operator()(const f32x4 (&acc)[2][2][4][2], const Unit& u, int wr, int wc, int fr, int fq) const {
#pragma unroll
        for (int ai = 0; ai < 2; ++ai)
#pragma unroll
            for (int m = 0; m < 4; ++m) {
                const int eg = u.pm * BM + ai * HALF + wr * 64 + m * 16 + fr, hh = eg >> 7, e = eg & 127, sw = (e >> 2) & 3;
#pragma unroll
                for (int bj = 0; bj < 2; ++bj) {
                    const int tok = u.pn * BM + bj * HALF + wc * 32 + 8 * fq, b = tok >> 14, sq = tok & (cfg::SEQ - 1), tile = sq >> 6, g = (sq & 63) >> 3;
                    unsigned char* blk = VT + ((size_t)((b * 8 + hh) * 256 + tile)) * 8192 + e * 64;
                    f32x4 v0 = acc[ai][bj][m][0] * 16.f, v1 = acc[ai][bj][m][1] * 16.f;
#pragma unroll
                    for (int i = 0; i < 4; ++i) { v0[i] = __builtin_amdgcn_fmed3f(v0[i], -448.f, 448.f); v1[i] = __builtin_amdgcn_fmed3f(v1[i], -448.f, 448.f); }
                    int w0 = 0, w1 = 0;
                    w0 = __builtin_amdgcn_cvt_pk_fp8_f32(v0[0], v0[1], w0, false); w0 = __builtin_amdgcn_cvt_pk_fp8_f32(v0[2], v0[3], w0, true);
                    w1 = __builtin_amdgcn_cvt_pk_fp8_f32(v1[0], v1[1], w1, false); w1 = __builtin_amdgcn_cvt_pk_fp8_f32(v1[2], v1[3], w1, true);
                    const int p0 = 4 * g, p1 = 32 + 4 * g;
                    *(unsigned*)(blk + (((p0 >> 4) ^ sw) << 4) + (p0 & 15)) = (unsigned)w0;
                    *(unsigned*)(blk + (((p1 >> 4) ^ sw) << 4) + (p1 & 15)) = (unsigned)w1;
                }
            }
    }
};
struct EpiRes {
    static constexpr bool PERM = false, AFTER_DRAIN = false;
    const bf16_t* X; float* Vout;
    __device__ __forceinline__ void operator()(const f32x4 (&acc)[2][2][4][2], const Unit& u, int wr, int wc, int fr, int fq) const {
        const int col0 = u.pn * BM + wc * 32 + 4 * fq;
#pragma unroll
        for (int ai = 0; ai < 2; ++ai)
#pragma unroll
            for (int m = 0; m < 4; ++m) {
                const size_t ro = (size_t)(u.pm * BM + ai * HALF + wr * 64 + m * 16 + fr) * 1024 + col0;
#pragma unroll
                for (int bj = 0; bj < 2; ++bj)
#pragma unroll
                    for (int n = 0; n < 2; ++n) { const size_t off = ro + bj * HALF + n * 16; typedef unsigned u32x2_ __attribute__((ext_vector_type(2))); const u32x2_ xb = *(const u32x2_*)(X + off);
                        const f32x4 x = (f32x4){__builtin_bit_cast(float, xb[0] << 16), __builtin_bit_cast(float, xb[0] & 0xffff0000u), __builtin_bit_cast(float, xb[1] << 16), __builtin_bit_cast(float, xb[1] & 0xffff0000u)};
                        *(f32x4*)(Vout + off) = x * cfg::ALPHA + acc[ai][bj][m][n]; }
            }
    }
};
struct EpiHin {
    static constexpr bool PERM = true, AFTER_DRAIN = false;
    bf16_t* QKVG; bf16_t* LG; const float* lbtab;
    __device__ __forceinline__ void operator()(const f32x4 (&acc)[2][2][4][2], const Unit& u, int wr, int wc, int fr, int fq) const {
        const int sec = u.pn >> 2;
        const int col0 = (u.pn & 3) * 256 + wc * 32 + 8 * fq;
        bf16_t* base = QKVG + (size_t)sec * ((size_t)cfg::T * 1024);
#pragma unroll
        for (int ai = 0; ai < 2; ++ai)
#pragma unroll
            for (int m = 0; m < 4; ++m) {
                const size_t ro = (size_t)(u.pm * BM + ai * HALF + wr * 64 + m * 16 + fr) * 1024 + col0;
#pragma unroll
                for (int bj = 0; bj < 2; ++bj) {
                    f32x4 v0 = acc[ai][bj][m][0], v1 = acc[ai][bj][m][1];
                    if (sec == 0 || sec == 3) {
#pragma unroll
                        for (int i = 0; i < 4; ++i) { v0[i] = v0[i] * sigm(v0[i]); v1[i] = v1[i] * sigm(v1[i]); }
                    } else if (sec == 1) {
                        const f32x4 l0 = *(const f32x4*)(lbtab + col0 + bj * HALF), l1 = *(const f32x4*)(lbtab + col0 + bj * HALF + 4);
                        f32x4 g0, g1;
#pragma unroll
                        for (int i = 0; i < 4; ++i) {
                            const float s0 = sigm(v0[i]), os0 = 1.f - s0, s1 = sigm(v1[i]), os1 = 1.f - s1;
                            g0[i] = __logf(l0[i] + (1.f - l0[i]) * s0); v0[i] = (1.f - l0[i]) * os0;
                            g1[i] = __logf(l1[i] + (1.f - l1[i]) * s1); v1[i] = (1.f - l1[i]) * os1;
                        }
                        { u32x4 lw; lw.x = cvt_pk_bf16(g0[0], g0[1]); lw.y = cvt_pk_bf16(g0[2], g0[3]); lw.z = cvt_pk_bf16(g1[0], g1[1]); lw.w = cvt_pk_bf16(g1[2], g1[3]); *(u32x4*)(LG + ro + bj * HALF) = lw; }
                    }
                    u32x4 w; w.x = cvt_pk_bf16(v0[0], v0[1]); w.y = cvt_pk_bf16(v0[2], v0[3]); w.z = cvt_pk_bf16(v1[0], v1[1]); w.w = cvt_pk_bf16(v1[2], v1[3]);
                    *(u32x4*)(base + ro + bj * HALF) = w;
                }
            }
    }
};

struct MoeTabs { const PG8_LAS int* toff; const PG8_LAS int* cntv; const PG8_LAS unsigned char* tile_e; const PG8_LAS unsigned short* xl; int nxl; };
template <int NN> struct MoeOrder {
    MoeTabs tb; int G, c; const int* rowlist;
    __device__ __forceinline__ bool next(int i, Unit& u) const {
        const int L = i * (G >> 3) + (c >> 3); if (L >= tb.nxl * NN) return false;
        const int ti = L / NN, n = L - ti * NN, tile = __builtin_amdgcn_readfirstlane((int)tb.xl[ti]), e = __builtin_amdgcn_readfirstlane((int)tb.tile_e[tile]);
        u.pm = tile; u.pn = e * NN + n; u.aux = n; u.e = e; return true;
    }
    __device__ __forceinline__ int row_of(const Unit& u, int r) const {
        const int slot = (u.pm - __builtin_amdgcn_readfirstlane(tb.toff[u.e])) * 256 + r, last = __builtin_amdgcn_readfirstlane(tb.cntv[u.e]) - 1;
        return rowlist[(size_t)u.e * cfg::T + (slot < last ? slot : last)];
    }
    __device__ __forceinline__ void a_ready(const Unit&) const {}
    __device__ __forceinline__ void done(const Unit&) const {}
};
struct EpiSwiglu {
    static constexpr bool PERM = true, AFTER_DRAIN = false;
    bf16_t* H1;
    __device__ __forceinline__ void operator()(const f32x4 (&acc)[2][2][4][2], const Unit& u, int wr, int wc, int fr, int fq) const {
        const int col0 = u.aux * 128 + wc * 32 + 8 * fq;
#pragma unroll
        for (int ai = 0; ai < 2; ++ai)
#pragma unroll
            for (int m = 0; m < 4; ++m) {
                const size_t row = (size_t)u.pm * BM + ai * HALF + wr * 64 + m * 16 + fr;
                const f32x4 g0 = acc[ai][0][m][0], g1 = acc[ai][0][m][1], u0 = acc[ai][1][m][0], u1 = acc[ai][1][m][1];
                f32x4 h0, h1;
#pragma unroll
                for (int i = 0; i < 4; ++i) { h0[i] = g0[i] * sigm(g0[i]) * u0[i]; h1[i] = g1[i] * sigm(g1[i]) * u1[i]; }
                u32x4 w; w.x = cvt_pk_bf16(h0[0], h0[1]); w.y = cvt_pk_bf16(h0[2], h0[3]); w.z = cvt_pk_bf16(h1[0], h1[1]); w.w = cvt_pk_bf16(h1[2], h1[3]);
                *(u32x4*)(H1 + row * 256 + col0) = w;
            }
    }
};
struct EpiDown {
    static constexpr bool PERM = true, AFTER_DRAIN = false;
    unsigned char* Y;
    __device__ __forceinline__ void operator()(const f32x4 (&acc)[2][2][4][2], const Unit& u, int wr, int wc, int fr, int fq) const {
        const int col0 = u.aux * 256 + wc * 32 + 8 * fq;
        typedef unsigned u32x2_ __attribute__((ext_vector_type(2)));
#pragma unroll
        for (int ai = 0; ai < 2; ++ai)
#pragma unroll
            for (int m = 0; m < 4; ++m) {
                unsigned char* rowp = Y + ((size_t)u.pm * BM + ai * HALF + wr * 64 + m * 16 + fr) * 1024 + col0;
#pragma unroll
                for (int bj = 0; bj < 2; ++bj) {
                    f32x4 v0 = acc[ai][bj][m][0] * 64.f, v1 = acc[ai][bj][m][1] * 64.f;
#pragma unroll
                    for (int i = 0; i < 4; ++i) { v0[i] = __builtin_amdgcn_fmed3f(v0[i], -448.f, 448.f); v1[i] = __builtin_amdgcn_fmed3f(v1[i], -448.f, 448.f); }
                    int w0 = 0, w1 = 0;
                    w0 = __builtin_amdgcn_cvt_pk_fp8_f32(v0[0], v0[1], w0, false); w0 = __builtin_amdgcn_cvt_pk_fp8_f32(v0[2], v0[3], w0, true);
                    w1 = __builtin_amdgcn_cvt_pk_fp8_f32(v1[0], v1[1], w1, false); w1 = __builtin_amdgcn_cvt_pk_fp8_f32(v1[2], v1[3], w1, true);
                    *(u32x2_*)(rowp + bj * HALF) = (u32x2_){(unsigned)w0, (unsigned)w1};
                }
            }
    }
};
template <class Epi, class Sched, bool ALIGN_EPI = false, bool SP2 = false>
__device__ __forceinline__ void gemm_phase(PG8_LAS unsigned char* lds, const Gemm g, const Sched& S, const Epi& E) {
    int tid_l = threadIdx.x; asm volatile("" : "+v"(tid_l));
    const int tid = tid_l, wid = __builtin_amdgcn_readfirstlane(tid >> 6), lane = tid & 63, wr = wid >> 2, wc = wid & 3, fr = lane & 15, fq = lane >> 4;
    const int K = g.K, nt = K / BK;
    unsigned voffA[2], voffB[2];
#pragma unroll
    for (int i = 0; i < 2; ++i) { int R, C; stage_rc(tid * 16 + i * 8192, R, C); const int Rb = Epi::PERM ? ((R & ~31) + perm32(R & 31)) : R;
        voffA[i] = (unsigned)(R * K + C) * 2u; voffB[i] = (unsigned)(Rb * K + C) * 2u; }
    const size_t kstep = (size_t)(BK * 2);
    const size_t hstep = (size_t)HALF * K * 2;
    const size_t tstep = 2 * hstep;
    const unsigned ldsw = (unsigned)wid * 1024u;
    const int aoff = lds_byte(wr * 64 + fr, fq * 8), boff = lds_byte(wc * 32 + fr, fq * 8);
#define PG8_SA(b, h) (((b) * 2 + (h)) * HTB)
#define PG8_SB(b, h) ((4 + (b) * 2 + (h)) * HTB)
#define PG8_STAGE(bufoff, gbase, voff) do { _Pragma("unroll") for (int _i = 0; _i < 2; ++_i) \
        __builtin_amdgcn_global_load_lds((const unsigned*)((const char*)(gbase) + (voff)[_i]), (PG8_LAS unsigned*)(lds + (bufoff) + ldsw + _i * 8192), 16, 0, 0); } while (0)
#define PG8_LDA(dst, b, h) do { _Pragma("unroll") for (int m = 0; m < 4; ++m) _Pragma("unroll") for (int k = 0; k < 2; ++k) dst[m][k] = *(const PG8_LAS bf16x8*)(lds + PG8_SA(b, h) + aoff + m * 2048 + k * 1024); } while (0)
#define PG8_LDB(dst, b, h) do { _Pragma("unroll") for (int n = 0; n < 2; ++n) _Pragma("unroll") for (int k = 0; k < 2; ++k) dst[n][k] = *(const PG8_LAS bf16x8*)(lds + PG8_SB(b, h) + boff + n * 2048 + k * 1024); } while (0)
#define PG8_MMA(ai, bj, At, Bt) do { __builtin_amdgcn_s_setprio(1); _Pragma("unroll") for (int m = 0; m < 4; ++m) _Pragma("unroll") for (int n = 0; n < 2; ++n) _Pragma("unroll") for (int k = 0; k < 2; ++k) \
        acc[ai][bj][m][n] = __builtin_amdgcn_mfma_f32_16x16x32_bf16(Bt[n][k], At[m][k], acc[ai][bj][m][n], 0, 0, 0); __builtin_amdgcn_s_setprio(0); } while (0)
#define PG8_WAIT_V(n) asm volatile("s_waitcnt vmcnt(" #n ")" ::: "memory")
#define PG8_WAIT_L(n) asm volatile("s_waitcnt lgkmcnt(" #n ")" ::: "memory")
#define PG8_BAR __builtin_amdgcn_s_barrier()
#define PG8_SCHED __builtin_amdgcn_sched_barrier(0)
    Unit cur, nxt; int ui = 0;
    if (!S.next(0, cur)) return;
    f32x4 acc[2][2][4][2];
#pragma unroll
    for (int a = 0; a < 2; ++a)
#pragma unroll
        for (int b = 0; b < 2; ++b)
#pragma unroll
            for (int m = 0; m < 4; ++m)
#pragma unroll
                for (int n = 0; n < 2; ++n) acc[a][b][m][n] = (f32x4){0.f, 0.f, 0.f, 0.f};
    bf16x8 At[4][2], B0[2][2], B1[2][2];
    const char* cA = (const char*)g.A + (size_t)cur.pm * tstep; const char* cB = (const char*)g.Bt + (size_t)cur.pn * tstep;
    S.a_ready(cur);
    if constexpr (SP2) {
        PG8_STAGE(PG8_SB(0, 0), cB, voffB); PG8_STAGE(PG8_SB(0, 1), cB + hstep, voffB); PG8_STAGE(PG8_SA(0, 0), cA, voffA); PG8_STAGE(PG8_SA(0, 1), cA + hstep, voffA);
        if (wr == 1) PG8_BAR;
        PG8_WAIT_V(2); PG8_BAR;
        PG8_STAGE(PG8_SB(1, 0), cB + kstep, voffB); PG8_STAGE(PG8_SA(1, 0), cA + kstep, voffA); PG8_STAGE(PG8_SB(1, 1), cB + hstep + kstep, voffB);
        PG8_WAIT_V(6); PG8_BAR;
    } else {
        PG8_STAGE(PG8_SB(0, 0), cB, voffB); PG8_STAGE(PG8_SA(0, 0), cA, voffA); PG8_STAGE(PG8_SB(0, 1), cB + hstep, voffB); PG8_STAGE(PG8_SA(0, 1), cA + hstep, voffA);
        if (wr == 1) PG8_BAR;
        PG8_WAIT_V(4); PG8_BAR;
        PG8_STAGE(PG8_SB(1, 0), cB + kstep, voffB); PG8_STAGE(PG8_SA(1, 0), cA + kstep, voffA); PG8_STAGE(PG8_SB(1, 1), cB + hstep + kstep, voffB);
        PG8_WAIT_V(6); PG8_BAR;
    }
    for (;;) {
        const bool has_next = S.next(ui + 1, nxt);
        const char* nA = has_next ? (const char*)g.A + (size_t)nxt.pm * tstep : cA; const char* nB = has_next ? (const char*)g.Bt + (size_t)nxt.pn * tstep : cB;
        for (int t = 0; t < nt; t += 2) {
            const bool last = (t == nt - 2);
            const char* a1 = cA + (size_t)(t + 1) * kstep;
            const char* a2 = last ? nA : cA + (size_t)(t + 2) * kstep; const char* b2 = last ? nB : cB + (size_t)(t + 2) * kstep;
            const char* a3 = a2 + kstep; const char* b3 = b2 + kstep;
            if (last && has_next) S.a_ready(nxt);
            if constexpr (SP2) {
            PG8_LDB(B0, 0, 0); PG8_LDB(B1, 0, 1); PG8_SCHED; PG8_LDA(At, 0, 0); PG8_STAGE(PG8_SA(1, 1), a1 + hstep, voffA);
            PG8_WAIT_V(8); PG8_WAIT_L(0); PG8_BAR; PG8_MMA(0, 0, At, B0); PG8_MMA(0, 1, At, B1); PG8_BAR; PG8_SCHED;
            PG8_LDA(At, 0, 1); PG8_STAGE(PG8_SB(0, 0), b2, voffB); PG8_STAGE(PG8_SB(0, 1), b2 + hstep, voffB); PG8_STAGE(PG8_SA(0, 0), a2, voffA);
            PG8_WAIT_V(8); PG8_WAIT_L(0); PG8_BAR; PG8_MMA(1, 0, At, B0); PG8_MMA(1, 1, At, B1); PG8_BAR; PG8_SCHED;
            PG8_LDB(B0, 1, 0); PG8_LDB(B1, 1, 1); PG8_SCHED; PG8_LDA(At, 1, 0); PG8_STAGE(PG8_SA(0, 1), a2 + hstep, voffA);
            PG8_WAIT_V(8); PG8_WAIT_L(0); PG8_BAR; PG8_MMA(0, 0, At, B0); PG8_MMA(0, 1, At, B1); PG8_BAR; PG8_SCHED;
            PG8_LDA(At, 1, 1); PG8_STAGE(PG8_SB(1, 0), b3, voffB); PG8_STAGE(PG8_SB(1, 1), b3 + hstep, voffB); PG8_STAGE(PG8_SA(1, 0), a3, voffA);
            PG8_WAIT_V(8); PG8_WAIT_L(0); PG8_BAR; PG8_MMA(1, 0, At, B0); PG8_MMA(1, 1, At, B1); PG8_BAR; PG8_SCHED;
            } else {
            PG8_LDB(B0, 0, 0); PG8_SCHED; PG8_LDA(At, 0, 0); PG8_STAGE(PG8_SA(1, 1), a1 + hstep, voffA);
            PG8_WAIT_L(8); PG8_BAR; PG8_WAIT_L(0); PG8_MMA(0, 0, At, B0); PG8_BAR; PG8_SCHED;
            PG8_LDB(B1, 0, 1); PG8_STAGE(PG8_SB(0, 0), b2, voffB);
            PG8_BAR; PG8_WAIT_L(0); PG8_MMA(0, 1, At, B1); PG8_BAR;
            PG8_LDA(At, 0, 1); PG8_STAGE(PG8_SA(0, 0), a2, voffA);
            PG8_BAR; PG8_WAIT_L(0); PG8_MMA(1, 0, At, B0); PG8_BAR; PG8_SCHED;
            PG8_STAGE(PG8_SB(0, 1), b2 + hstep, voffB);
            PG8_WAIT_V(6); PG8_BAR; PG8_MMA(1, 1, At, B1); PG8_BAR;
            PG8_LDB(B0, 1, 0); PG8_SCHED; PG8_LDA(At, 1, 0); PG8_STAGE(PG8_SA(0, 1), a2 + hstep, voffA);
            PG8_WAIT_L(8); PG8_BAR; PG8_WAIT_L(0); PG8_MMA(0, 0, At, B0); PG8_BAR; PG8_SCHED;
            PG8_LDB(B1, 1, 1); PG8_STAGE(PG8_SB(1, 0), b3, voffB);
            PG8_BAR; PG8_WAIT_L(0); PG8_MMA(0, 1, At, B1); PG8_BAR;
            PG8_LDA(At, 1, 1); PG8_STAGE(PG8_SA(1, 0), a3, voffA);
            PG8_BAR; PG8_WAIT_L(0); PG8_MMA(1, 0, At, B0); PG8_BAR; PG8_SCHED;
            PG8_STAGE(PG8_SB(1, 1), b3 + hstep, voffB);
            PG8_WAIT_V(6); PG8_BAR; PG8_MMA(1, 1, At, B1); PG8_BAR;
            }
        }
        if constexpr (ALIGN_EPI) { if (wr == 0) PG8_BAR; }
        if constexpr (!Epi::AFTER_DRAIN) { E(acc, cur, wr, wc, fr, fq); S.done(cur); }
        if (!has_next) break;
#pragma unroll
        for (int a = 0; a < 2; ++a)
#pragma unroll
            for (int b = 0; b < 2; ++b)
#pragma unroll
                for (int m = 0; m < 4; ++m)
#pragma unroll
                    for (int n = 0; n < 2; ++n) acc[a][b][m][n] = (f32x4){0.f, 0.f, 0.f, 0.f};
        cur = nxt; cA = nA; cB = nB; ++ui;
        if constexpr (ALIGN_EPI) { if (wr == 1) PG8_BAR; }
    }
    PG8_WAIT_V(0);
    if constexpr (!ALIGN_EPI) { if (wr == 0) PG8_BAR; }
    PG8_BAR;
    if constexpr (Epi::AFTER_DRAIN) { E.fused(acc, cur, wr, wc, fr, fq, lds, wid, lane); S.done(cur); }
#undef PG8_SA
#undef PG8_SB
#undef PG8_STAGE
#undef PG8_LDA
#undef PG8_LDB
#undef PG8_MMA
#undef PG8_WAIT_V
#undef PG8_WAIT_L
#undef PG8_BAR
#undef PG8_SCHED
}


#define PG8_GOFF(dst, unit) do { _Pragma("unroll") for (int _h = 0; _h < 2; ++_h) _Pragma("unroll") for (int _i = 0; _i < 2; ++_i) { int R_, C_; stage_rc(tid * 16 + _i * 8192, R_, C_); \
        dst[_h][_i] = (unsigned)(S.row_of(unit, _h * HALF + R_) * K + C_) * 2u; } } while (0)
template <class Epi, class Sched, bool ALIGN_EPI = false, bool SP2 = false>
__device__ __forceinline__ void gemm_phase_g(PG8_LAS unsigned char* lds, const Gemm g, const Sched& S, const Epi& E) {
    int tid_l = threadIdx.x; asm volatile("" : "+v"(tid_l));
    const int tid = tid_l, wid = __builtin_amdgcn_readfirstlane(tid >> 6), lane = tid & 63, wr = wid >> 2, wc = wid & 3, fr = lane & 15, fq = lane >> 4;
    const int K = g.K, nt = K / BK;
    unsigned voffA[2], voffB[2];
#pragma unroll
    for (int i = 0; i < 2; ++i) { int R, C; stage_rc(tid * 16 + i * 8192, R, C); const int Rb = Epi::PERM ? ((R & ~31) + perm32(R & 31)) : R;
        voffA[i] = (unsigned)(R * K + C) * 2u; voffB[i] = (unsigned)(Rb * K + C) * 2u; }
    const size_t kstep = (size_t)(BK * 2);
    const size_t hstep = (size_t)HALF * K * 2;
    const size_t tstep = 2 * hstep;
    const unsigned ldsw = (unsigned)wid * 1024u;
    const int aoff = lds_byte(wr * 64 + fr, fq * 8), boff = lds_byte(wc * 32 + fr, fq * 8);
#define PG8_SA(b, h) (((b) * 2 + (h)) * HTB)
#define PG8_SB(b, h) ((4 + (b) * 2 + (h)) * HTB)
#define PG8_STAGE(bufoff, gbase, voff) do { _Pragma("unroll") for (int _i = 0; _i < 2; ++_i) \
        __builtin_amdgcn_global_load_lds((const unsigned*)((const char*)(gbase) + (voff)[_i]), (PG8_LAS unsigned*)(lds + (bufoff) + ldsw + _i * 8192), 16, 0, 0); } while (0)
#define PG8_LDA(dst, b, h) do { _Pragma("unroll") for (int m = 0; m < 4; ++m) _Pragma("unroll") for (int k = 0; k < 2; ++k) dst[m][k] = *(const PG8_LAS bf16x8*)(lds + PG8_SA(b, h) + aoff + m * 2048 + k * 1024); } while (0)
#define PG8_LDB(dst, b, h) do { _Pragma("unroll") for (int n = 0; n < 2; ++n) _Pragma("unroll") for (int k = 0; k < 2; ++k) dst[n][k] = *(const PG8_LAS bf16x8*)(lds + PG8_SB(b, h) + boff + n * 2048 + k * 1024); } while (0)
#define PG8_MMA(ai, bj, At, Bt) do { __builtin_amdgcn_s_setprio(1); _Pragma("unroll") for (int m = 0; m < 4; ++m) _Pragma("unroll") for (int n = 0; n < 2; ++n) _Pragma("unroll") for (int k = 0; k < 2; ++k) \
        acc[ai][bj][m][n] = __builtin_amdgcn_mfma_f32_16x16x32_bf16(Bt[n][k], At[m][k], acc[ai][bj][m][n], 0, 0, 0); __builtin_amdgcn_s_setprio(0); } while (0)
#define PG8_WAIT_V(n) asm volatile("s_waitcnt vmcnt(" #n ")" ::: "memory")
#define PG8_WAIT_L(n) asm volatile("s_waitcnt lgkmcnt(" #n ")" ::: "memory")
#define PG8_BAR __builtin_amdgcn_s_barrier()
#define PG8_SCHED __builtin_amdgcn_sched_barrier(0)
    Unit cur, nxt; int ui = 0;
    if (!S.next(0, cur)) return;
    f32x4 acc[2][2][4][2];
#pragma unroll
    for (int a = 0; a < 2; ++a)
#pragma unroll
        for (int b = 0; b < 2; ++b)
#pragma unroll
            for (int m = 0; m < 4; ++m)
#pragma unroll
                for (int n = 0; n < 2; ++n) acc[a][b][m][n] = (f32x4){0.f, 0.f, 0.f, 0.f};
    bf16x8 At[4][2], B0[2][2], B1[2][2];
    const char* cA = (const char*)g.A; unsigned vC[2][2], vN[2][2], vS[2][2]; PG8_GOFF(vC, cur); const char* cB = (const char*)g.Bt + (size_t)cur.pn * tstep;
    S.a_ready(cur);
    if constexpr (SP2) {
        PG8_STAGE(PG8_SB(0, 0), cB, voffB); PG8_STAGE(PG8_SB(0, 1), cB + hstep, voffB); PG8_STAGE(PG8_SA(0, 0), cA, vC[0]); PG8_STAGE(PG8_SA(0, 1), cA, vC[1]);
        if (wr == 1) PG8_BAR;
        PG8_WAIT_V(2); PG8_BAR;
        PG8_STAGE(PG8_SB(1, 0), cB + kstep, voffB); PG8_STAGE(PG8_SA(1, 0), cA + kstep, vC[0]); PG8_STAGE(PG8_SB(1, 1), cB + hstep + kstep, voffB);
        PG8_WAIT_V(6); PG8_BAR;
    } else {
        PG8_STAGE(PG8_SB(0, 0), cB, voffB); PG8_STAGE(PG8_SA(0, 0), cA, vC[0]); PG8_STAGE(PG8_SB(0, 1), cB + hstep, voffB); PG8_STAGE(PG8_SA(0, 1), cA, vC[1]);
        if (wr == 1) PG8_BAR;
        PG8_WAIT_V(4); PG8_BAR;
        PG8_STAGE(PG8_SB(1, 0), cB + kstep, voffB); PG8_STAGE(PG8_SA(1, 0), cA + kstep, vC[0]); PG8_STAGE(PG8_SB(1, 1), cB + hstep + kstep, voffB);
        PG8_WAIT_V(6); PG8_BAR;
    }
    for (;;) {
        const bool has_next = S.next(ui + 1, nxt);
        const char* nA = (const char*)g.A; if (has_next) { PG8_GOFF(vN, nxt); } else { _Pragma("unroll") for (int _h = 0; _h < 2; ++_h) _Pragma("unroll") for (int _i = 0; _i < 2; ++_i) vN[_h][_i] = vC[_h][_i]; } const char* nB = has_next ? (const char*)g.Bt + (size_t)nxt.pn * tstep : cB;
        for (int t = 0; t < nt; t += 2) {
            const bool last = (t == nt - 2); _Pragma("unroll") for (int _h = 0; _h < 2; ++_h) _Pragma("unroll") for (int _i = 0; _i < 2; ++_i) vS[_h][_i] = last ? vN[_h][_i] : vC[_h][_i];
            const char* a1 = cA + (size_t)(t + 1) * kstep;
            const char* a2 = last ? nA : cA + (size_t)(t + 2) * kstep; const char* b2 = last ? nB : cB + (size_t)(t + 2) * kstep;
            const char* a3 = a2 + kstep; const char* b3 = b2 + kstep;
            if (last && has_next) S.a_ready(nxt);
            if constexpr (SP2) {
            PG8_LDB(B0, 0, 0); PG8_LDB(B1, 0, 1); PG8_SCHED; PG8_LDA(At, 0, 0); PG8_STAGE(PG8_SA(1, 1), a1, vC[1]);
            PG8_WAIT_V(8); PG8_WAIT_L(0); PG8_BAR; PG8_MMA(0, 0, At, B0); PG8_MMA(0, 1, At, B1); PG8_BAR; PG8_SCHED;
            PG8_LDA(At, 0, 1); PG8_STAGE(PG8_SB(0, 0), b2, voffB); PG8_STAGE(PG8_SB(0, 1), b2 + hstep, voffB); PG8_STAGE(PG8_SA(0, 0), a2, vS[0]);
            PG8_WAIT_V(8); PG8_WAIT_L(0); PG8_BAR; PG8_MMA(1, 0, At, B0); PG8_MMA(1, 1, At, B1); PG8_BAR; PG8_SCHED;
            PG8_LDB(B0, 1, 0); PG8_LDB(B1, 1, 1); PG8_SCHED; PG8_LDA(At, 1, 0); PG8_STAGE(PG8_SA(0, 1), a2, vS[1]);
            PG8_WAIT_V(8); PG8_WAIT_L(0); PG8_BAR; PG8_MMA(0, 0, At, B0); PG8_MMA(0, 1, At, B1); PG8_BAR; PG8_SCHED;
            PG8_LDA(At, 1, 1); PG8_STAGE(PG8_SB(1, 0), b3, voffB); PG8_STAGE(PG8_SB(1, 1), b3 + hstep, voffB); PG8_STAGE(PG8_SA(1, 0), a3, vS[0]);
            PG8_WAIT_V(8); PG8_WAIT_L(0); PG8_BAR; PG8_MMA(1, 0, At, B0); PG8_MMA(1, 1, At, B1); PG8_BAR; PG8_SCHED;
            } else {
            PG8_LDB(B0, 0, 0); PG8_SCHED; PG8_LDA(At, 0, 0); PG8_STAGE(PG8_SA(1, 1), a1, vC[1]);
            PG8_WAIT_L(8); PG8_BAR; PG8_WAIT_L(0); PG8_MMA(0, 0, At, B0); PG8_BAR; PG8_SCHED;
            PG8_LDB(B1, 0, 1); PG8_STAGE(PG8_SB(0, 0), b2, voffB);
            PG8_BAR; PG8_WAIT_L(0); PG8_MMA(0, 1, At, B1); PG8_BAR;
            PG8_LDA(At, 0, 1); PG8_STAGE(PG8_SA(0, 0), a2, vS[0]);
            PG8_BAR; PG8_WAIT_L(0); PG8_MMA(1, 0, At, B0); PG8_BAR; PG8_SCHED;
            PG8_STAGE(PG8_SB(0, 1), b2 + hstep, voffB);
            PG8_WAIT_V(6); PG8_BAR; PG8_MMA(1, 1, At, B1); PG8_BAR;
            PG8_LDB(B0, 1, 0); PG8_SCHED; PG8_LDA(At, 1, 0); PG8_STAGE(PG8_SA(0, 1), a2, vS[1]);
            PG8_WAIT_L(8); PG8_BAR; PG8_WAIT_L(0); PG8_MMA(0, 0, At, B0); PG8_BAR; PG8_SCHED;
            PG8_LDB(B1, 1, 1); PG8_STAGE(PG8_SB(1, 0), b3, voffB);
            PG8_BAR; PG8_WAIT_L(0); PG8_MMA(0, 1, At, B1); PG8_BAR;
            PG8_LDA(At, 1, 1); PG8_STAGE(PG8_SA(1, 0), a3, vS[0]);
            PG8_BAR; PG8_WAIT_L(0); PG8_MMA(1, 0, At, B0); PG8_BAR; PG8_SCHED;
            PG8_STAGE(PG8_SB(1, 1), b3 + hstep, voffB);
            PG8_WAIT_V(6); PG8_BAR; PG8_MMA(1, 1, At, B1); PG8_BAR;
            }
        }
        if constexpr (ALIGN_EPI) { if (wr == 0) PG8_BAR; }
        if constexpr (!Epi::AFTER_DRAIN) { E(acc, cur, wr, wc, fr, fq); S.done(cur); }
        if (!has_next) break;
#pragma unroll
        for (int a = 0; a < 2; ++a)
#pragma unroll
            for (int b = 0; b < 2; ++b)
#pragma unroll
                for (int m = 0; m < 4; ++m)
#pragma unroll
                    for (int n = 0; n < 2; ++n) acc[a][b][m][n] = (f32x4){0.f, 0.f, 0.f, 0.f};
        cur = nxt; cA = nA; cB = nB; ++ui; _Pragma("unroll") for (int _h = 0; _h < 2; ++_h) _Pragma("unroll") for (int _i = 0; _i < 2; ++_i) vC[_h][_i] = vN[_h][_i];
        if constexpr (ALIGN_EPI) { if (wr == 1) PG8_BAR; }
    }
    PG8_WAIT_V(0);
    if constexpr (!ALIGN_EPI) { if (wr == 0) PG8_BAR; }
    PG8_BAR;
    if constexpr (Epi::AFTER_DRAIN) { E.fused(acc, cur, wr, wc, fr, fq, lds, wid, lane); S.done(cur); }
#undef PG8_SA
#undef PG8_SB
#undef PG8_STAGE
#undef PG8_LDA
#undef PG8_LDB
#undef PG8_MMA
#undef PG8_WAIT_V
#undef PG8_WAIT_L
#undef PG8_BAR
#undef PG8_SCHED
}
#undef PG8_GOFF

}


namespace {
#define GAS __attribute__((address_space(1)))
#define LAS __attribute__((address_space(3)))
typedef unsigned short bf16;
typedef unsigned v4u __attribute__((ext_vector_type(4)));
typedef float f32x4 __attribute__((ext_vector_type(4)));
constexpr int NWAVES = 8, NTHREADS = 512, LDS_BYTES = 147456;

__device__ __forceinline__ unsigned pk2(float lo, float hi) { typedef float f2_c __attribute__((ext_vector_type(2))); typedef __bf16 b2_c __attribute__((ext_vector_type(2))); const f2_c v = {lo, hi}; return __builtin_bit_cast(unsigned, __builtin_convertvector(v, b2_c)); }
__device__ __forceinline__ unsigned f2bf(float f) { return pk2(f, f) & 0xffffu; }
__device__ __forceinline__ float bf2f(bf16 h) { return __uint_as_float((unsigned)h << 16); }
__device__ __forceinline__ float wave_sum(float v) {
#pragma unroll
    for (int o = 1; o < 64; o <<= 1) v += __shfl_xor(v, o);
    return v;
}
__device__ __forceinline__ float sigmoidf_(float x) { return __builtin_amdgcn_rcpf(1.f + __expf(-x)); }
__device__ __forceinline__ int fkey_(float x) { const int b = (int)__float_as_uint(x); return b >= 0 ? b : (b ^ 0x7fffffff); }
__device__ __forceinline__ float fkey_inv_(int k) { return __uint_as_float((unsigned)(k >= 0 ? k : (k ^ 0x7fffffff))); }
constexpr int KEY_NEG_INF = (int)0x807fffff;
template <int CTRL> __device__ __forceinline__ int dppi_(int v) { return __builtin_amdgcn_update_dpp(v, v, CTRL, 0xF, 0xF, false); }
template <int CTRL> __device__ __forceinline__ float dppf_(float v) { return __uint_as_float((unsigned)__builtin_amdgcn_update_dpp((int)__float_as_uint(v), (int)__float_as_uint(v), CTRL, 0xF, 0xF, false)); }
__device__ __forceinline__ int imax_(int a, int b) { return a > b ? a : b; }
__device__ __forceinline__ int gmax8i_(int v) {
    asm volatile("s_nop 1\n\tv_max_i32_dpp %0, %0, %0 quad_perm:[1,0,3,2] row_mask:0xf bank_mask:0xf\n\ts_nop 1\n\tv_max_i32_dpp %0, %0, %0 quad_perm:[2,3,0,1] row_mask:0xf bank_mask:0xf\n\t"
                 "s_nop 1\n\tv_max_i32_dpp %0, %0, %0 row_half_mirror row_mask:0xf bank_mask:0xf" : "+v"(v));
    return v; }
__device__ __forceinline__ int wmaxi_(int v) { v = gmax8i_(v); asm volatile("s_nop 1\n\tv_max_i32_dpp %0, %0, %0 row_mirror row_mask:0xf bank_mask:0xf" : "+v"(v));
    const int a = __builtin_amdgcn_readlane(v, 0), b = __builtin_amdgcn_readlane(v, 16), c = __builtin_amdgcn_readlane(v, 32), d = __builtin_amdgcn_readlane(v, 48); return imax_(imax_(a, b), imax_(c, d)); }
__device__ __forceinline__ float wsumf_(float v) { v += dppf_<0xB1>(v); v += dppf_<0x4E>(v); v += dppf_<0x141>(v); v += dppf_<0x140>(v);
    const float a = __uint_as_float((unsigned)__builtin_amdgcn_readlane((int)__float_as_uint(v), 0)), b = __uint_as_float((unsigned)__builtin_amdgcn_readlane((int)__float_as_uint(v), 16)),
                c = __uint_as_float((unsigned)__builtin_amdgcn_readlane((int)__float_as_uint(v), 32)), d = __uint_as_float((unsigned)__builtin_amdgcn_readlane((int)__float_as_uint(v), 48)); return (a + b) + (c + d); }


struct WS {
    int* ctl;
    bf16 *Wqkv_t, *Wo_t, *Hin_t, *Hout_t, *Wgu_t, *Wd_t;
    float *rot, *lbtab;
    float *V32;
    bf16 *Xb, *Qb, *Kb, *Vb, *Ob, *Gb;
    float *LG;
    bf16 *Uf, *Sf; float *Dbuf;
    float *Wr_t;
    bf16 *H1, *Y;
    int *rowlist; float *tok_w; int *tok_es;
};
constexpr int NROWS = T * 9 + 65 * 256;
constexpr int TAB_OFF = 131072;


template <int PERMK> __device__ __forceinline__ int perm_row(int n) {
    if (PERMK == 1) { if (n < 2048) { const int p = n & 63; if (p < 16) return (n & ~63) + 2 * (p & 7) + (p >> 3); } return n; }
    if (PERMK == 2) { const int up = n >> 8, i = n & 255; return (i >> 7) * 256 + up * 128 + (i & 127); }
    return n;
}
template <int PERMK> __device__ __forceinline__ void transpose_item(const float* W, int K, int N, bf16* WT, LAS float* scr, int item, int lane) {
    const int nblk = N / 32, kb = item / nblk, nb = item % nblk, k0 = 64 * kb, n0 = 32 * nb;
#pragma unroll 8
    for (int i = 0; i < 32; ++i) { const int kk = 2 * i + (lane >> 5); scr[kk * 33 + (lane & 31)] = W[(size_t)(k0 + kk) * N + n0 + (lane & 31)]; }
    asm volatile("s_waitcnt lgkmcnt(0)" ::: "memory");
    const int c = lane & 7;
#pragma unroll
    for (int j = 0; j < 4; ++j) { const int n = (lane >> 3) + 8 * j; const LAS float* s = scr + (8 * c) * 33 + n;
        v4u o; o.x = pk2(s[0 * 33], s[1 * 33]); o.y = pk2(s[2 * 33], s[3 * 33]); o.z = pk2(s[4 * 33], s[5 * 33]); o.w = pk2(s[6 * 33], s[7 * 33]);
        *(GAS v4u*)(WT + (size_t)perm_row<PERMK>(n0 + n) * K + k0 + 8 * c) = o; }
    asm volatile("s_waitcnt lgkmcnt(0)" ::: "memory");
}
template <int PERMK> __device__ __forceinline__ void transpose_batch(const float* W, size_t sstride, bf16* WT, size_t dstride, int nmat, int K, int N, LAS float* scr, int gw, int ngw, int lane) {
    const int ipm = (K / 64) * (N / 32);
    for (int it = gw; it < nmat * ipm; it += ngw) { const int mat = it / ipm; transpose_item<PERMK>(W + (size_t)mat * sstride, K, N, WT + (size_t)mat * dstride, scr, it % ipm, lane); }
}
struct Inputs { const float* p[17]; };
constexpr int CNT_STRIDE = 520, CNT_BASE = 16384;
constexpr int CTL_POISON = 2048;
typedef int v8i_ __attribute__((ext_vector_type(8)));
typedef float v16f_ __attribute__((ext_vector_type(16)));
__device__ __forceinline__ bool fp8_mfma_selftest(int lane) {
    const int r32 = lane & 31, h = lane >> 5;
    v8i_ A, B;
#pragma unroll
    for (int w = 0; w < 8; ++w) {
        float av[4], bv[4];
#pragma unroll
        for (int b = 0; b < 4; ++b) { const int k = 32 * h + 4 * w + b; av[b] = (float)((r32 * 3 + k * 5) % 5); bv[b] = (float)((k * 7 + r32 * 2) % 4); }
        int aw = 0, bw = 0;
        aw = __builtin_amdgcn_cvt_pk_fp8_f32(av[0], av[1], aw, false); aw = __builtin_amdgcn_cvt_pk_fp8_f32(av[2], av[3], aw, true);
        bw = __builtin_amdgcn_cvt_pk_fp8_f32(bv[0], bv[1], bw, false); bw = __builtin_amdgcn_cvt_pk_fp8_f32(bv[2], bv[3], bw, true);
        A[w] = aw; B[w] = bw;
    }
    v16f_ C;
#pragma unroll
    for (int r = 0; r < 16; ++r) C[r] = 0.f;
    C = __builtin_amdgcn_mfma_scale_f32_32x32x64_f8f6f4(A, B, C, 0, 0, 0, 0x7F7F7F7F, 0, 0x7F7F7F7F);
    bool ok = true;
#pragma unroll
    for (int r = 0; r < 16; ++r) {
        const int i = (r & 3) + 8 * (r >> 2) + 4 * h, j = r32; float e = 0.f;
        for (int k = 0; k < 64; ++k) e += (float)((i * 3 + k * 5) % 5) * (float)((k * 7 + j * 2) % 4);
        ok = ok && (C[r] == e);
    }
    return __all(ok);
}

__device__ __forceinline__ void prologue_phase(const Inputs& in, const WS& w, float* X32, LAS unsigned char* lds) {
    int tid_l = threadIdx.x; asm volatile("" : "+v"(tid_l));
    const int tid = tid_l, lane = tid & 63, wave = tid >> 6;
    const int gw = blockIdx.x * NWAVES + wave, ngw = gridDim.x * NWAVES;
    LAS float* scr = (LAS float*)(lds + wave * 16384);
    transpose_batch<1>(in.p[1], (size_t)D * 3072, w.Wqkv_t, (size_t)3072 * D, 2, D, 3072, scr, gw, ngw, lane);
    transpose_batch<0>(in.p[2], (size_t)D * D, w.Wo_t, (size_t)D * D, 2, D, D, scr, gw, ngw, lane);
    transpose_batch<0>(in.p[5], (size_t)D * 4096, w.Hin_t, (size_t)4096 * D, 2, D, 4096, scr, gw, ngw, lane);
    transpose_batch<0>(in.p[6], (size_t)D * D, w.Hout_t, (size_t)D * D, 2, D, D, scr, gw, ngw, lane);
    for (int L = 0; L < DEPTH; ++L) {
        transpose_batch<2>(in.p[11] + (size_t)L * NE * D * 512, (size_t)D * 512, w.Wgu_t + (size_t)L * 65 * 512 * D, (size_t)512 * D, NE, D, 512, scr, gw, ngw, lane);
        transpose_batch<2>(in.p[13] + (size_t)L * D * 512, 0, w.Wgu_t + ((size_t)L * 65 + 64) * 512 * D, 0, 1, D, 512, scr, gw, ngw, lane);
        transpose_batch<0>(in.p[12] + (size_t)L * NE * 256 * D, (size_t)256 * D, w.Wd_t + (size_t)L * 65 * D * 256, (size_t)D * 256, NE, 256, D, scr, gw, ngw, lane);
        transpose_batch<0>(in.p[14] + (size_t)L * 256 * D, 0, w.Wd_t + ((size_t)L * 65 + 64) * D * 256, 0, 1, 256, D, scr, gw, ngw, lane);
    }
    if (blockIdx.x == 0 && wave == 0) { const bool ok = fp8_mfma_selftest(lane); if (!ok && lane == 0) w.ctl[CTL_POISON] = 1; }
    const int gt = blockIdx.x * NTHREADS + tid, ngt = gridDim.x * NTHREADS;
    for (int i = gt; i < SEQ * 8; i += ngt) {
        const int pos = i >> 3, j = i & 7;
        const float inv_freq = (float)pow(500000.0, -(double)(2 * j) / 16.0);
        float sn, cs; sincosf((float)pos * inv_freq, &sn, &cs);
        w.rot[2 * i] = cs; w.rot[2 * i + 1] = sn;
    }
    for (int i = gt; i < 2 * 1024; i += ngt) {
        const int col = i & 1023, L = (i >> 10) ? 3 : 1; const float* r = in.p[7];
        const float v0 = r[col], v1 = r[1024 + col], v2 = r[2048 + col], v3 = r[3072 + col];
        const float mx = fmaxf(fmaxf(v0, v1), fmaxf(v2, v3));
        const float e0 = expf(v0 - mx), e1 = expf(v1 - mx), e2 = expf(v2 - mx), e3 = expf(v3 - mx), den = e0 + e1 + e2 + e3;
        w.lbtab[i] = (L == 1) ? e1 / den : (e1 + e2 + e3) / den;
    }
    if (gt < 2) { const float* lp = in.p[3] + gt * 256; float d01 = 0.f, d23 = 0.f; for (int i = 0; i < 64; ++i) { d01 += lp[i] * lp[64 + i]; d23 += lp[128 + i] * lp[192 + i]; }
        w.lbtab[2048 + gt] = expf(d01) - expf(d23) + (0.8f - 0.6f * expf(-0.3f * (float)(2 * gt))); }
    for (int i = gt; i < T; i += ngt) w.rowlist[(size_t)NE * T + i] = i;
    for (int i = gt; i < DEPTH * NE * D; i += ngt) { const int L = i / (NE * D), r = i % (NE * D), e = r / D, k = r % D; const float v = in.p[9][(size_t)L * D * NE + (size_t)k * NE + e];
        const unsigned hb = f2bf(v); bf16* dst = (bf16*)w.Wr_t + (size_t)L * 2 * NE * D; dst[r] = (bf16)hb; dst[NE * D + r] = (bf16)f2bf(v - __uint_as_float(hb << 16)); }
    for (size_t i = gt; i < (size_t)T * D / 4; i += ngt) {
        const f32x4 v = ((const f32x4*)in.p[0])[i];
        uint2 o; o.x = pk2(v[0], v[1]); o.y = pk2(v[2], v[3]); ((uint2*)w.Xb)[i] = o;
    }
}

__device__ __forceinline__ void ln_row(const float* vrow, float* xrow, bf16* brow, const float* g, const float* b, int lane) {
    f32x4 v[4]; float s = 0.f;
#pragma unroll
    for (int j = 0; j < 4; ++j) { v[j] = ((const f32x4*)vrow)[lane + 64 * j]; s += (v[j][0] + v[j][1]) + (v[j][2] + v[j][3]); }
    const float mean = wsumf_(s) * (1.f / D); float q = 0.f;
#pragma unroll
    for (int j = 0; j < 4; ++j) { v[j] = v[j] - mean; q += (v[j][0] * v[j][0] + v[j][1] * v[j][1]) + (v[j][2] * v[j][2] + v[j][3] * v[j][3]); }
    const float rstd = __builtin_amdgcn_rsqf(wsumf_(q) * (1.f / D) + LN_EPS);
#pragma unroll
    for (int j = 0; j < 4; ++j) {
        const f32x4 g4 = ((const f32x4*)g)[lane + 64 * j], b4 = ((const f32x4*)b)[lane + 64 * j];
        const f32x4 o = v[j] * rstd * g4 + b4;
        ((f32x4*)xrow)[lane + 64 * j] = o;
        uint2 ob; ob.x = pk2(o[0], o[1]); ob.y = pk2(o[2], o[3]); ((uint2*)brow)[lane + 64 * j] = ob;
    }
}
typedef float f32x4_ __attribute__((ext_vector_type(4)));
__device__ __forceinline__ pg8::MoeTabs moe_tables(const int* cnt, LAS unsigned char* lds, int tid) {
    asm volatile("" : "+v"(tid));
    LAS int* toff = (LAS int*)(lds + TAB_OFF); LAS int* cntv = toff + 80; LAS unsigned char* tile_e = (LAS unsigned char*)(cntv + 80);
    __syncthreads();
    if (tid < 64) cntv[tid] = cnt[tid * CNT_STRIDE];
    if (tid == 64) cntv[64] = T;
    __syncthreads();
    if (tid == 0) { int a = 0; for (int e = 0; e < 65; ++e) { toff[e] = a; a += (cntv[e] + 255) >> 8; } toff[65] = a; }
    __syncthreads();
    if (tid < 65) for (int m = toff[tid]; m < toff[tid + 1]; ++m) tile_e[m] = (unsigned char)tid;
    LAS unsigned short* xl = (LAS unsigned short*)(lds + TAB_OFF + 4096); LAS int* nxl = (LAS int*)(lds + TAB_OFF + 4096 + 3072);
    if (tid == 0) {
        const int g = blockIdx.x & 7; int n = 0;
        for (int e = g; e < 64; e += 8) for (int m = toff[e]; m < toff[e + 1]; ++m) xl[n++] = (unsigned short)m;
        for (int m = toff[64] + g; m < toff[65]; m += 8) xl[n++] = (unsigned short)m;
        nxl[0] = n;
    }
    __syncthreads();
    pg8::MoeTabs tb{toff, cntv, tile_e, xl, nxl[0]}; return tb;
}
typedef short bf16x8r __attribute__((ext_vector_type(8)));
__device__ __forceinline__ void lnroute_phase(const float* V32, float* X32, bf16* Xb, const float* lg, const float* lb, const bf16* WrHL, const float* bias, int* cnt, int* rowlist, float* tok_w, int* tok_es, LAS unsigned char* lds) {
    int tid_l = threadIdx.x; asm volatile("" : "+v"(tid_l));
    const int tid = tid_l, lane = tid & 63, wave = tid >> 6;
    constexpr int WP = 144;
    LAS unsigned char* wt = lds;
    LAS float* logitS = (LAS float*)(lds + 40960) + wave * 1024;
    LAS float* selw = (LAS float*)(lds + 40960 + 32768) + wave * 1024;
    LAS int* cntL = (LAS int*)(lds + 40960 + 65536); LAS int* baseL = cntL + 64;
    const float bias_e = bias[lane];
    for (int grp = blockIdx.x; grp < T / 128; grp += gridDim.x) {
        if (tid < 64) cntL[tid] = 0;
        const int tok0 = grp * 128 + wave * 16;
#pragma unroll 1
        for (int rb = 0; rb < 16; rb += 4) {
            f32x4 v[4][4];
#pragma unroll
            for (int r = 0; r < 4; ++r)
#pragma unroll
                for (int j = 0; j < 4; ++j) v[r][j] = __builtin_nontemporal_load((const f32x4*)(V32 + (size_t)(tok0 + rb + r) * D) + lane + 64 * j);
#pragma unroll
            for (int r = 0; r < 4; ++r) {
                float sm = 0.f;
#pragma unroll
                for (int j = 0; j < 4; ++j) sm += (v[r][j][0] + v[r][j][1]) + (v[r][j][2] + v[r][j][3]);
                const float mean = wsumf_(sm) * (1.f / D); float q = 0.f;
#pragma unroll
                for (int j = 0; j < 4; ++j) { v[r][j] = v[r][j] - mean; q += (v[r][j][0] * v[r][j][0] + v[r][j][1] * v[r][j][1]) + (v[r][j][2] * v[r][j][2] + v[r][j][3] * v[r][j][3]); }
                const float rstd = __builtin_amdgcn_rsqf(wsumf_(q) * (1.f / D) + LN_EPS);
#pragma unroll
                for (int j = 0; j < 4; ++j) {
                    const f32x4 g4 = ((const f32x4*)lg)[lane + 64 * j], b4 = ((const f32x4*)lb)[lane + 64 * j];
                    const f32x4 o = v[r][j] * rstd * g4 + b4;
                    ((f32x4*)(X32 + (size_t)(tok0 + rb + r) * D))[lane + 64 * j] = o;
                    uint2 ob; ob.x = pk2(o[0], o[1]); ob.y = pk2(o[2], o[3]); ((uint2*)(Xb + (size_t)(tok0 + rb + r) * D))[lane + 64 * j] = ob;
                }
            }
        }
        asm volatile("s_waitcnt vmcnt(0)" ::: "memory");
        f32x4_ acc[4];
#pragma unroll
        for (int nb = 0; nb < 4; ++nb) acc[nb] = (f32x4_){0.f, 0.f, 0.f, 0.f};
        const float* xa = X32 + (size_t)(tok0 + (lane & 15)) * D + 8 * (lane >> 4);
        const bf16* wsrc = WrHL + (size_t)(tid >> 8) * NE * D + (size_t)((tid >> 2) & 63) * D + (tid & 3) * 16;
        const int wdst = ((tid >> 8) * 64 + ((tid >> 2) & 63)) * WP + (tid & 3) * 32;
        v4u w0 = *(const v4u*)(wsrc), w1 = *(const v4u*)(wsrc + 8);
        f32x4 xa0 = *(const f32x4*)(xa), xa1 = *(const f32x4*)(xa + 4), xa2 = *(const f32x4*)(xa + 32), xa3 = *(const f32x4*)(xa + 36);
        *(LAS v4u*)(wt + wdst) = w0; *(LAS v4u*)(wt + wdst + 16) = w1;
        __syncthreads();
#pragma unroll 1
        for (int kb = 0; kb < 16; ++kb) {
            const int cur = kb & 1;
            f32x4 xn0, xn1, xn2, xn3;
            if (kb + 1 < 16) { w0 = *(const v4u*)(wsrc + (kb + 1) * 64); w1 = *(const v4u*)(wsrc + (kb + 1) * 64 + 8);
                xn0 = *(const f32x4*)(xa + (kb + 1) * 64); xn1 = *(const f32x4*)(xa + (kb + 1) * 64 + 4); xn2 = *(const f32x4*)(xa + (kb + 1) * 64 + 32); xn3 = *(const f32x4*)(xa + (kb + 1) * 64 + 36); }
#pragma unroll
            for (int ss = 0; ss < 2; ++ss) {
                const f32x4 a0 = ss ? xa2 : xa0, a1 = ss ? xa3 : xa1;
                unsigned hb[8]; float lo[8];
#pragma unroll
                for (int i = 0; i < 4; ++i) { hb[i] = f2bf(a0[i]); lo[i] = a0[i] - __uint_as_float(hb[i] << 16); hb[4 + i] = f2bf(a1[i]); lo[4 + i] = a1[i] - __uint_as_float(hb[4 + i] << 16); }
                const v4u ah = (v4u){hb[0] | (hb[1] << 16), hb[2] | (hb[3] << 16), hb[4] | (hb[5] << 16), hb[6] | (hb[7] << 16)};
                const v4u al = (v4u){pk2(lo[0], lo[1]), pk2(lo[2], lo[3]), pk2(lo[4], lo[5]), pk2(lo[6], lo[7])};
                const LAS unsigned char* wp = wt + cur * (2 * 64 * WP) + (lane & 15) * WP + (ss * 32 + 8 * (lane >> 4)) * 2;
#pragma unroll
                for (int nb = 0; nb < 4; ++nb) {
                    const v4u bh = *(const LAS v4u*)(wp + nb * 16 * WP), bl = *(const LAS v4u*)(wp + 64 * WP + nb * 16 * WP);
                    acc[nb] = __builtin_amdgcn_mfma_f32_16x16x32_bf16(__builtin_bit_cast(bf16x8r, ah), __builtin_bit_cast(bf16x8r, bh), acc[nb], 0, 0, 0);
                    acc[nb] = __builtin_amdgcn_mfma_f32_16x16x32_bf16(__builtin_bit_cast(bf16x8r, ah), __builtin_bit_cast(bf16x8r, bl), acc[nb], 0, 0, 0);
                    acc[nb] = __builtin_amdgcn_mfma_f32_16x16x32_bf16(__builtin_bit_cast(bf16x8r, al), __builtin_bit_cast(bf16x8r, bh), acc[nb], 0, 0, 0);
                }
            }
            if (kb + 1 < 16) { *(LAS v4u*)(wt + (cur ^ 1) * (2 * 64 * WP) + wdst) = w0; *(LAS v4u*)(wt + (cur ^ 1) * (2 * 64 * WP) + wdst + 16) = w1; xa0 = xn0; xa1 = xn1; xa2 = xn2; xa3 = xn3; }
            __syncthreads();
        }
#pragma unroll
        for (int nb = 0; nb < 4; ++nb)
#pragma unroll
            for (int r = 0; r < 4; ++r) logitS[(4 * (lane >> 4) + r) * 64 + 16 * nb + (lane & 15)] = acc[nb][r];
        asm volatile("s_waitcnt lgkmcnt(0)" ::: "memory");
        int mycount = 0;
#pragma unroll 1
        for (int t = 0; t < 16; ++t) {
            const float logit = logitS[t * 64 + lane];
            const float s = sigmoidf_(logit), c = s + bias_e;
            const int kc = fkey_(c);
            const int k1 = gmax8i_(kc);
            const unsigned long long eq = __ballot(kc == k1);
            const int g = lane >> 3; const unsigned gm = (unsigned)((eq >> (g * 8)) & 0xFFull); const int first = __ffs(gm) - 1;
            const int k2 = gmax8i_(((lane & 7) == first) ? KEY_NEG_INF : kc);
            const float gs = fkey_inv_(k1) + fkey_inv_(k2);
            int grank = 0;
#pragma unroll
            for (int gp = 0; gp < 8; ++gp) { const float og = __uint_as_float((unsigned)__builtin_amdgcn_readlane((int)__float_as_uint(gs), gp * 8)); grank += (og > gs || (og == gs && gp < g)) ? 1 : 0; }
            int work = (grank < 4) ? kc : KEY_NEG_INF; unsigned long long selm = 0ull;
#pragma unroll
            for (int r = 0; r < TOPK; ++r) {
                const int mx = wmaxi_(work);
                const unsigned long long e = __ballot(work == mx);
                const int l = __builtin_ctzll(e);
                selm |= 1ull << l;
                work = (lane == l) ? KEY_NEG_INF : work;
            }
            const bool sel = ((selm >> lane) & 1ull) != 0ull;
            const float ssum = wsumf_(sel ? s : 0.f);
            selw[t * 64 + lane] = sel ? s * __builtin_amdgcn_rcpf(ssum + 1e-20f) * ROUTED_SCALE : -1.f;
            mycount += sel ? 1 : 0;
        }
        const int localbase = __hip_atomic_fetch_add(&cntL[lane], mycount, __ATOMIC_RELAXED, __HIP_MEMORY_SCOPE_WORKGROUP);
        __syncthreads();
        if (wave == 0) { const int c = cntL[lane]; baseL[lane] = c > 0 ? atomicAdd(&cnt[lane * CNT_STRIDE], c) : 0; }
        __syncthreads();
        int slot = baseL[lane] + localbase;
#pragma unroll 1
        for (int t = 0; t < 16; ++t) {
            const float wv = selw[t * 64 + lane]; const bool sel = wv >= 0.f;
            const unsigned long long sm = __ballot(sel);
            if (sel) {
                rowlist[(size_t)lane * T + slot] = tok0 + t;
                const int j = __popcll(sm & ((1ull << lane) - 1ull));
                tok_es[(size_t)(tok0 + t) * 8 + j] = (lane << 16) | slot; tok_w[(size_t)(tok0 + t) * 8 + j] = wv;
                ++slot;
            }
        }
        __syncthreads();
    }
}
__device__ __forceinline__ void combine_phase(const unsigned char* Y, const int* tok_es, const float* tok_w, pg8::MoeTabs tb, const bf16* Xin, float* X32, bf16* Xb, const float* g, const float* b, const int* poison) {
    int tid_l = threadIdx.x; asm volatile("" : "+v"(tid_l));
    const int lane = tid_l & 63, gw = blockIdx.x * NWAVES + (tid_l >> 6), ngw = gridDim.x * NWAVES;
    const bool bad = poison[0] != 0;
    for (int row = gw; row < T; row += ngw) {
        const int es = lane < 8 ? tok_es[(size_t)row * 8 + lane] : 0; const float ew = lane < 8 ? tok_w[(size_t)row * 8 + lane] : 0.f;
        const bf16* xin = Xin + (size_t)row * D;
        f32x4 v[4];
#pragma unroll
        for (int j = 0; j < 4; ++j) { const uint2 d = ((const uint2*)xin)[lane + 64 * j];
            v[j] = (f32x4){__uint_as_float(d.x << 16), __uint_as_float(d.x & 0xffff0000u), __uint_as_float(d.y << 16), __uint_as_float(d.y & 0xffff0000u)} * ALPHA; }
#pragma unroll
        for (int jj = 0; jj < 9; ++jj) {
            size_t pos; float gt = 1.f;
            if (jj < 8) { const int p = __shfl(es, jj); gt = __shfl(ew, jj); pos = (size_t)tb.toff[p >> 16] * 256 + (p & 0xffff); } else pos = (size_t)tb.toff[64] * 256 + row;
            const unsigned* yr = (const unsigned*)(Y + pos * 1024); gt *= (1.f / 64.f);
            typedef float f2_ __attribute__((ext_vector_type(2)));
#pragma unroll
            for (int j = 0; j < 4; ++j) { const unsigned d = __builtin_nontemporal_load(yr + lane + 64 * j);
                const f2_ a = __builtin_amdgcn_cvt_pk_f32_fp8((int)d, false), c = __builtin_amdgcn_cvt_pk_f32_fp8((int)d, true);
                v[j][0] += gt * a[0]; v[j][1] += gt * a[1]; v[j][2] += gt * c[0]; v[j][3] += gt * c[1]; }
        }
        float s = 0.f;
#pragma unroll
        for (int j = 0; j < 4; ++j) s += (v[j][0] + v[j][1]) + (v[j][2] + v[j][3]);
        const float mean = wsumf_(s) * (1.f / D); float q = 0.f;
#pragma unroll
        for (int j = 0; j < 4; ++j) { v[j] = v[j] - mean; q += (v[j][0] * v[j][0] + v[j][1] * v[j][1]) + (v[j][2] * v[j][2] + v[j][3] * v[j][3]); }
        const float rstd = __builtin_amdgcn_rsqf(wsumf_(q) * (1.f / D) + LN_EPS);
#pragma unroll
        for (int j = 0; j < 4; ++j) {
            const f32x4 g4 = ((const f32x4*)g)[lane + 64 * j], b4 = ((const f32x4*)b)[lane + 64 * j];
            f32x4 o = v[j] * rstd * g4 + b4;
            if (bad) { const float qn = __builtin_nanf(""); o = (f32x4){qn, qn, qn, qn}; }
            if (X32) ((f32x4*)(X32 + (size_t)row * D))[lane + 64 * j] = o;
            uint2 ob; ob.x = pk2(o[0], o[1]); ob.y = pk2(o[2], o[3]); ((uint2*)(Xb + (size_t)row * D))[lane + 64 * j] = ob;
        }
    }
}
namespace attn {
typedef float f32x16 __attribute__((ext_vector_type(16)));
typedef unsigned u32x4 __attribute__((ext_vector_type(4)));
typedef int v8i __attribute__((ext_vector_type(8)));
constexpr int SLOTB = 16384, NSLOT = 4, WSF_OFF = 65536;
constexpr float THR = 2.f;
constexpr int ONE = 0x7F7F7F7F; constexpr int STG_OFF = 69632;
__device__ __forceinline__ int crow(int r, int hi) { return (r & 3) + 8 * (r >> 2) + 4 * hi; }
__device__ __forceinline__ void glds16(const void* gsrc, unsigned lds_dst) { unsigned keep;
    asm volatile("s_mov_b32 %0, m0\n\ts_mov_b32 m0, %2\n\ts_nop 0\n\tglobal_load_lds_dwordx4 %1, off\n\ts_mov_b32 m0, %0" : "=&s"(keep) : "v"(gsrc), "s"(lds_dst) : "memory"); }
#define ATT_WAIT_BAR(N) asm volatile("s_waitcnt vmcnt(" #N ") lgkmcnt(0)\n\ts_barrier" ::: "memory")
typedef short v4i16_t __attribute__((ext_vector_type(4)));
typedef short s16x4 __attribute__((ext_vector_type(4)));
__device__ __forceinline__ s16x4 vtr(const LAS unsigned char* p) { return __builtin_bit_cast(s16x4, __builtin_amdgcn_ds_read_tr16_b64_v4i16((LAS v4i16_t*)p)); }
__device__ __forceinline__ unsigned cvtpk(float lo, float hi) { typedef float f2 __attribute__((ext_vector_type(2))); typedef __bf16 b2 __attribute__((ext_vector_type(2))); f2 v = {lo, hi}; b2 b = __builtin_convertvector(v, b2); return __builtin_bit_cast(unsigned, b); }
__device__ __forceinline__ float max3f(float a, float b, float c) { float r; asm("v_max3_f32 %0, %1, %2, %3" : "=v"(r) : "v"(a), "v"(b), "v"(c)); return r; }
__device__ __forceinline__ float xhalf_max(float m) { auto rr = __builtin_amdgcn_permlane32_swap(__float_as_uint(m), __float_as_uint(m), false, false); float r; asm("v_max_f32 %0, %1, %2" : "=v"(r) : "v"(rr[0]), "v"(rr[1])); return r; }
__device__ __forceinline__ float xhalf_sum(float m) { auto rr = __builtin_amdgcn_permlane32_swap(__float_as_uint(m), __float_as_uint(m), false, false); return __uint_as_float(rr[0]) + __uint_as_float(rr[1]); }
__device__ __forceinline__ v8i mk8(const u32x4& a, const u32x4& b) { return (v8i){(int)a[0], (int)a[1], (int)a[2], (int)a[3], (int)b[0], (int)b[1], (int)b[2], (int)b[3]}; }

template <int VAR>
__device__ __forceinline__ void attn_unit(int b, int h, int qb, const unsigned char* __restrict__ Q8, const unsigned char* __restrict__ K8, const unsigned char* __restrict__ VT, bf16* Og,
                                          float lam, const float* __restrict__ subg, float oscale, LAS unsigned char* lds) {
    int tid_l = threadIdx.x; asm volatile("" : "+v"(tid_l));
    const int tid = tid_l, lane = tid & 63, r32 = lane & 31, hi = lane >> 5;
    const int wid = __builtin_amdgcn_readfirstlane(tid >> 6), mp = wid >> 2, wq = wid & 3;
    const size_t rowbase = (size_t)b * SEQ; const int q0 = qb * 128;
    const unsigned lds0 = (unsigned)(uintptr_t)lds;
    LAS float* wsf = (LAS float*)(lds + WSF_OFF) + wid * 64;
    const int kkey = 16 * wq + (lane >> 2), kcc = lane & 3;
    const unsigned char* ksrc = K8 + (rowbase + kkey) * 1024 + (h * 2 + mp) * 64 + 16 * (kcc ^ ((kkey >> 2) & 3));
    const unsigned char* vsrc = VT + ((size_t)((b * 8 + h) * 256)) * 8192 + wid * 1024 + lane * 16;
#define ATT_DMA_K(t, slot) glds16(ksrc + (size_t)(t) * 64 * 1024, (unsigned)__builtin_amdgcn_readfirstlane(lds0 + (unsigned)(slot) * SLOTB + wid * 1024))
#define ATT_DMA_V(t, slot) glds16(vsrc + (size_t)(t) * 8192, (unsigned)__builtin_amdgcn_readfirstlane(lds0 + (unsigned)(slot) * SLOTB + 8192 + wid * 1024))
    const unsigned char* Qw = Q8 + (rowbase + q0 + wq * 32 + r32) * 1024 + (h * 2 + mp) * 64 + hi * 32;
    const u32x4 qa = *(const u32x4*)(Qw), qb_ = *(const u32x4*)(Qw + 16);
    const v8i qf = mk8(qa, qb_);
    const int NT = 2 * qb + 2, tlast = 2 * qb + (wq >> 1);
    constexpr int KSL = 8192, VBASE = 4 * 8192;
#undef ATT_DMA_K
#undef ATT_DMA_V
#define ATT_DMA_K(t) glds16(ksrc + (size_t)(t) * 64 * 1024, (unsigned)__builtin_amdgcn_readfirstlane(lds0 + (unsigned)((t) & 3) * KSL + wid * 1024))
#define ATT_DMA_V(t) glds16(vsrc + (size_t)(t) * 8192, (unsigned)__builtin_amdgcn_readfirstlane(lds0 + VBASE + (unsigned)((t) & 3) * KSL + wid * 1024))
    ATT_DMA_K(0); if (NT > 1) ATT_DMA_K(1); ATT_DMA_V(0);
    int nlast = 0; if (NT > 2) { ATT_DMA_K(2); nlast += 1; } if (NT > 1) { ATT_DMA_V(1); nlast += 1; }
    f32x16 o[4];
    float zero_ = 0.f; asm volatile("" : "+v"(zero_));
#pragma unroll
    for (int d = 0; d < 4; ++d)
#pragma unroll
        for (int r = 0; r < 16; ++r) o[d][r] = zero_;
    const int sw = (r32 >> 2) & 3;
    const unsigned fua = (unsigned)(((2 * hi) ^ sw) * 16), fub = (unsigned)(((2 * hi + 1) ^ sw) * 16);
    const LAS unsigned char* kaddr0 = lds + mp * 4096 + r32 * 64; const LAS unsigned char* vaddr0 = lds + VBASE + r32 * 64;
    u32x4 kf[2][2], vf[4][2];
#define ATT_DSR128(dst, addr, off) dst = *(const LAS u32x4*)((addr) + (off))
#define ATT_KISSUE(t) do { const LAS unsigned char* ka_ = kaddr0 + ((t) & 3) * KSL; \
        ATT_DSR128(kf[0][0], ka_ + fua, 0); ATT_DSR128(kf[0][1], ka_ + fub, 0); ATT_DSR128(kf[1][0], ka_ + fua, 2048); ATT_DSR128(kf[1][1], ka_ + fub, 2048); } while (0)
#define ATT_VISSUE(t) do { const LAS unsigned char* va_ = vaddr0 + ((t) & 3) * KSL; \
        _Pragma("unroll") for (int d0 = 0; d0 < 4; ++d0) { ATT_DSR128(vf[d0][0], va_ + fua, d0 * 2048); ATT_DSR128(vf[d0][1], va_ + fub, d0 * 2048); } } while (0)
#define ATT_WB(N) asm volatile("s_waitcnt vmcnt(" #N ") lgkmcnt(0)\n\ts_barrier" ::: "memory")
#define ATT_WAITN(n) do { if ((n) == 2) { ATT_WB(2); } else if ((n) == 1) { ATT_WB(1); } else { ATT_WB(0); } __builtin_amdgcn_sched_barrier(0); } while (0)
#define ATT_SB() __builtin_amdgcn_sched_barrier(0)
#define ATT_QKM(P, blk) do { P = __builtin_amdgcn_mfma_scale_f32_32x32x64_f8f6f4(mk8(kf[blk][0], kf[blk][1]), qf, negm, 0, 0, 0, ONE, 0, ONE); if constexpr (VAR & 64) P = __builtin_amdgcn_mfma_scale_f32_32x32x64_f8f6f4(mk8(kf[blk][0], kf[blk][1]), qf, P, 0, 0, 0, ONE, 0, ONE); } while (0)
#define ATT_PVM(d0) do { o[d0] = __builtin_amdgcn_mfma_scale_f32_32x32x64_f8f6f4(pw, mk8(vf[d0][0], vf[d0][1]), o[d0], 0, 0, 0, ONE, 0, ONE); if constexpr (VAR & 64) o[d0] = __builtin_amdgcn_mfma_scale_f32_32x32x64_f8f6f4(pw, mk8(vf[d0][0], vf[d0][1]), o[d0], 0, 0, 0, ONE, 0, ONE); } while (0)
#define ATT_EXP8(P, b0) do { _Pragma("unroll") for (int r = (b0); r < (b0) + 8; ++r) P[r] = __builtin_amdgcn_exp2f(P[r]); } while (0)
#define ATT_MAXDEC(P0, P1, first) do { \
        float rm; { float ra_; \
        asm volatile("s_nop 15\n\ts_nop 7\n\t"     \
            "v_max3_f32 %0, %2, %3, %4\n\tv_max3_f32 %0, %0, %5, %6\n\tv_max3_f32 %0, %0, %7, %8\n\tv_max3_f32 %0, %0, %9, %10\n\t" \
            "v_max3_f32 %0, %0, %11, %12\n\tv_max3_f32 %0, %0, %13, %14\n\tv_max3_f32 %0, %0, %15, %16\n\tv_max3_f32 %0, %0, %17, %17" \
            : "=&v"(ra_), "+v"(P1) : "v"(P0[0]), "v"(P0[1]), "v"(P0[2]), "v"(P0[3]), "v"(P0[4]), "v"(P0[5]), "v"(P0[6]), "v"(P0[7]), "v"(P0[8]), "v"(P0[9]), "v"(P0[10]), "v"(P0[11]), "v"(P0[12]), "v"(P0[13]), "v"(P0[14]), "v"(P0[15])); \
        asm volatile("v_max3_f32 %0, %1, %2, %3\n\tv_max3_f32 %0, %0, %4, %5\n\tv_max3_f32 %0, %0, %6, %7\n\tv_max3_f32 %0, %0, %8, %9\n\t" \
            "v_max3_f32 %0, %0, %10, %11\n\tv_max3_f32 %0, %0, %12, %13\n\tv_max3_f32 %0, %0, %14, %15\n\tv_max3_f32 %0, %0, %16, %17" \
            : "=&v"(rm) : "v"(ra_), "v"(P1[0]), "v"(P1[1]), "v"(P1[2]), "v"(P1[3]), "v"(P1[4]), "v"(P1[5]), "v"(P1[6]), "v"(P1[7]), "v"(P1[8]), "v"(P1[9]), "v"(P1[10]), "v"(P1[11]), "v"(P1[12]), "v"(P1[13]), "v"(P1[14]), "v"(P1[15])); } \
        rm = xhalf_max(rm) - 6.f; \
        if (first) { _Pragma("unroll") for (int r = 0; r < 16; ++r) { P0[r] -= rm; P1[r] -= rm; negm[r] = 6.f - rm; } } \
        else if (__any(rm > THR)) { const float dl = fmaxf(rm, 0.f); const float nm_ = negm[0] - dl; \
            _Pragma("unroll") for (int r = 0; r < 16; ++r) { P0[r] -= dl; P1[r] -= dl; negm[r] = nm_; } \
            const float f = __builtin_amdgcn_exp2f(-dl); la *= f; lb *= f; if (hi == 0) wsf[r32] = f; resc = true; } } while (0)
    f32x16 pc0, pc1, negm; v8i pw; bool resc = false; float e[32]; float la = 0.f, lb = 0.f;
#pragma unroll
    for (int w = 0; w < 8; ++w) pw[w] = 0;
    ATT_WAITN(nlast);
    ATT_KISSUE(0);
    asm volatile("s_waitcnt lgkmcnt(0)\n\ts_barrier" ::: "memory"); ATT_SB();
#pragma unroll
    for (int r = 0; r < 16; ++r) negm[r] = 6.f;
    ATT_QKM(pc0, 0); ATT_QKM(pc1, 1);
    ATT_MAXDEC(pc0, pc1, true);
#define ATT_ES8(P, b0, eo, L) do { _Pragma("unroll") for (int r = 0; r < 8; ++r) { e[(eo) + r] = __builtin_amdgcn_exp2f(P[(b0) + r]); L += e[(eo) + r]; } \
        asm volatile("" : "+v"(e[(eo)]), "+v"(e[(eo) + 1]), "+v"(e[(eo) + 2]), "+v"(e[(eo) + 3]), "+v"(e[(eo) + 4]), "+v"(e[(eo) + 5]), "+v"(e[(eo) + 6]), "+v"(e[(eo) + 7]), "+v"(L)); } while (0)
#define ATT_CVT16(eo, w0) do { _Pragma("unroll") for (int w = 0; w < 4; ++w) { int x; asm volatile("" : "=v"(x)); x = __builtin_amdgcn_cvt_pk_fp8_f32(e[(eo) + 4 * w], e[(eo) + 4 * w + 1], x, false); x = __builtin_amdgcn_cvt_pk_fp8_f32(e[(eo) + 4 * w + 2], e[(eo) + 4 * w + 3], x, true); pw[(w0) + w] = x; } \
        asm volatile("" : "+v"(pw)); } while (0)
#define ATT_ISSUE_DMA(t) do { nlast = 0; if ((t) + 3 < NT) { ATT_DMA_K((t) + 3); nlast += 1; } if ((t) + 2 < NT) { ATT_DMA_V((t) + 2); nlast += 1; } } while (0)
#define ATT_PV_EXP() do { \
        ATT_PVM(0); ATT_SB(); ATT_ES8(pc0, 0, 0, la); ATT_SB(); \
        ATT_PVM(1); ATT_SB(); ATT_ES8(pc0, 8, 8, lb); ATT_SB(); \
        ATT_PVM(2); ATT_SB(); ATT_ES8(pc1, 0, 16, la); ATT_SB(); \
        ATT_PVM(3); ATT_SB(); ATT_ES8(pc1, 8, 24, lb); ATT_SB(); } while (0)
#define ATT_PV_EXP_D(t) do { \
        ATT_PVM(0); ATT_SB(); if (mp == 0) ATT_DMA_K((t) + 3); ATT_ES8(pc0, 0, 0, la); ATT_SB(); \
        ATT_PVM(1); ATT_SB(); if (mp == 1) ATT_DMA_K((t) + 3); ATT_ES8(pc0, 8, 8, lb); ATT_SB(); \
        ATT_PVM(2); ATT_SB(); if (mp == 0) ATT_DMA_V((t) + 2); ATT_ES8(pc1, 0, 16, la); ATT_SB(); \
        ATT_PVM(3); ATT_SB(); if (mp == 1) ATT_DMA_V((t) + 2); ATT_ES8(pc1, 8, 24, lb); ATT_SB(); } while (0)
#define ATT_RESC() do { if (resc) { resc = false; \
        _Pragma("unroll") for (int r = 0; r < 16; ++r) { const float fr = wsf[crow(r, hi)]; \
            _Pragma("unroll") for (int d = 0; d < 4; ++d) o[d][r] *= fr; } } } while (0)
#define ATT_CVT_ASM(eo, w0, TIE) do { int x0_, x1_, x2_, x3_; \
        asm volatile("v_cvt_pk_fp8_f32 %0, %5, %6\n\tv_cvt_pk_fp8_f32 %1, %9, %10\n\tv_cvt_pk_fp8_f32 %2, %13, %14\n\tv_cvt_pk_fp8_f32 %3, %17, %18\n\tv_cvt_pk_fp8_f32 %0, %7, %8 op_sel:[0,0,1]\n\tv_cvt_pk_fp8_f32 %1, %11, %12 op_sel:[0,0,1]\n\tv_cvt_pk_fp8_f32 %2, %15, %16 op_sel:[0,0,1]\n\tv_cvt_pk_fp8_f32 %3, %19, %20 op_sel:[0,0,1]" \
            : "=&v"(x0_), "=&v"(x1_), "=&v"(x2_), "=&v"(x3_), "+v"(TIE) : "v"(e[(eo) + 0]), "v"(e[(eo) + 1]), "v"(e[(eo) + 2]), "v"(e[(eo) + 3]), "v"(e[(eo) + 4]), "v"(e[(eo) + 5]), "v"(e[(eo) + 6]), "v"(e[(eo) + 7]), "v"(e[(eo) + 8]), "v"(e[(eo) + 9]), "v"(e[(eo) + 10]), "v"(e[(eo) + 11]), "v"(e[(eo) + 12]), "v"(e[(eo) + 13]), "v"(e[(eo) + 14]), "v"(e[(eo) + 15])); \
        pw[(w0)] = x0_; pw[(w0) + 1] = x1_; pw[(w0) + 2] = x2_; pw[(w0) + 3] = x3_; } while (0)
#define ATT_MAXDEC2(P0, P1) do { \
        ATT_CVT_ASM(0, 0, P1); ATT_CVT_ASM(16, 4, P1); \
        float rmr_; { float ra_; \
        asm volatile("s_nop 1\n\tv_max3_f32 %0, %2, %3, %4\n\tv_max3_f32 %0, %0, %5, %6\n\tv_max3_f32 %0, %0, %7, %8\n\tv_max3_f32 %0, %0, %9, %10\n\tv_max3_f32 %0, %0, %11, %12\n\tv_max3_f32 %0, %0, %13, %14\n\tv_max3_f32 %0, %0, %15, %16\n\tv_max3_f32 %0, %0, %17, %17" \
            : "=&v"(ra_), "+v"(P1) : "v"(P0[0]), "v"(P0[1]), "v"(P0[2]), "v"(P0[3]), "v"(P0[4]), "v"(P0[5]), "v"(P0[6]), "v"(P0[7]), "v"(P0[8]), "v"(P0[9]), "v"(P0[10]), "v"(P0[11]), "v"(P0[12]), "v"(P0[13]), "v"(P0[14]), "v"(P0[15])); \
        asm volatile("v_max3_f32 %0, %1, %2, %3\n\tv_max3_f32 %0, %0, %4, %5\n\tv_max3_f32 %0, %0, %6, %7\n\tv_max3_f32 %0, %0, %8, %9\n\tv_max3_f32 %0, %0, %10, %11\n\tv_max3_f32 %0, %0, %12, %13\n\tv_max3_f32 %0, %0, %14, %15\n\tv_max3_f32 %0, %0, %16, %17\n\tv_mov_b32 %1, %0\n\ts_nop 1\n\tv_permlane32_swap_b32 %0, %1\n\tv_max_f32 %0, %0, %1" \
            : "=&v"(rmr_), "+v"(ra_) : "v"(P1[0]), "v"(P1[1]), "v"(P1[2]), "v"(P1[3]), "v"(P1[4]), "v"(P1[5]), "v"(P1[6]), "v"(P1[7]), "v"(P1[8]), "v"(P1[9]), "v"(P1[10]), "v"(P1[11]), "v"(P1[12]), "v"(P1[13]), "v"(P1[14]), "v"(P1[15])); } \
        if (__any(rmr_ > THR + 6.f)) { const float dl = fmaxf(rmr_ - 6.f, 0.f); const float nm_ = negm[0] - dl;     \
            _Pragma("unroll") for (int r = 0; r < 16; ++r) { P0[r] -= dl; P1[r] -= dl; negm[r] = nm_; } \
            const float f = __builtin_amdgcn_exp2f(-dl); la *= f; lb *= f; if (hi == 0) wsf[r32] = f; resc = true; } } while (0)
#define ATT_QK_NEXT(t) do { \
        ATT_QKM(pc0, 0); ATT_SB(); \
        ATT_QKM(pc1, 1); ATT_SB(); \
        ATT_MAXDEC2(pc0, pc1); } while (0)
    {
        ATT_ISSUE_DMA(0);
        if (1 <= tlast) ATT_KISSUE(1);
        ATT_ES8(pc0, 0, 0, la); ATT_ES8(pc0, 8, 8, lb); ATT_ES8(pc1, 0, 16, la); ATT_ES8(pc1, 8, 24, lb);
        ATT_VISSUE(0);
        if (1 <= tlast) ATT_QK_NEXT(0); else { ATT_CVT16(0, 0); ATT_CVT16(16, 4); }
        ATT_WAITN(nlast);
    }
    int t = 1;
#define ATT_KISSUE_S(sl) do { const LAS unsigned char* ka_ = kaddr0 + (sl) * KSL; \
        ATT_DSR128(kf[0][0], ka_ + fua, 0); ATT_DSR128(kf[0][1], ka_ + fub, 0); ATT_DSR128(kf[1][0], ka_ + fua, 2048); ATT_DSR128(kf[1][1], ka_ + fub, 2048); } while (0)
#define ATT_VISSUE_S(sl) do { const LAS unsigned char* va_ = vaddr0 + (sl) * KSL; \
        _Pragma("unroll") for (int d0 = 0; d0 < 4; ++d0) { ATT_DSR128(vf[d0][0], va_ + fua, d0 * 2048); ATT_DSR128(vf[d0][1], va_ + fub, d0 * 2048); } } while (0)
#define ATT_DMA_K_S(tt, sl) glds16(ksrc + (size_t)(tt) * 64 * 1024, (unsigned)__builtin_amdgcn_readfirstlane(lds0 + (unsigned)(sl) * KSL + wid * 1024))
#define ATT_DMA_V_S(tt, sl) glds16(vsrc + (size_t)(tt) * 8192, (unsigned)__builtin_amdgcn_readfirstlane(lds0 + VBASE + (unsigned)(sl) * KSL + wid * 1024))
#define ATT_STEP_S(tt, c) do { \
        ATT_KISSUE_S(((c) + 1) & 3); ATT_SB(); \
        ATT_PVM(0); ATT_SB(); ATT_DMA_K_S((tt) + 3, ((c) + 3) & 3); ATT_ES8(pc0, 0, 0, la); ATT_SB(); \
        ATT_PVM(1); ATT_SB(); ATT_ES8(pc0, 8, 8, lb); ATT_SB(); \
        ATT_PVM(2); ATT_SB(); ATT_DMA_V_S((tt) + 2, ((c) + 2) & 3); ATT_ES8(pc1, 0, 16, la); ATT_SB(); \
        ATT_PVM(3); ATT_SB(); ATT_ES8(pc1, 8, 24, lb); ATT_SB(); \
        ATT_RESC(); \
        ATT_VISSUE_S((c) & 3); \
        ATT_QK_NEXT(tt); \
        ATT_WB(2); ATT_SB(); } while (0)
    const int nst = tlast < NT - 3 ? tlast : NT - 3;
#pragma unroll 1
    for (; t + 3 < nst; t += 4) { ATT_STEP_S(t, 1); ATT_STEP_S(t + 1, 2); ATT_STEP_S(t + 2, 3); ATT_STEP_S(t + 3, 0); }
    for (; t < tlast && t + 3 < NT; ++t) {
        ATT_KISSUE(t + 1); ATT_SB();
        ATT_PV_EXP_D(t);
        ATT_RESC();
        ATT_VISSUE(t);
        ATT_QK_NEXT(t);
        ATT_WB(2); ATT_SB();
    }
    for (; t < tlast; ++t) {
        ATT_ISSUE_DMA(t);
        ATT_KISSUE(t + 1); ATT_SB();
        ATT_PV_EXP();
        ATT_RESC();
        ATT_VISSUE(t);
        ATT_QK_NEXT(t);
        ATT_WAITN(nlast);
    }
    if (tlast >= 1) {
        ATT_ISSUE_DMA(tlast);
        ATT_PV_EXP();
        ATT_RESC();
        ATT_VISSUE(tlast);
        ATT_CVT16(0, 0); ATT_CVT16(16, 4);
        ATT_WAITN(nlast);
    }
    if (tlast + 1 < NT) {
        ATT_ISSUE_DMA(tlast + 1);
        ATT_PVM(0); ATT_PVM(1); ATT_PVM(2); ATT_PVM(3);
        ATT_WAITN(nlast);
    } else { ATT_PVM(0); ATT_PVM(1); ATT_PVM(2); ATT_PVM(3); }
    float l_reg = xhalf_sum(la + lb);
    if (hi == 0) wsf[32 + r32] = l_reg;
    asm volatile("s_waitcnt lgkmcnt(0)" ::: "memory");
    float rli[16];
#pragma unroll
    for (int r = 0; r < 16; ++r) rli[r] = 0.0625f * __builtin_amdgcn_rcpf(wsf[32 + crow(r, hi)]);
    ATT_WAIT_BAR(0);
    LAS float* xo = (LAS float*)(lds + wq * 16384) + lane;
    if (mp == 1) {
#pragma unroll
        for (int d = 0; d < 4; ++d)
#pragma unroll
            for (int r = 0; r < 16; ++r) xo[(d * 16 + r) * 64] = o[d][r] * rli[r];
    }
    ATT_WAIT_BAR(0);
    float ss[16];
#pragma unroll
    for (int r = 0; r < 16; ++r) ss[r] = 0.f;
    if (mp == 0) {
#pragma unroll
        for (int d = 0; d < 4; ++d)
#pragma unroll
            for (int r = 0; r < 16; ++r) { const float v = o[d][r] * rli[r] - lam * xo[(d * 16 + r) * 64]; o[d][r] = v; ss[r] += v * v; }
#pragma unroll
        for (int r = 0; r < 16; ++r) { float s = ss[r]; s += __shfl_xor(s, 1); s += __shfl_xor(s, 2); s += __shfl_xor(s, 4); s += __shfl_xor(s, 8); s += __shfl_xor(s, 16);
            ss[r] = oscale * __builtin_amdgcn_rsqf(s * (1.f / 128.f) + LN_EPS); }
        asm volatile("s_waitcnt lgkmcnt(0)" ::: "memory");
    }
    ATT_WAIT_BAR(0);
    if (mp == 0) {
        LAS unsigned short* stg = (LAS unsigned short*)(lds + STG_OFF + wq * 8192);
#pragma unroll
        for (int d = 0; d < 4; ++d) { const float gsc = subg[d * 32 + r32];
#pragma unroll
            for (int r = 0; r < 16; ++r) stg[crow(r, hi) * 128 + d * 32 + r32] = (unsigned short)f2bf(o[d][r] * ss[r] * gsc); }
        asm volatile("s_waitcnt lgkmcnt(0)" ::: "memory");
        bf16* Ow = Og + (rowbase + q0 + wq * 32) * 1024 + h * 128;
#pragma unroll
        for (int i = 0; i < 8; ++i) { const int row = 4 * i + (lane >> 4), ch = lane & 15;
            const u32x4 v = *(const LAS u32x4*)(stg + row * 128 + ch * 8);
            *(u32x4*)(Ow + (size_t)row * 1024 + ch * 8) = v; }
    }
#undef ATT_DMA_K
#undef ATT_DMA_V
}
template <int VAR = 0>
__device__ __forceinline__ void attn_phase(const unsigned char* Q8, const unsigned char* K8, const unsigned char* VT, bf16* Og, float lam, const float* subg, float oscale, LAS unsigned char* lds) {
    const int G = gridDim.x, bx = blockIdx.x, vcu = (G % 8 == 0) ? (bx % 8) * (G / 8) + bx / 8 : bx;
    for (int v = vcu; v < 256; v += G) {
        const int bh = v >> 4, s = v & 15;
#pragma unroll 1
        for (int i = 0; i < 8; ++i) {
            const int qb = (i >> 1) * 32 + ((i & 1) ? 31 - s : s);
            attn_unit<VAR>(bh >> 3, bh & 7, qb, Q8, K8, VT, Og, lam, subg, oscale, lds);
        }
    }
}
}

namespace hgrn {
typedef short bf16x8 __attribute__((ext_vector_type(8)));
typedef short s16x4 __attribute__((ext_vector_type(4)));
typedef float f32x16 __attribute__((ext_vector_type(16)));
typedef unsigned u32x4 __attribute__((ext_vector_type(4)));
typedef unsigned u32x2 __attribute__((ext_vector_type(2)));
constexpr int L_WT = 0, L_BM = 4096, L_KT = 8192, L_VT = 24576, L_QB = 40960, L_KB = 57344, L_QT = 73728, L_SSQ = 90624;
constexpr int QT_PITCH = 264;
using attn::crow; using attn::vtr; using attn::cvtpk;

__device__ __forceinline__ void chunk_cumsum(float (&v)[16], int lane, int wave, int seg, LAS unsigned char* lds) {
    LAS float* WT = (LAS float*)(lds + L_WT);
#pragma unroll
    for (int off = 8; off < 64; off <<= 1)
#pragma unroll
        for (int i = 0; i < 16; ++i) { const float n = __shfl_up(v[i], off); if (lane >= off) v[i] += n; }
    if (lane >= 56) {
#pragma unroll
        for (int i = 0; i < 16; ++i) WT[wave * 128 + seg * 16 + i] = v[i];
    }
    __syncthreads();
    for (int w = 0; w < wave; ++w) {
#pragma unroll
        for (int i = 0; i < 16; i += 4) { const f32x4 a = *(const LAS f32x4*)(WT + w * 128 + seg * 16 + i); v[i] += a[0]; v[i + 1] += a[1]; v[i + 2] += a[2]; v[i + 3] += a[3]; }
    }
}
__device__ __forceinline__ void unpack16(const u32x4& a, const u32x4& b, float (&o)[16]) {
#pragma unroll
    for (int i = 0; i < 4; ++i) { o[2 * i] = __uint_as_float(a[i] << 16); o[2 * i + 1] = __uint_as_float(a[i] & 0xffff0000u); o[8 + 2 * i] = __uint_as_float(b[i] << 16); o[8 + 2 * i + 1] = __uint_as_float(b[i] & 0xffff0000u); }
}
__device__ __forceinline__ void pack16(const float (&v)[16], u32x4& a, u32x4& b) {
#pragma unroll
    for (int i = 0; i < 4; ++i) { a[i] = cvtpk(v[2 * i], v[2 * i + 1]); b[i] = cvtpk(v[8 + 2 * i], v[8 + 2 * i + 1]); }
}
__device__ __forceinline__ int tr_off(int s, int seg) { return ((seg >> 1) * 4 + (s >> 4)) * 1024 + (s & 15) * 64 + (seg & 1) * 32; }

__device__ __forceinline__ void passA(const bf16* Kh, const bf16* LG, const bf16* Vh, bf16* Ufrag, float* Dbuf, LAS unsigned char* lds) {
    int tid_l = threadIdx.x; asm volatile("" : "+v"(tid_l));
    const int tid = tid_l, lane = tid & 63, wave = __builtin_amdgcn_readfirstlane(tid >> 6), t = tid >> 3, seg = tid & 7, hi = lane >> 5;
    LAS float* BL = (LAS float*)(lds + L_BM);
    for (int unit = blockIdx.x; unit < 4096; unit += gridDim.x) {
        const int bh = unit >> 8, c = unit & 255;
        const size_t ro = ((size_t)(bh >> 3) * SEQ + c * 64 + t) * 1024 + (bh & 7) * 128 + seg * 16;
        float b[16];
        { const u32x4 l0 = *(const u32x4*)(LG + ro), l1 = *(const u32x4*)(LG + ro + 8); unpack16(l0, l1, b); }
        const u32x4 k0 = *(const u32x4*)(Kh + ro), k1 = *(const u32x4*)(Kh + ro + 8), v0 = *(const u32x4*)(Vh + ro), v1 = *(const u32x4*)(Vh + ro + 8);
        chunk_cumsum(b, lane, wave, seg, lds);
        if (t == 63) {
#pragma unroll
            for (int i = 0; i < 16; ++i) { BL[seg * 16 + i] = b[i]; Dbuf[(size_t)unit * 128 + seg * 16 + i] = __expf(b[i]); }
        }
        __syncthreads();
        float kk[16]; unpack16(k0, k1, kk);
#pragma unroll
        for (int i = 0; i < 16; ++i) kk[i] *= __expf(BL[seg * 16 + i] - b[i]);
        u32x4 ka, kb_; pack16(kk, ka, kb_);
        const int to = tr_off(t, seg);
        *(LAS u32x4*)(lds + L_KT + to) = ka; *(LAS u32x4*)(lds + L_KT + to + 16) = kb_;
        *(LAS u32x4*)(lds + L_VT + to) = v0; *(LAS u32x4*)(lds + L_VT + to + 16) = v1;
        __syncthreads();
        const int db = wave >> 1, eb0 = (wave & 1) * 2;
        const int fo = ((lane >> 4) & 1) * 32 + (lane & 3) * 8 + (4 * hi + ((lane & 15) >> 2)) * 64;
        f32x16 u[2];
#pragma unroll
        for (int x = 0; x < 2; ++x)
#pragma unroll
            for (int r = 0; r < 16; ++r) u[x][r] = 0.f;
#pragma unroll
        for (int ks = 0; ks < 4; ++ks) {
            const LAS unsigned char* ap = lds + L_KT + (db * 4 + ks) * 1024 + fo;
            const s16x4 al = vtr(ap), ah = vtr(ap + 512);
            const bf16x8 af = (bf16x8){al[0], al[1], al[2], al[3], ah[0], ah[1], ah[2], ah[3]};
#pragma unroll
            for (int x = 0; x < 2; ++x) {
                const LAS unsigned char* bp = lds + L_VT + ((eb0 + x) * 4 + ks) * 1024 + fo;
                const s16x4 bl = vtr(bp), bhh = vtr(bp + 512);
                const bf16x8 bfr = (bf16x8){bl[0], bl[1], bl[2], bl[3], bhh[0], bhh[1], bhh[2], bhh[3]};
                u[x] = __builtin_amdgcn_mfma_f32_32x32x16_bf16(af, bfr, u[x], 0, 0, 0);
            }
        }
#pragma unroll
        for (int x = 0; x < 2; ++x) {
            u32x4 a, b2;
#pragma unroll
            for (int i = 0; i < 4; ++i) { a[i] = cvtpk(u[x][2 * i], u[x][2 * i + 1]); b2[i] = cvtpk(u[x][8 + 2 * i], u[x][8 + 2 * i + 1]); }
            bf16* up = Ufrag + (((size_t)unit * 16 + db * 4 + eb0 + x) * 64 + lane) * 16;
            *(u32x4*)up = a; *(u32x4*)(up + 8) = b2;
        }
        __syncthreads();
    }
}
__device__ __forceinline__ void passB(const bf16* Ufrag, const float* Dbuf, bf16* Sfrag) {
    int tid_l = threadIdx.x; asm volatile("" : "+v"(tid_l));
    const int tid = tid_l;
    if (tid >= 256) return;
    for (int i = blockIdx.x * 256 + tid; i < 65536; i += gridDim.x * 256) {
        const int seq = i >> 12, rem = i & 4095, tile = rem >> 8, lane = (rem >> 2) & 63, g = rem & 3;
        const int d0 = 32 * (tile >> 2) + 8 * g + 4 * (lane >> 5);
        const size_t eo = (((size_t)seq * 256 * 16 + tile) * 64 + lane) * 16 + 4 * g;
        const float* dp = Dbuf + (size_t)seq * 256 * 128 + d0;
        float s0 = 0.f, s1 = 0.f, s2 = 0.f, s3 = 0.f;
        for (int c0 = 0; c0 < 256; c0 += 8) {
            u32x2 uu[8]; f32x4 dd[8];
#pragma unroll
            for (int j = 0; j < 8; ++j) { uu[j] = *(const u32x2*)(Ufrag + eo + (size_t)(c0 + j) * 16384); dd[j] = *(const f32x4*)(dp + (size_t)(c0 + j) * 128); }
#pragma unroll
            for (int j = 0; j < 8; ++j) {
                u32x2 so; so[0] = cvtpk(s0, s1); so[1] = cvtpk(s2, s3);
                *(u32x2*)(Sfrag + eo + (size_t)(c0 + j) * 16384) = so;
                s0 = dd[j][0] * s0 + __uint_as_float(uu[j][0] << 16); s1 = dd[j][1] * s1 + __uint_as_float(uu[j][0] & 0xffff0000u);
                s2 = dd[j][2] * s2 + __uint_as_float(uu[j][1] << 16); s3 = dd[j][3] * s3 + __uint_as_float(uu[j][1] & 0xffff0000u);
            }
        }
    }
}
template <int PARTS = 7>
__device__ __forceinline__ void passC(const bf16* Qh, const bf16* Kh, const bf16* LG, const bf16* Vh, const bf16* Gh, const bf16* Sfrag, const float* ng, bf16* Oh, LAS unsigned char* lds) {
    int tid_l = threadIdx.x; asm volatile("" : "+v"(tid_l));
    const int tid = tid_l, lane = tid & 63, wave = __builtin_amdgcn_readfirstlane(tid >> 6), t = tid >> 3, seg = tid & 7, hi = lane >> 5, r32 = lane & 31;
    const int tb = wave >> 2, eb = wave & 3;
    LAS float* BM = (LAS float*)(lds + L_BM); LAS float* SSQ = (LAS float*)(lds + L_SSQ);
    const float ngl = ng[eb * 32 + r32];
    for (int unit = blockIdx.x; unit < 4096; unit += gridDim.x) {
        const int bh = unit >> 8, c = unit & 255;
        const size_t rb = ((size_t)(bh >> 3) * SEQ + c * 64) * 1024 + (bh & 7) * 128;
        const size_t ro = rb + (size_t)t * 1024 + seg * 16;
        float b[16];
        { const u32x4 l0 = *(const u32x4*)(LG + ro), l1 = *(const u32x4*)(LG + ro + 8); unpack16(l0, l1, b); }
        const u32x4 q0 = *(const u32x4*)(Qh + ro), q1 = *(const u32x4*)(Qh + ro + 8), k0 = *(const u32x4*)(Kh + ro), k1 = *(const u32x4*)(Kh + ro + 8);
        const u32x4 v0 = *(const u32x4*)(Vh + ro), v1 = *(const u32x4*)(Vh + ro + 8);
        u32x4 sf[4][2];
#pragma unroll
        for (int db = 0; db < 4; ++db) { const bf16* sp = Sfrag + (((size_t)unit * 16 + db * 4 + eb) * 64 + lane) * 16; sf[db][0] = *(const u32x4*)sp; sf[db][1] = *(const u32x4*)(sp + 8); }
        float gate[16];
#pragma unroll
        for (int r = 0; r < 16; ++r) gate[r] = bf2f(Gh[rb + (size_t)(32 * tb + crow(r, hi)) * 1024 + eb * 32 + r32]);
        chunk_cumsum(b, lane, wave, seg, lds);
        if (t == 31) {
#pragma unroll
            for (int i = 0; i < 16; ++i) BM[seg * 16 + i] = b[i];
        }
        __syncthreads();
        {
            float qq[16], kk[16], qt[16]; unpack16(q0, q1, qq); unpack16(k0, k1, kk);
#pragma unroll
            for (int i = 0; i < 16; ++i) { const float bm = BM[seg * 16 + i]; qt[i] = qq[i] * __expf(b[i]); qq[i] *= __expf(b[i] - bm); kk[i] *= __expf(bm - b[i]); }
            u32x4 a0, a1; pack16(qq, a0, a1);
            *(LAS u32x4*)(lds + L_QB + (seg * 2) * 1024 + t * 16) = a0; *(LAS u32x4*)(lds + L_QB + (seg * 2 + 1) * 1024 + t * 16) = a1;
            pack16(kk, a0, a1);
            *(LAS u32x4*)(lds + L_KB + (seg * 2) * 1024 + t * 16) = a0; *(LAS u32x4*)(lds + L_KB + (seg * 2 + 1) * 1024 + t * 16) = a1;
            pack16(qt, a0, a1);
            LAS unsigned char* qp = lds + L_QT + t * QT_PITCH + seg * 32;
            *(LAS u32x2*)(qp) = (u32x2){a0[0], a0[1]}; *(LAS u32x2*)(qp + 8) = (u32x2){a0[2], a0[3]}; *(LAS u32x2*)(qp + 16) = (u32x2){a1[0], a1[1]}; *(LAS u32x2*)(qp + 24) = (u32x2){a1[2], a1[3]};
            const int to = tr_off(t, seg);
            *(LAS u32x4*)(lds + L_VT + to) = v0; *(LAS u32x4*)(lds + L_VT + to + 16) = v1;
        }
        __syncthreads();
        if constexpr ((PARTS & 2) == 0) { if (b[0] == 12345.678f) Oh[rb] = 1; __syncthreads(); continue; }
        f32x16 p[2];
#pragma unroll
        for (int x = 0; x < 2; ++x)
#pragma unroll
            for (int r = 0; r < 16; ++r) p[x][r] = 0.f;
#pragma unroll
        for (int sb = 0; sb < 2; ++sb) {
            if (sb <= tb) {
#pragma unroll
                for (int d0 = 0; d0 < 8; ++d0) {
                    const bf16x8 ka = *(const LAS bf16x8*)(lds + L_KB + (2 * d0 + hi) * 1024 + (32 * sb + r32) * 16);
                    const bf16x8 qb_ = *(const LAS bf16x8*)(lds + L_QB + (2 * d0 + hi) * 1024 + (32 * tb + r32) * 16);
                    p[sb] = __builtin_amdgcn_mfma_f32_32x32x16_bf16(ka, qb_, p[sb], 0, 0, 0);
                }
            }
        }
        if (tb == 0) {
#pragma unroll
            for (int r = 0; r < 16; ++r) if (crow(r, hi) > r32) p[0][r] = 0.f;
        } else {
#pragma unroll
            for (int r = 0; r < 16; ++r) if (crow(r, hi) > r32) p[1][r] = 0.f;
        }
        u32x4 pw[4];
#pragma unroll
        for (int i = 0; i < 4; ++i) { pw[0][i] = cvtpk(p[0][2 * i], p[0][2 * i + 1]); pw[1][i] = cvtpk(p[0][8 + 2 * i], p[0][8 + 2 * i + 1]); pw[2][i] = cvtpk(p[1][2 * i], p[1][2 * i + 1]); pw[3][i] = cvtpk(p[1][8 + 2 * i], p[1][8 + 2 * i + 1]); }
        f32x16 o;
#pragma unroll
        for (int r = 0; r < 16; ++r) o[r] = 0.f;
        const int fo = ((lane >> 4) & 1) * 32 + (lane & 3) * 8 + (4 * hi + ((lane & 15) >> 2)) * 64;
#pragma unroll
        for (int ks = 0; ks < 4; ++ks) {
            if (ks < 2 * (tb + 1)) {
                const LAS unsigned char* bp = lds + L_VT + (eb * 4 + ks) * 1024 + fo;
                const s16x4 bl = vtr(bp), bhh = vtr(bp + 512);
                const bf16x8 vf = (bf16x8){bl[0], bl[1], bl[2], bl[3], bhh[0], bhh[1], bhh[2], bhh[3]};
                o = __builtin_amdgcn_mfma_f32_32x32x16_bf16(__builtin_bit_cast(bf16x8, pw[ks]), vf, o, 0, 0, 0);
            }
        }
#pragma unroll
        for (int s8 = 0; s8 < 8; ++s8) {
            const int db = s8 >> 1, half = s8 & 1;
            const LAS unsigned char* qp = lds + L_QT + (32 * tb + r32) * QT_PITCH + (32 * db + 16 * half + 4 * hi) * 2;
            const u32x2 lo = *(const LAS u32x2*)qp, hh = *(const LAS u32x2*)(qp + 16);
            const u32x4 af = (u32x4){lo[0], lo[1], hh[0], hh[1]};
            o = __builtin_amdgcn_mfma_f32_32x32x16_bf16(__builtin_bit_cast(bf16x8, af), __builtin_bit_cast(bf16x8, sf[db][half]), o, 0, 0, 0);
        }
        if constexpr ((PARTS & 4) == 0) { if (o[0] == 12345.678f) Oh[rb] = 1; __syncthreads(); continue; }
        float ssr[16];
#pragma unroll
        for (int r = 0; r < 16; ++r) { float s = o[r] * o[r]; s += __shfl_xor(s, 1); s += __shfl_xor(s, 2); s += __shfl_xor(s, 4); s += __shfl_xor(s, 8); s += __shfl_xor(s, 16); ssr[r] = s; }
        if (r32 == 0) {
#pragma unroll
            for (int r = 0; r < 16; ++r) SSQ[wave * 32 + crow(r, hi)] = ssr[r];
        }
        __syncthreads();
        bf16* op = Oh + rb + (size_t)(32 * tb) * 1024 + eb * 32 + r32;
#pragma unroll
        for (int r = 0; r < 16; ++r) {
            const int row = crow(r, hi);
            const float tot = SSQ[(tb * 4 + 0) * 32 + row] + SSQ[(tb * 4 + 1) * 32 + row] + SSQ[(tb * 4 + 2) * 32 + row] + SSQ[(tb * 4 + 3) * 32 + row];
            const float rstd = __builtin_amdgcn_rsqf(tot * (1.f / 128.f) + LN_EPS);
            op[(size_t)row * 1024] = (bf16)f2bf(o[r] * rstd * ngl * gate[r]);
        }
        __syncthreads();
    }
}
}


#define XB_TMO      128
#define XB_XCNT(j)  (256  + 64 * (j))
#define XB_XSUB(j)  (1280 + 64 * (j))
#define XB_XGEN(j)  (2304 + 64 * (j))
#define XB_TOP      3328
#define XB_TOPGEN   3392
#define XCD_BAR_WORDS 3456
#define XB_SPIN_CAP (1u << 18)

__device__ __forceinline__ unsigned xb_ld(unsigned* p)              { return __hip_atomic_load(p, __ATOMIC_RELAXED, __HIP_MEMORY_SCOPE_AGENT); }
__device__ __forceinline__ unsigned xb_add(unsigned* p, unsigned v) { return __hip_atomic_fetch_add(p, v, __ATOMIC_RELAXED, __HIP_MEMORY_SCOPE_AGENT); }
__device__ __forceinline__ unsigned xb_xcc_id() { return (unsigned)__builtin_amdgcn_s_getreg((3 << 11) | 20) & 0xFu; }
#define XB_SPIN(cond, bar) do { unsigned _sp = 0; while (cond) { __builtin_amdgcn_s_sleep(1); \
    if ((++_sp & 255u) == 0u) { if (xb_ld(&(bar)[XB_TMO])) break; if (_sp > XB_SPIN_CAP) { atomicAdd(&(bar)[XB_TMO], 1u); break; } } } } while (0)

struct XcdBarrier {
    unsigned* bar; unsigned x;
    volatile LAS unsigned* st;
};

__device__ __forceinline__ XcdBarrier xcd_barrier_post(unsigned* bar, volatile LAS unsigned* st) {
    XcdBarrier b; b.bar = bar; b.x = xb_xcc_id(); b.st = st;
    if (threadIdx.x == 0) (void)xb_add(&bar[XB_XCNT(b.x)], 1u);
    return b;
}
__device__ __forceinline__ void xcd_barrier_complete(unsigned* bar, unsigned x, unsigned& nloc, unsigned& nx) {
    const unsigned G = gridDim.x * gridDim.y * gridDim.z;
    unsigned sum, cnt, mine, sp = 0u;
    for (;;) {
        sum = 0u; cnt = 0u; mine = 0u;
#pragma unroll
        for (unsigned j = 0; j < 16; ++j) { const unsigned c = xb_ld(&bar[XB_XCNT(j)]); sum += c; cnt += (c > 0u) ? 1u : 0u; mine = (j == x) ? c : mine; }
        if (sum == G) break;
        __builtin_amdgcn_s_sleep(1);
        if ((++sp & 255u) == 0u) { if (xb_ld(&bar[XB_TMO])) break; if (sp > XB_SPIN_CAP) { atomicAdd(&bar[XB_TMO], 1u); break; } }
    }
    nloc = mine > 0u ? mine : 1u; nx = cnt > 0u ? cnt : 1u;
}

__device__ __forceinline__ void xcd_barrier(const XcdBarrier& b) {
    asm volatile("s_waitcnt vmcnt(0)" ::: "memory");
    __syncthreads();
    if (threadIdx.x == 0) {
        unsigned* bar = b.bar;
        __builtin_amdgcn_s_waitcnt(0);
        unsigned nloc = b.st[0], nx = b.st[1];
        if (nloc == 0u) { xcd_barrier_complete(bar, b.x, nloc, nx); b.st[0] = nloc; b.st[1] = nx; }
        const unsigned old = xb_add(&bar[XB_XSUB(b.x)], 1u);
        const unsigned gen = old / nloc;
        if (old + 1u == (gen + 1u) * nloc) {
            __builtin_amdgcn_fence(__ATOMIC_RELEASE, "agent");
            asm volatile("s_waitcnt vmcnt(0)" ::: "memory");
            const unsigned og = xb_add(&bar[XB_TOP], 1u);
            const unsigned tg = og / nx;
            if (og + 1u == (tg + 1u) * nx) xb_add(&bar[XB_TOPGEN], 1u);
            else XB_SPIN(xb_ld(&bar[XB_TOPGEN]) == tg, bar);
            __builtin_amdgcn_fence(__ATOMIC_ACQUIRE, "agent");
            xb_add(&bar[XB_XGEN(b.x)], 1u);
            asm volatile("s_waitcnt vmcnt(0)" ::: "memory");
        } else {
            XB_SPIN(xb_ld(&bar[XB_XGEN(b.x)]) == gen, bar);
            __builtin_amdgcn_fence(__ATOMIC_ACQUIRE, "agent");
            asm volatile("s_waitcnt vmcnt(0)" ::: "memory");
        }
    }
    __syncthreads();
}

constexpr int BAR_LDS_OFF = LDS_BYTES - 64;
constexpr int CTL_BAR = 4096;

#ifndef HGC_PROBE_PARTS
#define HGC_PROBE_PARTS 7
#endif
#ifndef PROBE_MASK
#define PROBE_MASK 0
#endif
#define PROBE_REP(bit) for (int rep_ = 0; rep_ < (((PROBE_MASK) & (bit)) ? 2 : 1); ++rep_)
struct Params { Inputs in; WS w; float* X; };
typedef const __attribute__((address_space(4))) Params CParams;
template <int MODE>
__device__ __forceinline__ void mv_probe(int* ctl, int lane) {
    v8i_ A, B;
#pragma unroll
    for (int w = 0; w < 8; ++w) { A[w] = 0x30303030 + (lane & 7) * 0x01010101; B[w] = 0x31313131 + (lane & 3) * 0x01010101; }
    v16f_ acc[4];
#pragma unroll
    for (int d = 0; d < 4; ++d)
#pragma unroll
        for (int r = 0; r < 16; ++r) acc[d][r] = 0.f;
    float x[8];
#pragma unroll
    for (int i = 0; i < 8; ++i) x[i] = -(float)(lane + i) * 0.01f;
    float s = 0.f;
#pragma unroll 1
    for (int it = 0; it < 2048; ++it) {
#pragma unroll
        for (int d = 0; d < 4; ++d) {
            if constexpr ((MODE & 1) != 0) { acc[d] = __builtin_amdgcn_mfma_scale_f32_32x32x64_f8f6f4(A, B, acc[d], 0, 0, 0, 0x7F7F7F7F, 0, 0x7F7F7F7F); __builtin_amdgcn_sched_barrier(0); }
            if constexpr ((MODE & 2) != 0) {
                asm volatile("" : "+v"(x[0]), "+v"(x[1]), "+v"(x[2]), "+v"(x[3]), "+v"(x[4]), "+v"(x[5]), "+v"(x[6]), "+v"(x[7]));
                float e[8];
#pragma unroll
                for (int i = 0; i < 8; ++i) { e[i] = __builtin_amdgcn_exp2f(x[i]); s += e[i]; }
                asm volatile("" : "+v"(e[0]), "+v"(e[1]), "+v"(e[2]), "+v"(e[3]), "+v"(e[4]), "+v"(e[5]), "+v"(e[6]), "+v"(e[7]), "+v"(s));
                __builtin_amdgcn_sched_barrier(0);
            }
        }
    }
    float t = s;
#pragma unroll
    for (int d = 0; d < 4; ++d)
#pragma unroll
        for (int r = 0; r < 16; ++r) t += acc[d][r];
    if (t == 12345.678f) ctl[CTL_POISON + 8] = 1;
}
#define KP() ({ CParams* kp_ = (CParams*)__builtin_amdgcn_kernarg_segment_ptr(); asm volatile("" : "+s"(kp_)); kp_; })

__global__ void __launch_bounds__(NTHREADS, 2) k_fwd(Params unused_by_name) {
#if defined(__HIP_DEVICE_COMPILE__)
    extern __shared__ __attribute__((aligned(16))) unsigned char lds_raw[];
    LAS unsigned char* lds = (LAS unsigned char*)lds_raw;
    const int tid = threadIdx.x;
    volatile LAS unsigned* bst = (volatile LAS unsigned*)(lds + BAR_LDS_OFF);
    if (tid == 0) { bst[0] = 0u; bst[1] = 0u; }
    __syncthreads();
    (void)xcd_barrier_post((unsigned*)(KP()->w.ctl + CTL_BAR), bst);
#define GRID_BAR() do { XcdBarrier b_; b_.bar = (unsigned*)(KP()->w.ctl + CTL_BAR); b_.x = xb_xcc_id(); b_.st = bst; xcd_barrier(b_); } while (0)
    if constexpr (((PROBE_MASK) & 2048) != 0) { mv_probe<((PROBE_MASK) >> 12) & 3>(KP()->w.ctl, tid & 63); }
    PROBE_REP(256) { CParams* kp = KP(); const Inputs in = kp->in; const WS w = kp->w; prologue_phase(in, w, kp->X, lds); }
    GRID_BAR();
#pragma unroll 1
    for (int layer = 0; layer < DEPTH; ++layer) {
        const int j = layer >> 1;
        if ((layer & 1) == 0) {
            {
                CParams* kp = KP();
                pg8::Gemm g{kp->w.Xb, kp->w.Wqkv_t + (size_t)j * 3072 * D, T, 2048, D}; pg8::StaticOrder S; S.init(T, 2048, gridDim.x, blockIdx.x);
                pg8::EpiQK8 E{(unsigned char*)kp->w.Qb, kp->w.rot};
                pg8::gemm_phase<pg8::EpiQK8, pg8::StaticOrder, true, true>(lds, g, S, E);
            }
            {
                CParams* kp = KP();
                pg8::Gemm g{kp->w.Wqkv_t + (size_t)j * 3072 * D + (size_t)2048 * D, kp->w.Xb, D, T, D}; pg8::StaticOrder S; S.init(D, T, gridDim.x, blockIdx.x);
                pg8::EpiVT E{(unsigned char*)kp->w.Vb};
                pg8::gemm_phase<pg8::EpiVT, pg8::StaticOrder, true, true>(lds, g, S, E);
            }
            GRID_BAR();
#ifdef ATT_PROBE_VAR
            {
                CParams* kp = KP();
                attn::attn_phase<ATT_PROBE_VAR>((const unsigned char*)kp->w.Qb, (const unsigned char*)kp->w.Qb + (size_t)T * 1024, (const unsigned char*)kp->w.Vb, (bf16*)kp->w.V32, kp->w.lbtab[2048 + j], kp->in.p[4] + (size_t)j * 128, 1.f, lds);
            }
            GRID_BAR();
#endif
            PROBE_REP(1) {
                CParams* kp = KP();
                attn::attn_phase((const unsigned char*)kp->w.Qb, (const unsigned char*)kp->w.Qb + (size_t)T * 1024, (const unsigned char*)kp->w.Vb, kp->w.Ob, kp->w.lbtab[2048 + j], kp->in.p[4] + (size_t)j * 128, 1.f - (0.8f - 0.6f * __expf(-0.3f * (float)layer)), lds);
            }
            GRID_BAR();
        } else {
            PROBE_REP(8) {
                CParams* kp = KP();
                pg8::Gemm g{kp->w.Xb, kp->w.Hin_t + (size_t)j * 4096 * D, T, 4096, D}; pg8::StaticOrder S; S.init(T, 4096, gridDim.x, blockIdx.x);
                pg8::EpiHin E{kp->w.Qb, (bf16*)kp->w.LG, kp->w.lbtab + j * 1024};
                pg8::gemm_phase<pg8::EpiHin, pg8::StaticOrder, true, true>(lds, g, S, E);
            }
            GRID_BAR();
            PROBE_REP(16) { CParams* kp = KP(); hgrn::passA(kp->w.Kb, (const bf16*)kp->w.LG, kp->w.Vb, kp->w.Uf, kp->w.Dbuf, lds); }
            GRID_BAR();
            PROBE_REP(16) { CParams* kp = KP(); hgrn::passB(kp->w.Uf, kp->w.Dbuf, kp->w.Sf); }
            GRID_BAR();
            if constexpr (((PROBE_MASK) & 4096) != 0) { CParams* kp = KP(); hgrn::passC<HGC_PROBE_PARTS>(kp->w.Qb, kp->w.Kb, (const bf16*)kp->w.LG, kp->w.Vb, kp->w.Gb, kp->w.Sf, kp->in.p[8] + (size_t)j * 128, (bf16*)kp->w.V32, lds); GRID_BAR(); }
            PROBE_REP(16) { CParams* kp = KP(); hgrn::passC(kp->w.Qb, kp->w.Kb, (const bf16*)kp->w.LG, kp->w.Vb, kp->w.Gb, kp->w.Sf, kp->in.p[8] + (size_t)j * 128, kp->w.Ob, lds); }
            GRID_BAR();
        }
        PROBE_REP(4) {
            CParams* kp = KP();
            const bf16* Wt = ((layer & 1) == 0) ? kp->w.Wo_t + (size_t)j * D * D : kp->w.Hout_t + (size_t)j * D * D;
            pg8::Gemm g{kp->w.Ob, Wt, T, D, D}; pg8::StaticOrder S; S.init(T, D, gridDim.x, blockIdx.x);
            pg8::EpiRes E{kp->w.Xb, kp->w.V32};
            pg8::gemm_phase<pg8::EpiRes, pg8::StaticOrder, true, true>(lds, g, S, E);
        }
        GRID_BAR();
        if constexpr (((PROBE_MASK) & 32) != 0) {
            CParams* kp = KP();
            lnroute_phase(kp->w.V32, kp->X, kp->w.Xb, kp->in.p[15] + (size_t)(layer * 2) * D, kp->in.p[16] + (size_t)(layer * 2) * D, (const bf16*)kp->w.Wr_t + (size_t)layer * 2 * NE * D,
                          kp->in.p[10] + (size_t)layer * NE, kp->w.ctl + CNT_BASE + (4 + layer) * 64 * CNT_STRIDE, (int*)kp->w.H1, (float*)((char*)kp->w.H1 + (16u << 20)), (int*)((char*)kp->w.H1 + (32u << 20)), lds);
            GRID_BAR();
        }
        {
            CParams* kp = KP();
            lnroute_phase(kp->w.V32, kp->X, kp->w.Xb, kp->in.p[15] + (size_t)(layer * 2) * D, kp->in.p[16] + (size_t)(layer * 2) * D, (const bf16*)kp->w.Wr_t + (size_t)layer * 2 * NE * D,
                          kp->in.p[10] + (size_t)layer * NE, kp->w.ctl + CNT_BASE + layer * 64 * CNT_STRIDE, kp->w.rowlist, kp->w.tok_w, kp->w.tok_es, lds);
        }
        GRID_BAR();
        const pg8::MoeTabs tb = moe_tables(KP()->w.ctl + CNT_BASE + layer * 64 * CNT_STRIDE, lds, tid);
        PROBE_REP(64) {
            CParams* kp = KP();
            pg8::Gemm g{kp->w.Xb, kp->w.Wgu_t + (size_t)layer * 65 * 512 * D, 0, 0, D};
            pg8::MoeOrder<2> S{tb, (int)gridDim.x, (int)blockIdx.x, kp->w.rowlist};
            pg8::EpiSwiglu E{kp->w.H1};
            pg8::gemm_phase_g<pg8::EpiSwiglu, pg8::MoeOrder<2>, true, true>(lds, g, S, E);
        }
        GRID_BAR();
        PROBE_REP(128) {
            CParams* kp = KP();
            int kdim = 256; asm volatile("" : "+s"(kdim));
            pg8::Gemm g{kp->w.H1, kp->w.Wd_t + (size_t)layer * 65 * D * 256, 0, 0, kdim};
            pg8::MoeOrder<4> S{tb, (int)gridDim.x, (int)blockIdx.x, kp->w.rowlist};
            pg8::EpiDown E{(unsigned char*)kp->w.Y};
            pg8::gemm_phase<pg8::EpiDown, pg8::MoeOrder<4>, true, true>(lds, g, S, E);
        }
        GRID_BAR();
        if ((PROBE_MASK) & 1024) { CParams* kp = KP(); combine_phase((const unsigned char*)kp->w.Y, kp->w.tok_es, kp->w.tok_w, tb, kp->w.Xb, kp->w.V32, kp->w.Qb, kp->in.p[15], kp->in.p[16], kp->w.ctl + CTL_POISON); GRID_BAR(); }
        { CParams* kp = KP(); combine_phase((const unsigned char*)kp->w.Y, kp->w.tok_es, kp->w.tok_w, tb, kp->w.Xb, (layer + 1 < DEPTH) ? (float*)nullptr : kp->X, kp->w.Xb, kp->in.p[15] + (size_t)(layer * 2 + 1) * D, kp->in.p[16] + (size_t)(layer * 2 + 1) * D, kp->w.ctl + CTL_POISON); }
        if (layer + 1 < DEPTH) GRID_BAR();
    }
#endif
}
}

extern "C" void kernel_launch(void* const* d_in, const int* in_sizes, int n_in, void* d_out, int out_size, void* d_ws, size_t ws_size, hipStream_t stream) {
    Inputs in{}; for (int i = 0; i < 17; ++i) in.p[i] = (const float*)d_in[i];
    float* X = (float*)d_out;
    char* ws = (char*)d_ws; size_t o = 0;
    auto carve = [&](size_t bytes) { char* p = ws + o; o += (bytes + 255) & ~(size_t)255; return p; };
    WS w{};
    w.ctl = (int*)carve(1 << 20);
    w.Wqkv_t = (bf16*)carve((size_t)2 * 3072 * D * 2); w.Wo_t = (bf16*)carve((size_t)2 * D * D * 2);
    w.Hin_t = (bf16*)carve((size_t)2 * 4096 * D * 2); w.Hout_t = (bf16*)carve((size_t)2 * D * D * 2);
    w.rot = (float*)carve((size_t)SEQ * 16 * 4); w.lbtab = (float*)carve(4 * 1024 * 4);
    w.V32 = (float*)carve((size_t)T * D * 4);
    w.Xb = (bf16*)carve((size_t)T * D * 2); w.Qb = (bf16*)carve((size_t)T * D * 2); w.Kb = (bf16*)carve((size_t)T * D * 2);
    w.Vb = (bf16*)carve((size_t)T * D * 2); w.Gb = (bf16*)carve((size_t)T * D * 2); w.Ob = (bf16*)carve((size_t)T * D * 2);
    w.LG = (float*)carve((size_t)T * D * 4); w.Dbuf = (float*)carve((size_t)4096 * 128 * 4);
    w.Wgu_t = (bf16*)carve((size_t)DEPTH * 65 * 512 * D * 2); w.Wd_t = (bf16*)carve((size_t)DEPTH * 65 * D * 256 * 2);
    w.Wr_t = (float*)carve((size_t)DEPTH * NE * D * 4);
    w.H1 = (bf16*)carve((size_t)NROWS * 256 * 2); w.Y = (bf16*)carve((size_t)NROWS * 1024 * 2);
    w.Uf = w.Y; w.Sf = w.Y + (size_t)4096 * 16384;
    w.rowlist = (int*)carve((size_t)(NE + 1) * T * 4); w.tok_w = (float*)carve((size_t)T * 8 * 4); w.tok_es = (int*)carve((size_t)T * 8 * 4);
    if (o > ws_size || n_in != 17) { fprintf(stderr, "kernel_launch: workspace too small (need %zu, have %zu) or n_in %d != 17; nothing launched\n", o, ws_size, n_in); return; }
    static int grid = 0;
    if (grid == 0) {
        int dev = 0, cus = 0;
        if (hipGetDevice(&dev) != hipSuccess || hipDeviceGetAttribute(&cus, hipDeviceAttributeMultiprocessorCount, dev) != hipSuccess) { grid = -1; return; }
        if (hipFuncSetAttribute((const void*)k_fwd, hipFuncAttributeMaxDynamicSharedMemorySize, LDS_BYTES) != hipSuccess) { fprintf(stderr, "kernel_launch: hipFuncSetAttribute failed\n"); grid = -1; return; }
        int per_cu = 0;
        if (hipOccupancyMaxActiveBlocksPerMultiprocessor(&per_cu, (const void*)k_fwd, NTHREADS, LDS_BYTES) != hipSuccess || per_cu < 1) { fprintf(stderr, "kernel_launch: occupancy query says %d blocks per CU\n", per_cu); }
        (void)hipGetLastError();
        grid = cus < 256 ? cus : 256;
    }
    if (grid < 0) return;
    (void)hipMemsetAsync(w.ctl, 0, 1 << 20, stream);
    Params prm{}; prm.in = in; prm.w = w; prm.X = X;
    hipLaunchKernelGGL(k_fwd, dim3(grid), dim3(NTHREADS), LDS_BYTES, stream, prm);
}
```

```cpp
#include <hip/hip_runtime.h>
#include <stdint.h>
#include <stdio.h>
#include <math.h>

namespace cfg {
constexpr int D = 1024, NB = 2, SEQ = 16384, T = NB * SEQ, DEPTH = 4;
constexpr int NE = 64, TOPK = 8, EFF = 256;
constexpr int NPAD = T * TOPK + NE * 256;
constexpr float ALPHA = 1.6817928305074290f;
constexpr float LN_EPS = 1e-5f;
constexpr float ROUTED_SCALE = 2.5f;
constexpr float C2 = 0.125f * 1.4426950408889634f;
}
using namespace cfg;

namespace pg8 {
#define PG8_LAS __attribute__((address_space(3)))
typedef unsigned short bf16_t;
typedef short bf16x8 __attribute__((ext_vector_type(8)));
typedef float f32x4 __attribute__((ext_vector_type(4)));
typedef unsigned u32x4 __attribute__((ext_vector_type(4)));
constexpr int BM = 256, BK = 64, HALF = 128, HTB = HALF * BK * 2  , STAGE_BYTES = 8 * HTB, NXCD = 8, WGM = 8;

__host__ __device__ __forceinline__ int lds_byte(int r, int c) { const int st = (r >> 4) * 2 + (c >> 5), rr = r & 15, cc = c & 31, ob = rr * 64 + cc * 2; return st * 1024 + (ob ^ (((ob >> 9) & 1) << 5)); }
__host__ __device__ __forceinline__ void stage_rc(int b, int& R, int& C) { const int st = b / 1024, sb = b % 1024, swz = sb ^ (((sb >> 9) & 1) << 5); R = (st >> 1) * 16 + swz / 64; C = (st & 1) * 32 + (swz % 64) / 2; }
__host__ __device__ __forceinline__ int perm32(int rho) { const int n = rho >> 4, i = rho & 15; return 8 * (i >> 2) + 4 * n + (i & 3); }

struct Unit { int pm, pn, aux, e; };
struct Gemm { const bf16_t* A; const bf16_t* Bt; int M, N, K; };

struct StaticOrder {
    int nM, nN, nwg, G, c;
    __host__ __device__ void init(int M, int N, int G_, int c_) { nM = M / BM; nN = N / BM; nwg = nM * nN; G = G_; c = c_; }
    __host__ __device__ bool next(int i, Unit& u) const {
        const long L = (long)i * G + c; if (L >= nwg) return false;
        int wgid = (int)L; { const int q = nwg / NXCD, r = nwg % NXCD, xcd = wgid % NXCD, off = wgid / NXCD; wgid = (xcd < r ? xcd * (q + 1) : r * (q + 1) + (xcd - r) * q) + off; }
        const int nig = WGM * nN, gid = wgid / nig, fm = gid * WGM, gsz = (nM - fm) < WGM ? (nM - fm) : WGM;
        u.pm = fm + ((wgid % nig) % gsz); u.pn = (wgid % nig) / gsz; return true;
    }
    __device__ __forceinline__ void a_ready(const Unit&) const {}
    __device__ __forceinline__ void done(const Unit&) const {}
};


__device__ __forceinline__ unsigned cvt_pk_bf16(float lo, float hi) { unsigned r; asm volatile("v_cvt_pk_bf16_f32 %0, %1, %2" : "=v"(r) : "v"(lo), "v"(hi)); return r; }
__device__ __forceinline__ float sigm(float x) { return __builtin_amdgcn_rcpf(1.f + __expf(-x)); }

struct EpiQKV {
    static constexpr bool PERM = true, AFTER_DRAIN = false;
    bf16_t* QKV; const float* rot;
    __device__ __forceinline__ void operator()(const f32x4 (&acc)[2][2][4][2], const Unit& u, int wr, int wc, int fr, int fq) const {
        const int sec = u.pn >> 2;
        bf16_t* base = QKV + (size_t)sec * ((size_t)cfg::T * 1024);
        const float sc = sec == 0 ? cfg::C2 : 1.f;
        const bool rotl = (sec < 2) && ((wc & 1) == 0) && (fq < 2);
        const int col0 = (u.pn & 3) * 256 + wc * 32 + 8 * fq;
#pragma unroll
        for (int ai = 0; ai < 2; ++ai)
#pragma unroll
            for (int m = 0; m < 4; ++m) {
                const int row = u.pm * BM + ai * HALF + wr * 64 + m * 16 + fr;
                f32x4 t0 = (f32x4){1.f, 0.f, 1.f, 0.f}, t1 = (f32x4){1.f, 0.f, 1.f, 0.f};
                if (rotl) { const f32x4* rp = (const f32x4*)(rot + ((size_t)(row & (cfg::SEQ - 1)) * 8 + 4 * fq) * 2); t0 = rp[0]; t1 = rp[1]; }
#pragma unroll
                for (int bj = 0; bj < 2; ++bj) {
                    const f32x4 v0 = acc[ai][bj][m][0], v1 = acc[ai][bj][m][1];
                    f32x4 r0, r1;
                    r0[0] = v0[0] * t0[0] - v0[1] * t0[1]; r0[1] = v0[1] * t0[0] + v0[0] * t0[1];
                    r0[2] = v0[2] * t0[2] - v0[3] * t0[3]; r0[3] = v0[3] * t0[2] + v0[2] * t0[3];
                    r1[0] = v1[0] * t1[0] - v1[1] * t1[1]; r1[1] = v1[1] * t1[0] + v1[0] * t1[1];
                    r1[2] = v1[2] * t1[2] - v1[3] * t1[3]; r1[3] = v1[3] * t1[2] + v1[2] * t1[3];
                    r0 = r0 * sc; r1 = r1 * sc;
                    u32x4 w; w.x = cvt_pk_bf16(r0[0], r0[1]); w.y = cvt_pk_bf16(r0[2], r0[3]); w.z = cvt_pk_bf16(r1[0], r1[1]); w.w = cvt_pk_bf16(r1[2], r1[3]);
                    *(u32x4*)(base + (size_t)row * 1024 + col0 + bj * HALF) = w;
                }
                asm volatile("" ::: "memory");
            }
    }
};
struct EpiQK8 {
    static constexpr bool PERM = true, AFTER_DRAIN = false;
    unsigned char* QK; const float* rot;
    __device__ __forceinline__ void operator()(const f32x4 (&acc)[2][2][4][2], const Unit& u, int wr, int wc, int fr, int fq) const {
        const int sec = u.pn >> 2;
        unsigned char* base = QK + (size_t)sec * ((size_t)cfg::T * 1024);
        const float sc = sec == 0 ? cfg::C2 * 4.f : 0.25f;
        const bool rotl = ((wc & 1) == 0) && (fq < 2);
        const int col0 = (u.pn & 3) * 256 + wc * 32 + 8 * fq;
        typedef unsigned u32x2_ __attribute__((ext_vector_type(2)));
#pragma unroll
        for (int ai = 0; ai < 2; ++ai)
#pragma unroll
            for (int m = 0; m < 4; ++m) {
                const int row = u.pm * BM + ai * HALF + wr * 64 + m * 16 + fr;
                f32x4 t0 = (f32x4){1.f, 0.f, 1.f, 0.f}, t1 = (f32x4){1.f, 0.f, 1.f, 0.f};
                if (rotl) { const f32x4* rp = (const f32x4*)(rot + ((size_t)(row & (cfg::SEQ - 1)) * 8 + 4 * fq) * 2); t0 = rp[0]; t1 = rp[1]; }
#pragma unroll
                for (int bj = 0; bj < 2; ++bj) {
                    const f32x4 v0 = acc[ai][bj][m][0], v1 = acc[ai][bj][m][1];
                    f32x4 r0, r1;
                    r0[0] = v0[0] * t0[0] - v0[1] * t0[1]; r0[1] = v0[1] * t0[0] + v0[0] * t0[1];
                    r0[2] = v0[2] * t0[2] - v0[3] * t0[3]; r0[3] = v0[3] * t0[2] + v0[2] * t0[3];
                    r1[0] = v1[0] * t1[0] - v1[1] * t1[1]; r1[1] = v1[1] * t1[0] + v1[0] * t1[1];
                    r1[2] = v1[2] * t1[2] - v1[3] * t1[3]; r1[3] = v1[3] * t1[2] + v1[2] * t1[3];
                    r0 = r0 * sc; r1 = r1 * sc;
#pragma unroll
                    for (int i = 0; i < 4; ++i) { r0[i] = __builtin_amdgcn_fmed3f(r0[i], -448.f, 448.f); r1[i] = __builtin_amdgcn_fmed3f(r1[i], -448.f, 448.f); }
                    int w0 = 0, w1 = 0;
                    w0 = __builtin_amdgcn_cvt_pk_fp8_f32(r0[0], r0[1], w0, false); w0 = __builtin_amdgcn_cvt_pk_fp8_f32(r0[2], r0[3], w0, true);
                    w1 = __builtin_amdgcn_cvt_pk_fp8_f32(r1[0], r1[1], w1, false); w1 = __builtin_amdgcn_cvt_pk_fp8_f32(r1[2], r1[3], w1, true);
                    *(u32x2_*)(base + (size_t)row * 1024 + col0 + bj * HALF) = (u32x2_){(unsigned)w0, (unsigned)w1};
                }
                asm volatile("" ::: "memory");
            }
    }
};
struct EpiVT {
    static constexpr bool PERM = true, AFTER_DRAIN = false;
    unsigned char* VT;
    __device__ __forceinline__ void operator()(const f32x4 (&acc)[2][2][4][2], const Unit& u, int wr, int wc, int fr, int fq) const {
#pragma unroll
        for (int ai = 0; ai < 2; ++ai)
#pragma unroll
            for (int m = 0; m < 4; ++m) {
                const int eg = u.pm * BM + ai * HALF + wr * 64 + m * 16 + fr, hh = eg >> 7, e = eg & 127, sw = (e >> 2) & 3;
#pragma unroll
                for (int bj = 0; bj < 2; ++bj) {
                    const int tok = u.pn * BM + bj * HALF + wc * 32 + 8 * fq, b = tok >> 14, sq = tok & (cfg::SEQ - 1), tile = sq >> 6, g = (sq & 63) >> 3;
                    unsigned char* blk = VT + ((size_t)((b * 8 + hh) * 256 + tile)) * 8192 + e * 64;
                    f32x4 v0 = acc[ai][bj][m][0] * 16.f, v1 = acc[ai][bj][m][1] * 16.f;
#pragma unroll
                    for (int i = 0; i < 4; ++i) { v0[i] = __builtin_amdgcn_fmed3f(v0[i], -448.f, 448.f); v1[i] = __builtin_amdgcn_fmed3f(v1[i], -448.f, 448.f); }
                    int w0 = 0, w1 = 0;
                    w0 = __builtin_amdgcn_cvt_pk_fp8_f32(v0[0], v0[1], w0, false); w0 = __builtin_amdgcn_cvt_pk_fp8_f32(v0[2], v0[3], w0, true);
                    w1 = __builtin_amdgcn_cvt_pk_fp8_f32(v1[0], v1[1], w1, false); w1 = __builtin_amdgcn_cvt_pk_fp8_f32(v1[2], v1[3], w1, true);
                    const int p0 = 4 * g, p1 = 32 + 4 * g;
                    *(unsigned*)(blk + (((p0 >> 4) ^ sw) << 4) + (p0 & 15)) = (unsigned)w0;
                    *(unsigned*)(blk + (((p1 >> 4) ^ sw) << 4) + (p1 & 15)) = (unsigned)w1;
                }
            }
    }
};
struct EpiRes {
    static constexpr bool PERM = true, AFTER_DRAIN = false;
    const bf16_t* X; bf16_t* Vout;
    __device__ __forceinline__ void operator()(const f32x4 (&acc)[2][2][4][2], const Unit& u, int wr, int wc, int fr, int fq) const {
        const int col0 = u.pn * BM + wc * 32 + 8 * fq;
#pragma unroll
        for (int ai = 0; ai < 2; ++ai)
#pragma unroll
            for (int m = 0; m < 4; ++m) {
                const size_t ro = (size_t)(u.pm * BM + ai * HALF + wr * 64 + m * 16 + fr) * 1024 + col0;
#pragma unroll
                for (int bj = 0; bj < 2; ++bj) { const size_t off = ro + bj * HALF; const u32x4 xb = *(const u32x4*)(X + off);
                    const f32x4 x0 = (f32x4){__builtin_bit_cast(float, xb[0] << 16), __builtin_bit_cast(float, xb[0] & 0xffff0000u), __builtin_bit_cast(float, xb[1] << 16), __builtin_bit_cast(float, xb[1] & 0xffff0000u)};
                    const f32x4 x1 = (f32x4){__builtin_bit_cast(float, xb[2] << 16), __builtin_bit_cast(float, xb[2] & 0xffff0000u), __builtin_bit_cast(float, xb[3] << 16), __builtin_bit_cast(float, xb[3] & 0xffff0000u)};
                    const f32x4 v0 = x0 * cfg::ALPHA + acc[ai][bj][m][0], v1 = x1 * cfg::ALPHA + acc[ai][bj][m][1];
                    u32x4 w; w.x = cvt_pk_bf16(v0[0], v0[1]); w.y = cvt_pk_bf16(v0[2], v0[3]); w.z = cvt_pk_bf16(v1[0], v1[1]); w.w = cvt_pk_bf16(v1[2], v1[3]);
                    *(u32x4*)(Vout + off) = w; }
            }
    }
};
struct EpiHin {
    static constexpr bool PERM = true, AFTER_DRAIN = false;
    bf16_t* QKVG; bf16_t* LG; const float* lbtab;
    __device__ __forceinline__ void operator()(const f32x4 (&acc)[2][2][4][2], const Unit& u, int wr, int wc, int fr, int fq) const {
        const int sec = u.pn >> 2;
        const int col0 = (u.pn & 3) * 256 + wc * 32 + 8 * fq;
        bf16_t* base = QKVG + (size_t)sec * ((size_t)cfg::T * 1024);
#pragma unroll
        for (int ai = 0; ai < 2; ++ai)
#pragma unroll
            for (int m = 0; m < 4; ++m) {
                const size_t ro = (size_t)(u.pm * BM + ai * HALF + wr * 64 + m * 16 + fr) * 1024 + col0;
#pragma unroll
                for (int bj = 0; bj < 2; ++bj) {
                    f32x4 v0 = acc[ai][bj][m][0], v1 = acc[ai][bj][m][1];
                    if (sec == 0 || sec == 3) {
#pragma unroll
                        for (int i = 0; i < 4; ++i) { v0[i] = v0[i] * sigm(v0[i]); v1[i] = v1[i] * sigm(v1[i]); }
                    } else if (sec == 1) {
                        const f32x4 l0 = *(const f32x4*)(lbtab + col0 + bj * HALF), l1 = *(const f32x4*)(lbtab + col0 + bj * HALF + 4);
                        f32x4 g0, g1;
#pragma unroll
                        for (int i = 0; i < 4; ++i) {
                            const float s0 = sigm(v0[i]), os0 = 1.f - s0, s1 = sigm(v1[i]), os1 = 1.f - s1;
                            g0[i] = __logf(l0[i] + (1.f - l0[i]) * s0); v0[i] = (1.f - l0[i]) * os0;
                            g1[i] = __logf(l1[i] + (1.f - l1[i]) * s1); v1[i] = (1.f - l1[i]) * os1;
                        }
                        { u32x4 lw; lw.x = cvt_pk_bf16(g0[0], g0[1]); lw.y = cvt_pk_bf16(g0[2], g0[3]); lw.z = cvt_pk_bf16(g1[0], g1[1]); lw.w = cvt_pk_bf16(g1[2], g1[3]); *(u32x4*)(LG + ro + bj * HALF) = lw; }
                    }
                    u32x4 w; w.x = cvt_pk_bf16(v0[0], v0[1]); w.y = cvt_pk_bf16(v0[2], v0[3]); w.z = cvt_pk_bf16(v1[0], v1[1]); w.w = cvt_pk_bf16(v1[2], v1[3]);
                    *(u32x4*)(base + ro + bj * HALF) = w;
                }
            }
    }
};

struct MoeTabs { const PG8_LAS int* toff; const PG8_LAS int* cntv; const PG8_LAS unsigned char* tile_e; const PG8_LAS unsigned short* xl; int nxl; };
template <int NN> struct MoeOrder {
    MoeTabs tb; int G, c; const int* rowlist;
    __device__ __forceinline__ bool next(int i, Unit& u) const {
        const int L = i * (G >> 3) + (c >> 3); if (L >= tb.nxl * NN) return false;
        const int ti = L / NN, n = L - ti * NN, tile = __builtin_amdgcn_readfirstlane((int)tb.xl[ti]), e = __builtin_amdgcn_readfirstlane((int)tb.tile_e[tile]);
        u.pm = tile; u.pn = e * NN + n; u.aux = n; u.e = e; return true;
    }
    __device__ __forceinline__ int row_of(const Unit& u, int r) const {
        const int slot = (u.pm - __builtin_amdgcn_readfirstlane(tb.toff[u.e])) * 256 + r, last = __builtin_amdgcn_readfirstlane(tb.cntv[u.e]) - 1;
        return rowlist[(size_t)u.e * cfg::T + (slot < last ? slot : last)];
    }
    __device__ __forceinline__ void a_ready(const Unit&) const {}
    __device__ __forceinline__ void done(const Unit&) const {}
};
struct EpiSwiglu {
    static constexpr bool PERM = true, AFTER_DRAIN = false;
    bf16_t* H1;
    __device__ __forceinline__ void operator()(const f32x4 (&acc)[2][2][4][2], const Unit& u, int wr, int wc, int fr, int fq) const {
        const int col0 = u.aux * 128 + wc * 32 + 8 * fq;
#pragma unroll
        for (int ai = 0; ai < 2; ++ai)
#pragma unroll
            for (int m = 0; m < 4; ++m) {
                const size_t row = (size_t)u.pm * BM + ai * HALF + wr * 64 + m * 16 + fr;
                const f32x4 g0 = acc[ai][0][m][0], g1 = acc[ai][0][m][1], u0 = acc[ai][1][m][0], u1 = acc[ai][1][m][1];
                f32x4 h0, h1;
#pragma unroll
                for (int i = 0; i < 4; ++i) { h0[i] = g0[i] * sigm(g0[i]) * u0[i]; h1[i] = g1[i] * sigm(g1[i]) * u1[i]; }
                u32x4 w; w.x = cvt_pk_bf16(h0[0], h0[1]); w.y = cvt_pk_bf16(h0[2], h0[3]); w.z = cvt_pk_bf16(h1[0], h1[1]); w.w = cvt_pk_bf16(h1[2], h1[3]);
                *(u32x4*)(H1 + row * 256 + col0) = w;
            }
    }
};
struct EpiDown {
    static constexpr bool PERM = true, AFTER_DRAIN = false;
    unsigned char* Y;
    __device__ __forceinline__ void operator()(const f32x4 (&acc)[2][2][4][2], const Unit& u, int wr, int wc, int fr, int fq) const {
        const int col0 = u.aux * 256 + wc * 32 + 8 * fq;
        typedef unsigned u32x2_ __attribute__((ext_vector_type(2)));
#pragma unroll
        for (int ai = 0; ai < 2; ++ai)
#pragma unroll
            for (int m = 0; m < 4; ++m) {
                unsigned char* rowp = Y + ((size_t)u.pm * BM + ai * HALF + wr * 64 + m * 16 + fr) * 1024 + col0;
#pragma unroll
                for (int bj = 0; bj < 2; ++bj) {
                    f32x4 v0 = acc[ai][bj][m][0] * 64.f, v1 = acc[ai][bj][m][1] * 64.f;
#pragma unroll
                    for (int i = 0; i < 4; ++i) { v0[i] = __builtin_amdgcn_fmed3f(v0[i], -448.f, 448.f); v1[i] = __builtin_amdgcn_fmed3f(v1[i], -448.f, 448.f); }
                    int w0 = 0, w1 = 0;
                    w0 = __builtin_amdgcn_cvt_pk_fp8_f32(v0[0], v0[1], w0, false); w0 = __builtin_amdgcn_cvt_pk_fp8_f32(v0[2], v0[3], w0, true);
                    w1 = __builtin_amdgcn_cvt_pk_fp8_f32(v1[0], v1[1], w1, false); w1 = __builtin_amdgcn_cvt_pk_fp8_f32(v1[2], v1[3], w1, true);
                    *(u32x2_*)(rowp + bj * HALF) = (u32x2_){(unsigned)w0, (unsigned)w1};
                }
            }
    }
};
template <class Epi, class Sched, bool ALIGN_EPI = false, bool SP2 = false>
__device__ __forceinline__ void gemm_phase(PG8_LAS unsigned char* lds, const Gemm g, const Sched& S, const Epi& E) {
    int tid_l = threadIdx.x; asm volatile("" : "+v"(tid_l));
    const int tid = tid_l, wid = __builtin_amdgcn_readfirstlane(tid >> 6), lane = tid & 63, wr = wid >> 2, wc = wid & 3, fr = lane & 15, fq = lane >> 4;
    const int K = g.K, nt = K / BK;
    unsigned voffA[2], voffB[2];
#pragma unroll
    for (int i = 0; i < 2; ++i) { int R, C; stage_rc(tid * 16 + i * 8192, R, C); const int Rb = Epi::PERM ? ((R & ~31) + perm32(R & 31)) : R;
        voffA[i] = (unsigned)(R * K + C) * 2u; voffB[i] = (unsigned)(Rb * K + C) * 2u; }
    const size_t kstep = (size_t)(BK * 2);
    const size_t hstep = (size_t)HALF * K * 2;
    const size_t tstep = 2 * hstep;
    const unsigned ldsw = (unsigned)wid * 1024u;
    const int aoff = lds_byte(wr * 64 + fr, fq * 8), boff = lds_byte(wc * 32 + fr, fq * 8);
#define PG8_SA(b, h) (((b) * 2 + (h)) * HTB)
#define PG8_SB(b, h) ((4 + (b) * 2 + (h)) * HTB)
#define PG8_STAGE(bufoff, gbase, voff) do { _Pragma("unroll") for (int _i = 0; _i < 2; ++_i) \
        __builtin_amdgcn_global_load_lds((const unsigned*)((const char*)(gbase) + (voff)[_i]), (PG8_LAS unsigned*)(lds + (bufoff) + ldsw + _i * 8192), 16, 0, 0); } while (0)
#define PG8_LDA(dst, b, h) do { _Pragma("unroll") for (int m = 0; m < 4; ++m) _Pragma("unroll") for (int k = 0; k < 2; ++k) dst[m][k] = *(const PG8_LAS bf16x8*)(lds + PG8_SA(b, h) + aoff + m * 2048 + k * 1024); } while (0)
#define PG8_LDB(dst, b, h) do { _Pragma("unroll") for (int n = 0; n < 2; ++n) _Pragma("unroll") for (int k = 0; k < 2; ++k) dst[n][k] = *(const PG8_LAS bf16x8*)(lds + PG8_SB(b, h) + boff + n * 2048 + k * 1024); } while (0)
#define PG8_MMA(ai, bj, At, Bt) do { __builtin_amdgcn_s_setprio(1); _Pragma("unroll") for (int m = 0; m < 4; ++m) _Pragma("unroll") for (int n = 0; n < 2; ++n) _Pragma("unroll") for (int k = 0; k < 2; ++k) \
        acc[ai][bj][m][n] = __builtin_amdgcn_mfma_f32_16x16x32_bf16(Bt[n][k], At[m][k], acc[ai][bj][m][n], 0, 0, 0); __builtin_amdgcn_s_setprio(0); } while (0)
#define PG8_WAIT_V(n) asm volatile("s_waitcnt vmcnt(" #n ")" ::: "memory")
#define PG8_WAIT_L(n) asm volatile("s_waitcnt lgkmcnt(" #n ")" ::: "memory")
#define PG8_BAR __builtin_amdgcn_s_barrier()
#define PG8_SCHED __builtin_amdgcn_sched_barrier(0)
    Unit cur, nxt; int ui = 0;
    if (!S.next(0, cur)) return;
    f32x4 acc[2][2][4][2];
#pragma unroll
    for (int a = 0; a < 2; ++a)
#pragma unroll
        for (int b = 0; b < 2; ++b)
#pragma unroll
            for (int m = 0; m < 4; ++m)
#pragma unroll
                for (int n = 0; n < 2; ++n) acc[a][b][m][n] = (f32x4){0.f, 0.f, 0.f, 0.f};
    bf16x8 At[4][2], B0[2][2], B1[2][2];
    const char* cA = (const char*)g.A + (size_t)cur.pm * tstep; const char* cB = (const char*)g.Bt + (size_t)cur.pn * tstep;
    S.a_ready(cur);
    if constexpr (SP2) {
        PG8_STAGE(PG8_SB(0, 0), cB, voffB); PG8_STAGE(PG8_SB(0, 1), cB + hstep, voffB); PG8_STAGE(PG8_SA(0, 0), cA, voffA); PG8_STAGE(PG8_SA(0, 1), cA + hstep, voffA);
        if (wr == 1) PG8_BAR;
        PG8_WAIT_V(2); PG8_BAR;
        PG8_STAGE(PG8_SB(1, 0), cB + kstep, voffB); PG8_STAGE(PG8_SA(1, 0), cA + kstep, voffA); PG8_STAGE(PG8_SB(1, 1), cB + hstep + kstep, voffB);
        PG8_WAIT_V(6); PG8_BAR;
    } else {
        PG8_STAGE(PG8_SB(0, 0), cB, voffB); PG8_STAGE(PG8_SA(0, 0), cA, voffA); PG8_STAGE(PG8_SB(0, 1), cB + hstep, voffB); PG8_STAGE(PG8_SA(0, 1), cA + hstep, voffA);
        if (wr == 1) PG8_BAR;
        PG8_WAIT_V(4); PG8_BAR;
        PG8_STAGE(PG8_SB(1, 0), cB + kstep, voffB); PG8_STAGE(PG8_SA(1, 0), cA + kstep, voffA); PG8_STAGE(PG8_SB(1, 1), cB + hstep + kstep, voffB);
        PG8_WAIT_V(6); PG8_BAR;
    }
    for (;;) {
        const bool has_next = S.next(ui + 1, nxt);
        const char* nA = has_next ? (const char*)g.A + (size_t)nxt.pm * tstep : cA; const char* nB = has_next ? (const char*)g.Bt + (size_t)nxt.pn * tstep : cB;
        for (int t = 0; t < nt; t += 2) {
            const bool last = (t == nt - 2);
            const char* a1 = cA + (size_t)(t + 1) * kstep;
            const char* a2 = last ? nA : cA + (size_t)(t + 2) * kstep; const char* b2 = last ? nB : cB + (size_t)(t + 2) * kstep;
            const char* a3 = a2 + kstep; const char* b3 = b2 + kstep;
            if (last && has_next) S.a_ready(nxt);
            if constexpr (SP2) {
            PG8_LDB(B0, 0, 0); PG8_LDB(B1, 0, 1); PG8_SCHED; PG8_LDA(At, 0, 0); PG8_STAGE(PG8_SA(1, 1), a1 + hstep, voffA);
            PG8_WAIT_V(8); PG8_WAIT_L(0); PG8_BAR; PG8_MMA(0, 0, At, B0); PG8_MMA(0, 1, At, B1); PG8_BAR; PG8_SCHED;
            PG8_LDA(At, 0, 1); PG8_STAGE(PG8_SB(0, 0), b2, voffB); PG8_STAGE(PG8_SB(0, 1), b2 + hstep, voffB); PG8_STAGE(PG8_SA(0, 0), a2, voffA);
            PG8_WAIT_V(8); PG8_WAIT_L(0); PG8_BAR; PG8_MMA(1, 0, At, B0); PG8_MMA(1, 1, At, B1); PG8_BAR; PG8_SCHED;
            PG8_LDB(B0, 1, 0); PG8_LDB(B1, 1, 1); PG8_SCHED; PG8_LDA(At, 1, 0); PG8_STAGE(PG8_SA(0, 1), a2 + hstep, voffA);
            PG8_WAIT_V(8); PG8_WAIT_L(0); PG8_BAR; PG8_MMA(0, 0, At, B0); PG8_MMA(0, 1, At, B1); PG8_BAR; PG8_SCHED;
            PG8_LDA(At, 1, 1); PG8_STAGE(PG8_SB(1, 0), b3, voffB); PG8_STAGE(PG8_SB(1, 1), b3 + hstep, voffB); PG8_STAGE(PG8_SA(1, 0), a3, voffA);
            PG8_WAIT_V(8); PG8_WAIT_L(0); PG8_BAR; PG8_MMA(1, 0, At, B0); PG8_MMA(1, 1, At, B1); PG8_BAR; PG8_SCHED;
            } else {
            PG8_LDB(B0, 0, 0); PG8_SCHED; PG8_LDA(At, 0, 0); PG8_STAGE(PG8_SA(1, 1), a1 + hstep, voffA);
            PG8_WAIT_L(8); PG8_BAR; PG8_WAIT_L(0); PG8_MMA(0, 0, At, B0); PG8_BAR; PG8_SCHED;
            PG8_LDB(B1, 0, 1); PG8_STAGE(PG8_SB(0, 0), b2, voffB);
            PG8_BAR; PG8_WAIT_L(0); PG8_MMA(0, 1, At, B1); PG8_BAR;
            PG8_LDA(At, 0, 1); PG8_STAGE(PG8_SA(0, 0), a2, voffA);
            PG8_BAR; PG8_WAIT_L(0); PG8_MMA(1, 0, At, B0); PG8_BAR; PG8_SCHED;
            PG8_STAGE(PG8_SB(0, 1), b2 + hstep, voffB);
            PG8_WAIT_V(6); PG8_BAR; PG8_MMA(1, 1, At, B1); PG8_BAR;
            PG8_LDB(B0, 1, 0); PG8_SCHED; PG8_LDA(At, 1, 0); PG8_STAGE(PG8_SA(0, 1), a2 + hstep, voffA);
            PG8_WAIT_L(8); PG8_BAR; PG8_WAIT_L(0); PG8_MMA(0, 0, At, B0); PG8_BAR; PG8_SCHED;
            PG8_LDB(B1, 1, 1); PG8_STAGE(PG8_SB(1, 0), b3, voffB);
            PG8_BAR; PG8_WAIT_L(0); PG8_MMA(0, 1, At, B1); PG8_BAR;
            PG8_LDA(At, 1, 1); PG8_STAGE(PG8_SA(1, 0), a3, voffA);
            PG8_BAR; PG8_WAIT_L(0); PG8_MMA(1, 0, At, B0); PG8_BAR; PG8_SCHED;
            PG8_STAGE(PG8_SB(1, 1), b3 + hstep, voffB);
            PG8_WAIT_V(6); PG8_BAR; PG8_MMA(1, 1, At, B1); PG8_BAR;
            }
        }
        if constexpr (ALIGN_EPI) { if (wr == 0) PG8_BAR; }
        if constexpr (!Epi::AFTER_DRAIN) { E(acc, cur, wr, wc, fr, fq); S.done(cur); }
        if (!has_next) break;
#pragma unroll
        for (int a = 0; a < 2; ++a)
#pragma unroll
            for (int b = 0; b < 2; ++b)
#pragma unroll
                for (int m = 0; m < 4; ++m)
#pragma unroll
                    for (int n = 0; n < 2; ++n) acc[a][b][m][n] = (f32x4){0.f, 0.f, 0.f, 0.f};
        cur = nxt; cA = nA; cB = nB; ++ui;
        if constexpr (ALIGN_EPI) { if (wr == 1) PG8_BAR; }
    }
    PG8_WAIT_V(0);
    if constexpr (!ALIGN_EPI) { if (wr == 0) PG8_BAR; }
    PG8_BAR;
    if constexpr (Epi::AFTER_DRAIN) { E.fused(acc, cur, wr, wc, fr, fq, lds, wid, lane); S.done(cur); }
#undef PG8_SA
#undef PG8_SB
#undef PG8_STAGE
#undef PG8_LDA
#undef PG8_LDB
#undef PG8_MMA
#undef PG8_WAIT_V
#undef PG8_WAIT_L
#undef PG8_BAR
#undef PG8_SCHED
}


#define PG8_GOFF(dst, unit) do { _Pragma("unroll") for (int _h = 0; _h < 2; ++_h) _Pragma("unroll") for (int _i = 0; _i < 2; ++_i) { int R_, C_; stage_rc(tid * 16 + _i * 8192, R_, C_); \
        dst[_h][_i] = (unsigned)(S.row_of(unit, _h * HALF + R_) * K + C_) * 2u; } } while (0)
template <class Epi, class Sched, bool ALIGN_EPI = false, bool SP2 = false>
__device__ __forceinline__ void gemm_phase_g(PG8_LAS unsigned char* lds, const Gemm g, const Sched& S, const Epi& E) {
    int tid_l = threadIdx.x; asm volatile("" : "+v"(tid_l));
    const int tid = tid_l, wid = __builtin_amdgcn_readfirstlane(tid >> 6), lane = tid & 63, wr = wid >> 2, wc = wid & 3, fr = lane & 15, fq = lane >> 4;
    const int K = g.K, nt = K / BK;
    unsigned voffA[2], voffB[2];
#pragma unroll
    for (int i = 0; i < 2; ++i) { int R, C; stage_rc(tid * 16 + i * 8192, R, C); const int Rb = Epi::PERM ? ((R & ~31) + perm32(R & 31)) : R;
        voffA[i] = (unsigned)(R * K + C) * 2u; voffB[i] = (unsigned)(Rb * K + C) * 2u; }
    const size_t kstep = (size_t)(BK * 2);
    const size_t hstep = (size_t)HALF * K * 2;
    const size_t tstep = 2 * hstep;
    const unsigned ldsw = (unsigned)wid * 1024u;
    const int aoff = lds_byte(wr * 64 + fr, fq * 8), boff = lds_byte(wc * 32 + fr, fq * 8);
#define PG8_SA(b, h) (((b) * 2 + (h)) * HTB)
#define PG8_SB(b, h) ((4 + (b) * 2 + (h)) * HTB)
#define PG8_STAGE(bufoff, gbase, voff) do { _Pragma("unroll") for (int _i = 0; _i < 2; ++_i) \
        __builtin_amdgcn_global_load_lds((const unsigned*)((const char*)(gbase) + (voff)[_i]), (PG8_LAS unsigned*)(lds + (bufoff) + ldsw + _i * 8192), 16, 0, 0); } while (0)
#define PG8_LDA(dst, b, h) do { _Pragma("unroll") for (int m = 0; m < 4; ++m) _Pragma("unroll") for (int k = 0; k < 2; ++k) dst[m][k] = *(const PG8_LAS bf16x8*)(lds + PG8_SA(b, h) + aoff + m * 2048 + k * 1024); } while (0)
#define PG8_LDB(dst, b, h) do { _Pragma("unroll") for (int n = 0; n < 2; ++n) _Pragma("unroll") for (int k = 0; k < 2; ++k) dst[n][k] = *(const PG8_LAS bf16x8*)(lds + PG8_SB(b, h) + boff + n * 2048 + k * 1024); } while (0)
#define PG8_MMA(ai, bj, At, Bt) do { __builtin_amdgcn_s_setprio(1); _Pragma("unroll") for (int m = 0; m < 4; ++m) _Pragma("unroll") for (int n = 0; n < 2; ++n) _Pragma("unroll") for (int k = 0; k < 2; ++k) \
        acc[ai][bj][m][n] = __builtin_amdgcn_mfma_f32_16x16x32_bf16(Bt[n][k], At[m][k], acc[ai][bj][m][n], 0, 0, 0); __builtin_amdgcn_s_setprio(0); } while (0)
#define PG8_WAIT_V(n) asm volatile("s_waitcnt vmcnt(" #n ")" ::: "memory")
#define PG8_WAIT_L(n) asm volatile("s_waitcnt lgkmcnt(" #n ")" ::: "memory")
#define PG8_BAR __builtin_amdgcn_s_barrier()
#define PG8_SCHED __builtin_amdgcn_sched_barrier(0)
    Unit cur, nxt; int ui = 0;
    if (!S.next(0, cur)) return;
    f32x4 acc[2][2][4][2];
#pragma unroll
    for (int a = 0; a < 2; ++a)
#pragma unroll
        for (int b = 0; b < 2; ++b)
#pragma unroll
            for (int m = 0; m < 4; ++m)
#pragma unroll
                for (int n = 0; n < 2; ++n) acc[a][b][m][n] = (f32x4){0.f, 0.f, 0.f, 0.f};
    bf16x8 At[4][2], B0[2][2], B1[2][2];
    const char* cA = (const char*)g.A; unsigned vC[2][2], vN[2][2], vS[2][2]; PG8_GOFF(vC, cur); const char* cB = (const char*)g.Bt + (size_t)cur.pn * tstep;
    S.a_ready(cur);
    if constexpr (SP2) {
        PG8_STAGE(PG8_SB(0, 0), cB, voffB); PG8_STAGE(PG8_SB(0, 1), cB + hstep, voffB); PG8_STAGE(PG8_SA(0, 0), cA, vC[0]); PG8_STAGE(PG8_SA(0, 1), cA, vC[1]);
        if (wr == 1) PG8_BAR;
        PG8_WAIT_V(2); PG8_BAR;
        PG8_STAGE(PG8_SB(1, 0), cB + kstep, voffB); PG8_STAGE(PG8_SA(1, 0), cA + kstep, vC[0]); PG8_STAGE(PG8_SB(1, 1), cB + hstep + kstep, voffB);
        PG8_WAIT_V(6); PG8_BAR;
    } else {
        PG8_STAGE(PG8_SB(0, 0), cB, voffB); PG8_STAGE(PG8_SA(0, 0), cA, vC[0]); PG8_STAGE(PG8_SB(0, 1), cB + hstep, voffB); PG8_STAGE(PG8_SA(0, 1), cA, vC[1]);
        if (wr == 1) PG8_BAR;
        PG8_WAIT_V(4); PG8_BAR;
        PG8_STAGE(PG8_SB(1, 0), cB + kstep, voffB); PG8_STAGE(PG8_SA(1, 0), cA + kstep, vC[0]); PG8_STAGE(PG8_SB(1, 1), cB + hstep + kstep, voffB);
        PG8_WAIT_V(6); PG8_BAR;
    }
    for (;;) {
        const bool has_next = S.next(ui + 1, nxt);
        const char* nA = (const char*)g.A; if (has_next) { PG8_GOFF(vN, nxt); } else { _Pragma("unroll") for (int _h = 0; _h < 2; ++_h) _Pragma("unroll") for (int _i = 0; _i < 2; ++_i) vN[_h][_i] = vC[_h][_i]; } const char* nB = has_next ? (const char*)g.Bt + (size_t)nxt.pn * tstep : cB;
        for (int t = 0; t < nt; t += 2) {
            const bool last = (t == nt - 2); _Pragma("unroll") for (int _h = 0; _h < 2; ++_h) _Pragma("unroll") for (int _i = 0; _i < 2; ++_i) vS[_h][_i] = last ? vN[_h][_i] : vC[_h][_i];
            const char* a1 = cA + (size_t)(t + 1) * kstep;
            const char* a2 = last ? nA : cA + (size_t)(t + 2) * kstep; const char* b2 = last ? nB : cB + (size_t)(t + 2) * kstep;
            const char* a3 = a2 + kstep; const char* b3 = b2 + kstep;
            if (last && has_next) S.a_ready(nxt);
            if constexpr (SP2) {
            PG8_LDB(B0, 0, 0); PG8_LDB(B1, 0, 1); PG8_SCHED; PG8_LDA(At, 0, 0); PG8_STAGE(PG8_SA(1, 1), a1, vC[1]);
            PG8_WAIT_V(8); PG8_WAIT_L(0); PG8_BAR; PG8_MMA(0, 0, At, B0); PG8_MMA(0, 1, At, B1); PG8_BAR; PG8_SCHED;
            PG8_LDA(At, 0, 1); PG8_STAGE(PG8_SB(0, 0), b2, voffB); PG8_STAGE(PG8_SB(0, 1), b2 + hstep, voffB); PG8_STAGE(PG8_SA(0, 0), a2, vS[0]);
            PG8_WAIT_V(8); PG8_WAIT_L(0); PG8_BAR; PG8_MMA(1, 0, At, B0); PG8_MMA(1, 1, At, B1); PG8_BAR; PG8_SCHED;
            PG8_LDB(B0, 1, 0); PG8_LDB(B1, 1, 1); PG8_SCHED; PG8_LDA(At, 1, 0); PG8_STAGE(PG8_SA(0, 1), a2, vS[1]);
            PG8_WAIT_V(8); PG8_WAIT_L(0); PG8_BAR; PG8_MMA(0, 0, At, B0); PG8_MMA(0, 1, At, B1); PG8_BAR; PG8_SCHED;
            PG8_LDA(At, 1, 1); PG8_STAGE(PG8_SB(1, 0), b3, voffB); PG8_STAGE(PG8_SB(1, 1), b3 + hstep, voffB); PG8_STAGE(PG8_SA(1, 0), a3, vS[0]);
            PG8_WAIT_V(8); PG8_WAIT_L(0); PG8_BAR; PG8_MMA(1, 0, At, B0); PG8_MMA(1, 1, At, B1); PG8_BAR; PG8_SCHED;
            } else {
            PG8_LDB(B0, 0, 0); PG8_SCHED; PG8_LDA(At, 0, 0); PG8_STAGE(PG8_SA(1, 1), a1, vC[1]);
            PG8_WAIT_L(8); PG8_BAR; PG8_WAIT_L(0); PG8_MMA(0, 0, At, B0); PG8_BAR; PG8_SCHED;
            PG8_LDB(B1, 0, 1); PG8_STAGE(PG8_SB(0, 0), b2, voffB);
            PG8_BAR; PG8_WAIT_L(0); PG8_MMA(0, 1, At, B1); PG8_BAR;
            PG8_LDA(At, 0, 1); PG8_STAGE(PG8_SA(0, 0), a2, vS[0]);
            PG8_BAR; PG8_WAIT_L(0); PG8_MMA(1, 0, At, B0); PG8_BAR; PG8_SCHED;
            PG8_STAGE(PG8_SB(0, 1), b2 + hstep, voffB);
            PG8_WAIT_V(6); PG8_BAR; PG8_MMA(1, 1, At, B1); PG8_BAR;
            PG8_LDB(B0, 1, 0); PG8_SCHED; PG8_LDA(At, 1, 0); PG8_STAGE(PG8_SA(0, 1), a2, vS[1]);
            PG8_WAIT_L(8); PG8_BAR; PG8_WAIT_L(0); PG8_MMA(0, 0, At, B0); PG8_BAR; PG8_SCHED;
            PG8_LDB(B1, 1, 1); PG8_STAGE(PG8_SB(1, 0), b3, voffB);
            PG8_BAR; PG8_WAIT_L(0); PG8_MMA(0, 1, At, B1); PG8_BAR;
            PG8_LDA(At, 1, 1); PG8_STAGE(PG8_SA(1, 0), a3, vS[0]);
            PG8_BAR; PG8_WAIT_L(0); PG8_MMA(1, 0, At, B0); PG8_BAR; PG8_SCHED;
            PG8_STAGE(PG8_SB(1, 1), b3 + hstep, voffB);
            PG8_WAIT_V(6); PG8_BAR; PG8_MMA(1, 1, At, B1); PG8_BAR;
            }
        }
        if constexpr (ALIGN_EPI) { if (wr == 0) PG8_BAR; }
        if constexpr (!Epi::AFTER_DRAIN) { E(acc, cur, wr, wc, fr, fq); S.done(cur); }
        if (!has_next) break;
#pragma unroll
        for (int a = 0; a < 2; ++a)
#pragma unroll
            for (int b = 0; b < 2; ++b)
#pragma unroll
                for (int m = 0; m < 4; ++m)
#pragma unroll
                    for (int n = 0; n < 2; ++n) acc[a][b][m][n] = (f32x4){0.f, 0.f, 0.f, 0.f};
        cur = nxt; cA = nA; cB = nB; ++ui; _Pragma("unroll") for (int _h = 0; _h < 2; ++_h) _Pragma("unroll") for (int _i = 0; _i < 2; ++_i) vC[_h][_i] = vN[_h][_i];
        if constexpr (ALIGN_EPI) { if (wr == 1) PG8_BAR; }
    }
    PG8_WAIT_V(0);
    if constexpr (!ALIGN_EPI) { if (wr == 0) PG8_BAR; }
    PG8_BAR;
    if constexpr (Epi::AFTER_DRAIN) { E.fused(acc, cur, wr, wc, fr, fq, lds, wid, lane); S.done(cur); }
#undef PG8_SA
#undef PG8_SB
#undef PG8_STAGE
#undef PG8_LDA
#undef PG8_LDB
#undef PG8_MMA
#undef PG8_WAIT_V
#undef PG8_WAIT_L
#undef PG8_BAR
#undef PG8_SCHED
}
#undef PG8_GOFF

}


namespace {
#define GAS __attribute__((address_space(1)))
#define LAS __attribute__((address_space(3)))
typedef unsigned short bf16;
typedef unsigned v4u __attribute__((ext_vector_type(4)));
typedef float f32x4 __attribute__((ext_vector_type(4)));
constexpr int NWAVES = 8, NTHREADS = 512, LDS_BYTES = 147456;

__device__ __forceinline__ unsigned pk2(float lo, float hi) { typedef float f2_c __attribute__((ext_vector_type(2))); typedef __bf16 b2_c __attribute__((ext_vector_type(2))); const f2_c v = {lo, hi}; return __builtin_bit_cast(unsigned, __builtin_convertvector(v, b2_c)); }
__device__ __forceinline__ unsigned f2bf(float f) { return pk2(f, f) & 0xffffu; }
__device__ __forceinline__ float bf2f(bf16 h) { return __uint_as_float((unsigned)h << 16); }
__device__ __forceinline__ float wave_sum(float v) {
#pragma unroll
    for (int o = 1; o < 64; o <<= 1) v += __shfl_xor(v, o);
    return v;
}
__device__ __forceinline__ float sigmoidf_(float x) { return __builtin_amdgcn_rcpf(1.f + __expf(-x)); }
__device__ __forceinline__ int fkey_(float x) { const int b = (int)__float_as_uint(x); return b >= 0 ? b : (b ^ 0x7fffffff); }
__device__ __forceinline__ float fkey_inv_(int k) { return __uint_as_float((unsigned)(k >= 0 ? k : (k ^ 0x7fffffff))); }
constexpr int KEY_NEG_INF = (int)0x807fffff;
template <int CTRL> __device__ __forceinline__ int dppi_(int v) { return __builtin_amdgcn_update_dpp(v, v, CTRL, 0xF, 0xF, false); }
template <int CTRL> __device__ __forceinline__ float dppf_(float v) { return __uint_as_float((unsigned)__builtin_amdgcn_update_dpp((int)__float_as_uint(v), (int)__float_as_uint(v), CTRL, 0xF, 0xF, false)); }
__device__ __forceinline__ int imax_(int a, int b) { return a > b ? a : b; }
__device__ __forceinline__ int gmax8i_(int v) {
    asm volatile("s_nop 1\n\tv_max_i32_dpp %0, %0, %0 quad_perm:[1,0,3,2] row_mask:0xf bank_mask:0xf\n\ts_nop 1\n\tv_max_i32_dpp %0, %0, %0 quad_perm:[2,3,0,1] row_mask:0xf bank_mask:0xf\n\t"
                 "s_nop 1\n\tv_max_i32_dpp %0, %0, %0 row_half_mirror row_mask:0xf bank_mask:0xf" : "+v"(v));
    return v; }
__device__ __forceinline__ int wmaxi_(int v) { v = gmax8i_(v); asm volatile("s_nop 1\n\tv_max_i32_dpp %0, %0, %0 row_mirror row_mask:0xf bank_mask:0xf" : "+v"(v));
    const int a = __builtin_amdgcn_readlane(v, 0), b = __builtin_amdgcn_readlane(v, 16), c = __builtin_amdgcn_readlane(v, 32), d = __builtin_amdgcn_readlane(v, 48); return imax_(imax_(a, b), imax_(c, d)); }
__device__ __forceinline__ float wsumf_(float v) { v += dppf_<0xB1>(v); v += dppf_<0x4E>(v); v += dppf_<0x141>(v); v += dppf_<0x140>(v);
    const float a = __uint_as_float((unsigned)__builtin_amdgcn_readlane((int)__float_as_uint(v), 0)), b = __uint_as_float((unsigned)__builtin_amdgcn_readlane((int)__float_as_uint(v), 16)),
                c = __uint_as_float((unsigned)__builtin_amdgcn_readlane((int)__float_as_uint(v), 32)), d = __uint_as_float((unsigned)__builtin_amdgcn_readlane((int)__float_as_uint(v), 48)); return (a + b) + (c + d); }


struct WS {
    int* ctl;
    bf16 *Wqkv_t, *Wo_t, *Hin_t, *Hout_t, *Wgu_t, *Wd_t;
    float *rot, *lbtab;
    float *V32;
    bf16 *Xb, *Qb, *Kb, *Vb, *Ob, *Gb;
    float *LG;
    bf16 *Uf, *Sf; float *Dbuf;
    float *Wr_t;
    bf16 *H1, *Y;
    int *rowlist; float *tok_w; int *tok_es;
};
constexpr int NROWS = T * 9 + 65 * 256;
constexpr int TAB_OFF = 131072;


template <int PERMK> __device__ __forceinline__ int perm_row(int n) {
    if (PERMK == 1) { if (n < 2048) { const int p = n & 63; if (p < 16) return (n & ~63) + 2 * (p & 7) + (p >> 3); } return n; }
    if (PERMK == 2) { const int up = n >> 8, i = n & 255; return (i >> 7) * 256 + up * 128 + (i & 127); }
    return n;
}
template <int PERMK> __device__ __forceinline__ void transpose_item(const float* W, int K, int N, bf16* WT, LAS float* scr, int item, int lane) {
    const int nblk = N / 32, kb = item / nblk, nb = item % nblk, k0 = 64 * kb, n0 = 32 * nb;
#pragma unroll 8
    for (int i = 0; i < 32; ++i) { const int kk = 2 * i + (lane >> 5); scr[kk * 33 + (lane & 31)] = __builtin_nontemporal_load(W + (size_t)(k0 + kk) * N + n0 + (lane & 31)); }
    asm volatile("s_waitcnt lgkmcnt(0)" ::: "memory");
    const int c = lane & 7;
#pragma unroll
    for (int j = 0; j < 4; ++j) { const int n = (lane >> 3) + 8 * j; const LAS float* s = scr + (8 * c) * 33 + n;
        v4u o; o.x = pk2(s[0 * 33], s[1 * 33]); o.y = pk2(s[2 * 33], s[3 * 33]); o.z = pk2(s[4 * 33], s[5 * 33]); o.w = pk2(s[6 * 33], s[7 * 33]);
        *(GAS v4u*)(WT + (size_t)perm_row<PERMK>(n0 + n) * K + k0 + 8 * c) = o; }
    asm volatile("s_waitcnt lgkmcnt(0)" ::: "memory");
}
template <int PERMK> __device__ __forceinline__ void transpose_batch(const float* W, size_t sstride, bf16* WT, size_t dstride, int nmat, int K, int N, LAS float* scr, int gw, int ngw, int lane) {
    const int ipm = (K / 64) * (N / 32);
    for (int it = gw; it < nmat * ipm; it += ngw) { const int mat = it / ipm; transpose_item<PERMK>(W + (size_t)mat * sstride, K, N, WT + (size_t)mat * dstride, scr, it % ipm, lane); }
}
struct Inputs { const float* p[17]; };
constexpr int CNT_STRIDE = 520, CNT_BASE = 16384;
constexpr int CTL_POISON = 2048;
typedef int v8i_ __attribute__((ext_vector_type(8)));
typedef float v16f_ __attribute__((ext_vector_type(16)));
__device__ __forceinline__ bool fp8_mfma_selftest(int lane) {
    const int r32 = lane & 31, h = lane >> 5;
    v8i_ A, B;
#pragma unroll
    for (int w = 0; w < 8; ++w) {
        float av[4], bv[4];
#pragma unroll
        for (int b = 0; b < 4; ++b) { const int k = 32 * h + 4 * w + b; av[b] = (float)((r32 * 3 + k * 5) % 5); bv[b] = (float)((k * 7 + r32 * 2) % 4); }
        int aw = 0, bw = 0;
        aw = __builtin_amdgcn_cvt_pk_fp8_f32(av[0], av[1], aw, false); aw = __builtin_amdgcn_cvt_pk_fp8_f32(av[2], av[3], aw, true);
        bw = __builtin_amdgcn_cvt_pk_fp8_f32(bv[0], bv[1], bw, false); bw = __builtin_amdgcn_cvt_pk_fp8_f32(bv[2], bv[3], bw, true);
        A[w] = aw; B[w] = bw;
    }
    v16f_ C;
#pragma unroll
    for (int r = 0; r < 16; ++r) C[r] = 0.f;
    C = __builtin_amdgcn_mfma_scale_f32_32x32x64_f8f6f4(A, B, C, 0, 0, 0, 0x7F7F7F7F, 0, 0x7F7F7F7F);
    bool ok = true;
#pragma unroll
    for (int r = 0; r < 16; ++r) {
        const int i = (r & 3) + 8 * (r >> 2) + 4 * h, j = r32; float e = 0.f;
        for (int k = 0; k < 64; ++k) e += (float)((i * 3 + k * 5) % 5) * (float)((k * 7 + j * 2) % 4);
        ok = ok && (C[r] == e);
    }
    return __all(ok);
}

__device__ __forceinline__ void prologue_phase(const Inputs& in, const WS& w, float* X32, LAS unsigned char* lds) {
    int tid_l = threadIdx.x; asm volatile("" : "+v"(tid_l));
    const int tid = tid_l, lane = tid & 63, wave = tid >> 6;
    const int gw = blockIdx.x * NWAVES + wave, ngw = gridDim.x * NWAVES;
    LAS float* scr = (LAS float*)(lds + wave * 16384);
    transpose_batch<1>(in.p[1], (size_t)D * 3072, w.Wqkv_t, (size_t)3072 * D, 2, D, 3072, scr, gw, ngw, lane);
    transpose_batch<0>(in.p[2], (size_t)D * D, w.Wo_t, (size_t)D * D, 2, D, D, scr, gw, ngw, lane);
    transpose_batch<0>(in.p[5], (size_t)D * 4096, w.Hin_t, (size_t)4096 * D, 2, D, 4096, scr, gw, ngw, lane);
    transpose_batch<0>(in.p[6], (size_t)D * D, w.Hout_t, (size_t)D * D, 2, D, D, scr, gw, ngw, lane);
    for (int L = 0; L < DEPTH; ++L) {
        transpose_batch<2>(in.p[11] + (size_t)L * NE * D * 512, (size_t)D * 512, w.Wgu_t + (size_t)L * 65 * 512 * D, (size_t)512 * D, NE, D, 512, scr, gw, ngw, lane);
        transpose_batch<2>(in.p[13] + (size_t)L * D * 512, 0, w.Wgu_t + ((size_t)L * 65 + 64) * 512 * D, 0, 1, D, 512, scr, gw, ngw, lane);
        transpose_batch<0>(in.p[12] + (size_t)L * NE * 256 * D, (size_t)256 * D, w.Wd_t + (size_t)L * 65 * D * 256, (size_t)D * 256, NE, 256, D, scr, gw, ngw, lane);
        transpose_batch<0>(in.p[14] + (size_t)L * 256 * D, 0, w.Wd_t + ((size_t)L * 65 + 64) * D * 256, 0, 1, 256, D, scr, gw, ngw, lane);
    }
    if (blockIdx.x == 0 && wave == 0) { const bool ok = fp8_mfma_selftest(lane); if (!ok && lane == 0) w.ctl[CTL_POISON] = 1; }
    const int gt = blockIdx.x * NTHREADS + tid, ngt = gridDim.x * NTHREADS;
    for (int i = gt; i < SEQ * 8; i += ngt) {
        const int pos = i >> 3, j = i & 7;
        const float inv_freq = (float)pow(500000.0, -(double)(2 * j) / 16.0);
        float sn, cs; sincosf((float)pos * inv_freq, &sn, &cs);
        w.rot[2 * i] = cs; w.rot[2 * i + 1] = sn;
    }
    for (int i = gt; i < 2 * 1024; i += ngt) {
        const int col = i & 1023, L = (i >> 10) ? 3 : 1; const float* r = in.p[7];
        const float v0 = r[col], v1 = r[1024 + col], v2 = r[2048 + col], v3 = r[3072 + col];
        const float mx = fmaxf(fmaxf(v0, v1), fmaxf(v2, v3));
        const float e0 = expf(v0 - mx), e1 = expf(v1 - mx), e2 = expf(v2 - mx), e3 = expf(v3 - mx), den = e0 + e1 + e2 + e3;
        w.lbtab[i] = (L == 1) ? e1 / den : (e1 + e2 + e3) / den;
    }
    if (gt < 2) { const float* lp = in.p[3] + gt * 256; float d01 = 0.f, d23 = 0.f; for (int i = 0; i < 64; ++i) { d01 += lp[i] * lp[64 + i]; d23 += lp[128 + i] * lp[192 + i]; }
        w.lbtab[2048 + gt] = expf(d01) - expf(d23) + (0.8f - 0.6f * expf(-0.3f * (float)(2 * gt))); }
    for (int i = gt; i < T; i += ngt) w.rowlist[(size_t)NE * T + i] = i;
    for (int i = gt; i < DEPTH * NE * D; i += ngt) { const int L = i / (NE * D), r = i % (NE * D), e = r / D, k = r % D; const float v = in.p[9][(size_t)L * D * NE + (size_t)k * NE + e];
        const unsigned hb = f2bf(v); bf16* dst = (bf16*)w.Wr_t + (size_t)L * 2 * NE * D; dst[r] = (bf16)hb; dst[NE * D + r] = (bf16)f2bf(v - __uint_as_float(hb << 16)); }
    for (size_t i = gt; i < (size_t)T * D / 4; i += ngt) {
        const f32x4 v = ((const f32x4*)in.p[0])[i];
        uint2 o; o.x = pk2(v[0], v[1]); o.y = pk2(v[2], v[3]); ((uint2*)w.Xb)[i] = o;
    }
}

__device__ __forceinline__ void ln_row(const float* vrow, float* xrow, bf16* brow, const float* g, const float* b, int lane) {
    f32x4 v[4]; float s = 0.f;
#pragma unroll
    for (int j = 0; j < 4; ++j) { v[j] = ((const f32x4*)vrow)[lane + 64 * j]; s += (v[j][0] + v[j][1]) + (v[j][2] + v[j][3]); }
    const float mean = wsumf_(s) * (1.f / D); float q = 0.f;
#pragma unroll
    for (int j = 0; j < 4; ++j) { v[j] = v[j] - mean; q += (v[j][0] * v[j][0] + v[j][1] * v[j][1]) + (v[j][2] * v[j][2] + v[j][3] * v[j][3]); }
    const float rstd = __builtin_amdgcn_rsqf(wsumf_(q) * (1.f / D) + LN_EPS);
#pragma unroll
    for (int j = 0; j < 4; ++j) {
        const f32x4 g4 = ((const f32x4*)g)[lane + 64 * j], b4 = ((const f32x4*)b)[lane + 64 * j];
        const f32x4 o = v[j] * rstd * g4 + b4;
        ((f32x4*)xrow)[lane + 64 * j] = o;
        uint2 ob; ob.x = pk2(o[0], o[1]); ob.y = pk2(o[2], o[3]); ((uint2*)brow)[lane + 64 * j] = ob;
    }
}
typedef float f32x4_ __attribute__((ext_vector_type(4)));
__device__ __forceinline__ pg8::MoeTabs moe_tables(const int* cnt, LAS unsigned char* lds, int tid) {
    asm volatile("" : "+v"(tid));
    LAS int* toff = (LAS int*)(lds + TAB_OFF); LAS int* cntv = toff + 80; LAS unsigned char* tile_e = (LAS unsigned char*)(cntv + 80);
    __syncthreads();
    if (tid < 64) cntv[tid] = cnt[tid * CNT_STRIDE];
    if (tid == 64) cntv[64] = T;
    __syncthreads();
    if (tid == 0) { int a = 0; for (int e = 0; e < 65; ++e) { toff[e] = a; a += (cntv[e] + 255) >> 8; } toff[65] = a; }
    __syncthreads();
    if (tid < 65) for (int m = toff[tid]; m < toff[tid + 1]; ++m) tile_e[m] = (unsigned char)tid;
    LAS unsigned short* xl = (LAS unsigned short*)(lds + TAB_OFF + 4096); LAS int* nxl = (LAS int*)(lds + TAB_OFF + 4096 + 3072);
    if (tid == 0) {
        const int g = blockIdx.x & 7; int n = 0;
        for (int e = g; e < 64; e += 8) for (int m = toff[e]; m < toff[e + 1]; ++m) xl[n++] = (unsigned short)m;
        for (int m = toff[64] + g; m < toff[65]; m += 8) xl[n++] = (unsigned short)m;
        nxl[0] = n;
    }
    __syncthreads();
    pg8::MoeTabs tb{toff, cntv, tile_e, xl, nxl[0]}; return tb;
}
typedef short bf16x8r __attribute__((ext_vector_type(8)));
__device__ __forceinline__ void lnroute_phase(const float* V32, float* X32, bf16* Xb, const float* lg, const float* lb, const bf16* WrHL, const float* bias, int* cnt, int* rowlist, float* tok_w, int* tok_es, LAS unsigned char* lds) {
    int tid_l = threadIdx.x; asm volatile("" : "+v"(tid_l));
    const int tid = tid_l, lane = tid & 63, wave = tid >> 6;
    constexpr int WP = 144;
    LAS unsigned char* wt = lds;
    LAS float* logitS = (LAS float*)(lds + 40960) + wave * 1024;
    LAS float* selw = (LAS float*)(lds + 40960 + 32768) + wave * 1024;
    LAS int* cntL = (LAS int*)(lds + 40960 + 65536); LAS int* baseL = cntL + 64;
    const float bias_e = bias[lane];
    for (int grp = blockIdx.x; grp < T / 128; grp += gridDim.x) {
        if (tid < 64) cntL[tid] = 0;
        const int tok0 = grp * 128 + wave * 16;
#pragma unroll 1
        for (int rb = 0; rb < 16; rb += 4) {
            f32x4 v[4][4];
#pragma unroll
            for (int r = 0; r < 4; ++r)
#pragma unroll
                for (int j = 0; j < 4; ++j) { typedef unsigned u2v_ __attribute__((ext_vector_type(2))); const u2v_ d = __builtin_nontemporal_load((const u2v_*)((const bf16*)V32 + (size_t)(tok0 + rb + r) * D) + lane + 64 * j);
                    v[r][j] = (f32x4){__uint_as_float(d[0] << 16), __uint_as_float(d[0] & 0xffff0000u), __uint_as_float(d[1] << 16), __uint_as_float(d[1] & 0xffff0000u)}; }
#pragma unroll
            for (int r = 0; r < 4; ++r) {
                float sm = 0.f;
#pragma unroll
                for (int j = 0; j < 4; ++j) sm += (v[r][j][0] + v[r][j][1]) + (v[r][j][2] + v[r][j][3]);
                const float mean = wsumf_(sm) * (1.f / D); float q = 0.f;
#pragma unroll
                for (int j = 0; j < 4; ++j) { v[r][j] = v[r][j] - mean; q += (v[r][j][0] * v[r][j][0] + v[r][j][1] * v[r][j][1]) + (v[r][j][2] * v[r][j][2] + v[r][j][3] * v[r][j][3]); }
                const float rstd = __builtin_amdgcn_rsqf(wsumf_(q) * (1.f / D) + LN_EPS);
#pragma unroll
                for (int j = 0; j < 4; ++j) {
                    const f32x4 g4 = ((const f32x4*)lg)[lane + 64 * j], b4 = ((const f32x4*)lb)[lane + 64 * j];
                    const f32x4 o = v[r][j] * rstd * g4 + b4;
                    ((f32x4*)(X32 + (size_t)(tok0 + rb + r) * D))[lane + 64 * j] = o;
                    uint2 ob; ob.x = pk2(o[0], o[1]); ob.y = pk2(o[2], o[3]); ((uint2*)(Xb + (size_t)(tok0 + rb + r) * D))[lane + 64 * j] = ob;
                }
            }
        }
        asm volatile("s_waitcnt vmcnt(0)" ::: "memory");
        f32x4_ acc[4];
#pragma unroll
        for (int nb = 0; nb < 4; ++nb) acc[nb] = (f32x4_){0.f, 0.f, 0.f, 0.f};
        const float* xa = X32 + (size_t)(tok0 + (lane & 15)) * D + 8 * (lane >> 4);
        const bf16* wsrc = WrHL + (size_t)(tid >> 8) * NE * D + (size_t)((tid >> 2) & 63) * D + (tid & 3) * 16;
        const int wdst = ((tid >> 8) * 64 + ((tid >> 2) & 63)) * WP + (tid & 3) * 32;
        v4u w0 = *(const v4u*)(wsrc), w1 = *(const v4u*)(wsrc + 8);
        f32x4 xa0 = *(const f32x4*)(xa), xa1 = *(const f32x4*)(xa + 4), xa2 = *(const f32x4*)(xa + 32), xa3 = *(const f32x4*)(xa + 36);
        *(LAS v4u*)(wt + wdst) = w0; *(LAS v4u*)(wt + wdst + 16) = w1;
        __syncthreads();
#pragma unroll 1
        for (int kb = 0; kb < 16; ++kb) {
            const int cur = kb & 1;
            f32x4 xn0, xn1, xn2, xn3;
            if (kb + 1 < 16) { w0 = *(const v4u*)(wsrc + (kb + 1) * 64); w1 = *(const v4u*)(wsrc + (kb + 1) * 64 + 8);
                xn0 = *(const f32x4*)(xa + (kb + 1) * 64); xn1 = *(const f32x4*)(xa + (kb + 1) * 64 + 4); xn2 = *(const f32x4*)(xa + (kb + 1) * 64 + 32); xn3 = *(const f32x4*)(xa + (kb + 1) * 64 + 36); }
#pragma unroll
            for (int ss = 0; ss < 2; ++ss) {
                const f32x4 a0 = ss ? xa2 : xa0, a1 = ss ? xa3 : xa1;
                unsigned hb[8]; float lo[8];
#pragma unroll
                for (int i = 0; i < 4; ++i) { hb[i] = f2bf(a0[i]); lo[i] = a0[i] - __uint_as_float(hb[i] << 16); hb[4 + i] = f2bf(a1[i]); lo[4 + i] = a1[i] - __uint_as_float(hb[4 + i] << 16); }
                const v4u ah = (v4u){hb[0] | (hb[1] << 16), hb[2] | (hb[3] << 16), hb[4] | (hb[5] << 16), hb[6] | (hb[7] << 16)};
                const v4u al = (v4u){pk2(lo[0], lo[1]), pk2(lo[2], lo[3]), pk2(lo[4], lo[5]), pk2(lo[6], lo[7])};
                const LAS unsigned char* wp = wt + cur * (2 * 64 * WP) + (lane & 15) * WP + (ss * 32 + 8 * (lane >> 4)) * 2;
#pragma unroll
                for (int nb = 0; nb < 4; ++nb) {
                    const v4u bh = *(const LAS v4u*)(wp + nb * 16 * WP), bl = *(const LAS v4u*)(wp + 64 * WP + nb * 16 * WP);
                    acc[nb] = __builtin_amdgcn_mfma_f32_16x16x32_bf16(__builtin_bit_cast(bf16x8r, ah), __builtin_bit_cast(bf16x8r, bh), acc[nb], 0, 0, 0);
                    acc[nb] = __builtin_amdgcn_mfma_f32_16x16x32_bf16(__builtin_bit_cast(bf16x8r, ah), __builtin_bit_cast(bf16x8r, bl), acc[nb], 0, 0, 0);
                    acc[nb] = __builtin_amdgcn_mfma_f32_16x16x32_bf16(__builtin_bit_cast(bf16x8r, al), __builtin_bit_cast(bf16x8r, bh), acc[nb], 0, 0, 0);
                }
            }
            if (kb + 1 < 16) { *(LAS v4u*)(wt + (cur ^ 1) * (2 * 64 * WP) + wdst) = w0; *(LAS v4u*)(wt + (cur ^ 1) * (2 * 64 * WP) + wdst + 16) = w1; xa0 = xn0; xa1 = xn1; xa2 = xn2; xa3 = xn3; }
            __syncthreads();
        }
#pragma unroll
        for (int nb = 0; nb < 4; ++nb)
#pragma unroll
            for (int r = 0; r < 4; ++r) logitS[(4 * (lane >> 4) + r) * 64 + 16 * nb + (lane & 15)] = acc[nb][r];
        asm volatile("s_waitcnt lgkmcnt(0)" ::: "memory");
        int mycount = 0;
#pragma unroll 1
        for (int t = 0; t < 16; ++t) {
            const float logit = logitS[t * 64 + lane];
            const float s = sigmoidf_(logit), c = s + bias_e;
            const int kc = fkey_(c);
            const int k1 = gmax8i_(kc);
            const unsigned long long eq = __ballot(kc == k1);
            const int g = lane >> 3; const unsigned gm = (unsigned)((eq >> (g * 8)) & 0xFFull); const int first = __ffs(gm) - 1;
            const int k2 = gmax8i_(((lane & 7) == first) ? KEY_NEG_INF : kc);
            const float gs = fkey_inv_(k1) + fkey_inv_(k2);
            int grank = 0;
#pragma unroll
            for (int gp = 0; gp < 8; ++gp) { const float og = __uint_as_float((unsigned)__builtin_amdgcn_readlane((int)__float_as_uint(gs), gp * 8)); grank += (og > gs || (og == gs && gp < g)) ? 1 : 0; }
            int work = (grank < 4) ? kc : KEY_NEG_INF; unsigned long long selm = 0ull;
#pragma unroll
            for (int r = 0; r < TOPK; ++r) {
                const int mx = wmaxi_(work);
                const unsigned long long e = __ballot(work == mx);
                const int l = __builtin_ctzll(e);
                selm |= 1ull << l;
                work = (lane == l) ? KEY_NEG_INF : work;
            }
            const bool sel = ((selm >> lane) & 1ull) != 0ull;
            const float ssum = wsumf_(sel ? s : 0.f);
            selw[t * 64 + lane] = sel ? s * __builtin_amdgcn_rcpf(ssum + 1e-20f) * ROUTED_SCALE : -1.f;
            mycount += sel ? 1 : 0;
        }
        const int localbase = __hip_atomic_fetch_add(&cntL[lane], mycount, __ATOMIC_RELAXED, __HIP_MEMORY_SCOPE_WORKGROUP);
        __syncthreads();
        if (wave == 0) { const int c = cntL[lane]; baseL[lane] = c > 0 ? atomicAdd(&cnt[lane * CNT_STRIDE], c) : 0; }
        __syncthreads();
        int slot = baseL[lane] + localbase;
#pragma unroll 1
        for (int t = 0; t < 16; ++t) {
            const float wv = selw[t * 64 + lane]; const bool sel = wv >= 0.f;
            const unsigned long long sm = __ballot(sel);
            if (sel) {
                rowlist[(size_t)lane * T + slot] = tok0 + t;
                const int j = __popcll(sm & ((1ull << lane) - 1ull));
                tok_es[(size_t)(tok0 + t) * 8 + j] = (lane << 16) | slot; tok_w[(size_t)(tok0 + t) * 8 + j] = wv;
                ++slot;
            }
        }
        __syncthreads();
    }
}
__device__ __forceinline__ void combine_phase(const unsigned char* Y, const int* tok_es, const float* tok_w, pg8::MoeTabs tb, const bf16* Xin, float* X32, bf16* Xb, const float* g, const float* b, const int* poison) {
    int tid_l = threadIdx.x; asm volatile("" : "+v"(tid_l));
    const int lane = tid_l & 63, gw = blockIdx.x * NWAVES + (tid_l >> 6), ngw = gridDim.x * NWAVES;
    const bool bad = poison[0] != 0;
    for (int row = gw; row < T; row += ngw) {
        const int es = lane < 8 ? tok_es[(size_t)row * 8 + lane] : 0; const float ew = lane < 8 ? tok_w[(size_t)row * 8 + lane] : 0.f;
        const bf16* xin = Xin + (size_t)row * D;
        f32x4 v[4];
#pragma unroll
        for (int j = 0; j < 4; ++j) { const uint2 d = ((const uint2*)xin)[lane + 64 * j];
            v[j] = (f32x4){__uint_as_float(d.x << 16), __uint_as_float(d.x & 0xffff0000u), __uint_as_float(d.y << 16), __uint_as_float(d.y & 0xffff0000u)} * ALPHA; }
#pragma unroll
        for (int jj = 0; jj < 9; ++jj) {
            size_t pos; float gt = 1.f;
            if (jj < 8) { const int p = __shfl(es, jj); gt = __shfl(ew, jj); pos = (size_t)tb.toff[p >> 16] * 256 + (p & 0xffff); } else pos = (size_t)tb.toff[64] * 256 + row;
            const unsigned* yr = (const unsigned*)(Y + pos * 1024); gt *= (1.f / 64.f);
            typedef float f2_ __attribute__((ext_vector_type(2)));
#pragma unroll
            for (int j = 0; j < 4; ++j) { const unsigned d = __builtin_nontemporal_load(yr + lane + 64 * j);
                const f2_ a = __builtin_amdgcn_cvt_pk_f32_fp8((int)d, false), c = __builtin_amdgcn_cvt_pk_f32_fp8((int)d, true);
                v[j][0] += gt * a[0]; v[j][1] += gt * a[1]; v[j][2] += gt * c[0]; v[j][3] += gt * c[1]; }
        }
        float s = 0.f;
#pragma unroll
        for (int j = 0; j < 4; ++j) s += (v[j][0] + v[j][1]) + (v[j][2] + v[j][3]);
        const float mean = wsumf_(s) * (1.f / D); float q = 0.f;
#pragma unroll
        for (int j = 0; j < 4; ++j) { v[j] = v[j] - mean; q += (v[j][0] * v[j][0] + v[j][1] * v[j][1]) + (v[j][2] * v[j][2] + v[j][3] * v[j][3]); }
        const float rstd = __builtin_amdgcn_rsqf(wsumf_(q) * (1.f / D) + LN_EPS);
#pragma unroll
        for (int j = 0; j < 4; ++j) {
            const f32x4 g4 = ((const f32x4*)g)[lane + 64 * j], b4 = ((const f32x4*)b)[lane + 64 * j];
            f32x4 o = v[j] * rstd * g4 + b4;
            if (bad) { const float qn = __builtin_nanf(""); o = (f32x4){qn, qn, qn, qn}; }
            if (X32) ((f32x4*)(X32 + (size_t)row * D))[lane + 64 * j] = o;
            uint2 ob; ob.x = pk2(o[0], o[1]); ob.y = pk2(o[2], o[3]); ((uint2*)(Xb + (size_t)row * D))[lane + 64 * j] = ob;
        }
    }
}
namespace attn {
typedef float f32x16 __attribute__((ext_vector_type(16)));
typedef unsigned u32x4 __attribute__((ext_vector_type(4)));
typedef int v8i __attribute__((ext_vector_type(8)));
constexpr int SLOTB = 16384, NSLOT = 4, WSF_OFF = 65536;
constexpr float THR = 2.f;
constexpr int ONE = 0x7F7F7F7F; constexpr int STG_OFF = 69632;
__device__ __forceinline__ int crow(int r, int hi) { return (r & 3) + 8 * (r >> 2) + 4 * hi; }
__device__ __forceinline__ void glds16(const void* gsrc, unsigned lds_dst) { unsigned keep;
    asm volatile("s_mov_b32 %0, m0\n\ts_mov_b32 m0, %2\n\ts_nop 0\n\tglobal_load_lds_dwordx4 %1, off\n\ts_mov_b32 m0, %0" : "=&s"(keep) : "v"(gsrc), "s"(lds_dst) : "memory"); }
#define ATT_WAIT_BAR(N) asm volatile("s_waitcnt vmcnt(" #N ") lgkmcnt(0)\n\ts_barrier" ::: "memory")
typedef short v4i16_t __attribute__((ext_vector_type(4)));
typedef short s16x4 __attribute__((ext_vector_type(4)));
__device__ __forceinline__ s16x4 vtr(const LAS unsigned char* p) { return __builtin_bit_cast(s16x4, __builtin_amdgcn_ds_read_tr16_b64_v4i16((LAS v4i16_t*)p)); }
__device__ __forceinline__ unsigned cvtpk(float lo, float hi) { typedef float f2 __attribute__((ext_vector_type(2))); typedef __bf16 b2 __attribute__((ext_vector_type(2))); f2 v = {lo, hi}; b2 b = __builtin_convertvector(v, b2); return __builtin_bit_cast(unsigned, b); }
__device__ __forceinline__ float max3f(float a, float b, float c) { float r; asm("v_max3_f32 %0, %1, %2, %3" : "=v"(r) : "v"(a), "v"(b), "v"(c)); return r; }
__device__ __forceinline__ float xhalf_max(float m) { auto rr = __builtin_amdgcn_permlane32_swap(__float_as_uint(m), __float_as_uint(m), false, false); float r; asm("v_max_f32 %0, %1, %2" : "=v"(r) : "v"(rr[0]), "v"(rr[1])); return r; }
__device__ __forceinline__ float xhalf_sum(float m) { auto rr = __builtin_amdgcn_permlane32_swap(__float_as_uint(m), __float_as_uint(m), false, false); return __uint_as_float(rr[0]) + __uint_as_float(rr[1]); }
__device__ __forceinline__ v8i mk8(const u32x4& a, const u32x4& b) { return (v8i){(int)a[0], (int)a[1], (int)a[2], (int)a[3], (int)b[0], (int)b[1], (int)b[2], (int)b[3]}; }

template <int VAR>
__device__ __forceinline__ void attn_unit(int b, int h, int qb, const unsigned char* __restrict__ Q8, const unsigned char* __restrict__ K8, const unsigned char* __restrict__ VT, bf16* Og,
                                          float lam, const float* __restrict__ subg, float oscale, LAS unsigned char* lds) {
    int tid_l = threadIdx.x; asm volatile("" : "+v"(tid_l));
    const int tid = tid_l, lane = tid & 63, r32 = lane & 31, hi = lane >> 5;
    const int wid = __builtin_amdgcn_readfirstlane(tid >> 6), mp = wid >> 2, wq = wid & 3;
    const size_t rowbase = (size_t)b * SEQ; const int q0 = qb * 128;
    const unsigned lds0 = (unsigned)(uintptr_t)lds;
    LAS float* wsf = (LAS float*)(lds + WSF_OFF) + wid * 64;
    const int kkey = 16 * wq + (lane >> 2), kcc = lane & 3;
    const unsigned char* ksrc = K8 + (rowbase + kkey) * 1024 + (h * 2 + mp) * 64 + 16 * (kcc ^ ((kkey >> 2) & 3));
    const unsigned char* vsrc = VT + ((size_t)((b * 8 + h) * 256)) * 8192 + wid * 1024 + lane * 16;
#define ATT_DMA_K(t, slot) glds16(ksrc + (size_t)(t) * 64 * 1024, (unsigned)__builtin_amdgcn_readfirstlane(lds0 + (unsigned)(slot) * SLOTB + wid * 1024))
#define ATT_DMA_V(t, slot) glds16(vsrc + (size_t)(t) * 8192, (unsigned)__builtin_amdgcn_readfirstlane(lds0 + (unsigned)(slot) * SLOTB + 8192 + wid * 1024))
    const unsigned char* Qw = Q8 + (rowbase + q0 + wq * 32 + r32) * 1024 + (h * 2 + mp) * 64 + hi * 32;
    const u32x4 qa = *(const u32x4*)(Qw), qb_ = *(const u32x4*)(Qw + 16);
    const v8i qf = mk8(qa, qb_);
    const int NT = 2 * qb + 2, tlast = 2 * qb + (wq >> 1);
    constexpr int KSL = 8192, VBASE = 4 * 8192;
#undef ATT_DMA_K
#undef ATT_DMA_V
#define ATT_DMA_K(t) glds16(ksrc + (size_t)(t) * 64 * 1024, (unsigned)__builtin_amdgcn_readfirstlane(lds0 + (unsigned)((t) & 3) * KSL + wid * 1024))
#define ATT_DMA_V(t) glds16(vsrc + (size_t)(t) * 8192, (unsigned)__builtin_amdgcn_readfirstlane(lds0 + VBASE + (unsigned)((t) & 3) * KSL + wid * 1024))
    ATT_DMA_K(0); if (NT > 1) ATT_DMA_K(1); ATT_DMA_V(0);
    int nlast = 0; if (NT > 2) { ATT_DMA_K(2); nlast += 1; } if (NT > 1) { ATT_DMA_V(1); nlast += 1; }
    f32x16 o[4];
    float zero_ = 0.f; asm volatile("" : "+v"(zero_));
#pragma unroll
    for (int d = 0; d < 4; ++d)
#pragma unroll
        for (int r = 0; r < 16; ++r) o[d][r] = zero_;
    const int sw = (r32 >> 2) & 3;
    const unsigned fua = (unsigned)(((2 * hi) ^ sw) * 16), fub = (unsigned)(((2 * hi + 1) ^ sw) * 16);
    const LAS unsigned char* kaddr0 = lds + mp * 4096 + r32 * 64; const LAS unsigned char* vaddr0 = lds + VBASE + r32 * 64;
    u32x4 kf[2][2], vf[4][2];
#define ATT_DSR128(dst, addr, off) dst = *(const LAS u32x4*)((addr) + (off))
#define ATT_KISSUE(t) do { const LAS unsigned char* ka_ = kaddr0 + ((t) & 3) * KSL; \
        ATT_DSR128(kf[0][0], ka_ + fua, 0); ATT_DSR128(kf[0][1], ka_ + fub, 0); ATT_DSR128(kf[1][0], ka_ + fua, 2048); ATT_DSR128(kf[1][1], ka_ + fub, 2048); } while (0)
#define ATT_VISSUE(t) do { const LAS unsigned char* va_ = vaddr0 + ((t) & 3) * KSL; \
        _Pragma("unroll") for (int d0 = 0; d0 < 4; ++d0) { ATT_DSR128(vf[d0][0], va_ + fua, d0 * 2048); ATT_DSR128(vf[d0][1], va_ + fub, d0 * 2048); } } while (0)
#define ATT_WB(N) asm volatile("s_waitcnt vmcnt(" #N ") lgkmcnt(0)\n\ts_barrier" ::: "memory")
#define ATT_WAITN(n) do { if ((n) == 2) { ATT_WB(2); } else if ((n) == 1) { ATT_WB(1); } else { ATT_WB(0); } __builtin_amdgcn_sched_barrier(0); } while (0)
#define ATT_SB() __builtin_amdgcn_sched_barrier(0)
#define ATT_QKM(P, blk) do { P = __builtin_amdgcn_mfma_scale_f32_32x32x64_f8f6f4(mk8(kf[blk][0], kf[blk][1]), qf, negm, 0, 0, 0, ONE, 0, ONE); if constexpr (VAR & 64) P = __builtin_amdgcn_mfma_scale_f32_32x32x64_f8f6f4(mk8(kf[blk][0], kf[blk][1]), qf, P, 0, 0, 0, ONE, 0, ONE); } while (0)
#define ATT_PVM(d0) do { o[d0] = __builtin_amdgcn_mfma_scale_f32_32x32x64_f8f6f4(pw, mk8(vf[d0][0], vf[d0][1]), o[d0], 0, 0, 0, ONE, 0, ONE); if constexpr (VAR & 64) o[d0] = __builtin_amdgcn_mfma_scale_f32_32x32x64_f8f6f4(pw, mk8(vf[d0][0], vf[d0][1]), o[d0], 0, 0, 0, ONE, 0, ONE); } while (0)
#define ATT_EXP8(P, b0) do { _Pragma("unroll") for (int r = (b0); r < (b0) + 8; ++r) P[r] = __builtin_amdgcn_exp2f(P[r]); } while (0)
#define ATT_MAXDEC(P0, P1, first) do { \
        float rm; { float ra_; \
        asm volatile("s_nop 15\n\ts_nop 7\n\t"     \
            "v_max3_f32 %0, %2, %3, %4\n\tv_max3_f32 %0, %0, %5, %6\n\tv_max3_f32 %0, %0, %7, %8\n\tv_max3_f32 %0, %0, %9, %10\n\t" \
            "v_max3_f32 %0, %0, %11, %12\n\tv_max3_f32 %0, %0, %13, %14\n\tv_max3_f32 %0, %0, %15, %16\n\tv_max3_f32 %0, %0, %17, %17" \
            : "=&v"(ra_), "+v"(P1) : "v"(P0[0]), "v"(P0[1]), "v"(P0[2]), "v"(P0[3]), "v"(P0[4]), "v"(P0[5]), "v"(P0[6]), "v"(P0[7]), "v"(P0[8]), "v"(P0[9]), "v"(P0[10]), "v"(P0[11]), "v"(P0[12]), "v"(P0[13]), "v"(P0[14]), "v"(P0[15])); \
        asm volatile("v_max3_f32 %0, %1, %2, %3\n\tv_max3_f32 %0, %0, %4, %5\n\tv_max3_f32 %0, %0, %6, %7\n\tv_max3_f32 %0, %0, %8, %9\n\t" \
            "v_max3_f32 %0, %0, %10, %11\n\tv_max3_f32 %0, %0, %12, %13\n\tv_max3_f32 %0, %0, %14, %15\n\tv_max3_f32 %0, %0, %16, %17" \
            : "=&v"(rm) : "v"(ra_), "v"(P1[0]), "v"(P1[1]), "v"(P1[2]), "v"(P1[3]), "v"(P1[4]), "v"(P1[5]), "v"(P1[6]), "v"(P1[7]), "v"(P1[8]), "v"(P1[9]), "v"(P1[10]), "v"(P1[11]), "v"(P1[12]), "v"(P1[13]), "v"(P1[14]), "v"(P1[15])); } \
        rm = xhalf_max(rm) - 6.f; \
        if (first) { _Pragma("unroll") for (int r = 0; r < 16; ++r) { P0[r] -= rm; P1[r] -= rm; negm[r] = 6.f - rm; } } \
        else if (__any(rm > THR)) { const float dl = fmaxf(rm, 0.f); const float nm_ = negm[0] - dl; \
            _Pragma("unroll") for (int r = 0; r < 16; ++r) { P0[r] -= dl; P1[r] -= dl; negm[r] = nm_; } \
            const float f = __builtin_amdgcn_exp2f(-dl); la *= f; lb *= f; if (hi == 0) wsf[r32] = f; resc = true; } } while (0)
    f32x16 pc0, pc1, negm; v8i pw; bool resc = false; float e[32]; float la = 0.f, lb = 0.f;
#pragma unroll
    for (int w = 0; w < 8; ++w) pw[w] = 0;
    ATT_WAITN(nlast);
    ATT_KISSUE(0);
    asm volatile("s_waitcnt lgkmcnt(0)\n\ts_barrier" ::: "memory"); ATT_SB();
#pragma unroll
    for (int r = 0; r < 16; ++r) negm[r] = 6.f;
    ATT_QKM(pc0, 0); ATT_QKM(pc1, 1);
    ATT_MAXDEC(pc0, pc1, true);
#define ATT_ES8(P, b0, eo, L) do { _Pragma("unroll") for (int r = 0; r < 8; ++r) { e[(eo) + r] = __builtin_amdgcn_exp2f(P[(b0) + r]); L += e[(eo) + r]; } \
        asm volatile("" : "+v"(e[(eo)]), "+v"(e[(eo) + 1]), "+v"(e[(eo) + 2]), "+v"(e[(eo) + 3]), "+v"(e[(eo) + 4]), "+v"(e[(eo) + 5]), "+v"(e[(eo) + 6]), "+v"(e[(eo) + 7]), "+v"(L)); } while (0)
#define ATT_CVT16(eo, w0) do { _Pragma("unroll") for (int w = 0; w < 4; ++w) { int x; asm volatile("" : "=v"(x)); x = __builtin_amdgcn_cvt_pk_fp8_f32(e[(eo) + 4 * w], e[(eo) + 4 * w + 1], x, false); x = __builtin_amdgcn_cvt_pk_fp8_f32(e[(eo) + 4 * w + 2], e[(eo) + 4 * w + 3], x, true); pw[(w0) + w] = x; } \
        asm volatile("" : "+v"(pw)); } while (0)
#define ATT_ISSUE_DMA(t) do { nlast = 0; if ((t) + 3 < NT) { ATT_DMA_K((t) + 3); nlast += 1; } if ((t) + 2 < NT) { ATT_DMA_V((t) + 2); nlast += 1; } } while (0)
#define ATT_PV_EXP() do { \
        ATT_PVM(0); ATT_SB(); ATT_ES8(pc0, 0, 0, la); ATT_SB(); \
        ATT_PVM(1); ATT_SB(); ATT_ES8(pc0, 8, 8, lb); ATT_SB(); \
        ATT_PVM(2); ATT_SB(); ATT_ES8(pc1, 0, 16, la); ATT_SB(); \
        ATT_PVM(3); ATT_SB(); ATT_ES8(pc1, 8, 24, lb); ATT_SB(); } while (0)
#define ATT_PV_EXP_D(t) do { \
        ATT_PVM(0); ATT_SB(); if (mp == 0) ATT_DMA_K((t) + 3); ATT_ES8(pc0, 0, 0, la); ATT_SB(); \
        ATT_PVM(1); ATT_SB(); if (mp == 1) ATT_DMA_K((t) + 3); ATT_ES8(pc0, 8, 8, lb); ATT_SB(); \
        ATT_PVM(2); ATT_SB(); if (mp == 0) ATT_DMA_V((t) + 2); ATT_ES8(pc1, 0, 16, la); ATT_SB(); \
        ATT_PVM(3); ATT_SB(); if (mp == 1) ATT_DMA_V((t) + 2); ATT_ES8(pc1, 8, 24, lb); ATT_SB(); } while (0)
#define ATT_RESC() do { if (resc) { resc = false; \
        _Pragma("unroll") for (int r = 0; r < 16; ++r) { const float fr = wsf[crow(r, hi)]; \
            _Pragma("unroll") for (int d = 0; d < 4; ++d) o[d][r] *= fr; } } } while (0)
#define ATT_CVT_ASM(eo, w0, TIE) do { int x0_, x1_, x2_, x3_; \
        asm volatile("v_cvt_pk_fp8_f32 %0, %5, %6\n\tv_cvt_pk_fp8_f32 %1, %9, %10\n\tv_cvt_pk_fp8_f32 %2, %13, %14\n\tv_cvt_pk_fp8_f32 %3, %17, %18\n\tv_cvt_pk_fp8_f32 %0, %7, %8 op_sel:[0,0,1]\n\tv_cvt_pk_fp8_f32 %1, %11, %12 op_sel:[0,0,1]\n\tv_cvt_pk_fp8_f32 %2, %15, %16 op_sel:[0,0,1]\n\tv_cvt_pk_fp8_f32 %3, %19, %20 op_sel:[0,0,1]" \
            : "=&v"(x0_), "=&v"(x1_), "=&v"(x2_), "=&v"(x3_), "+v"(TIE) : "v"(e[(eo) + 0]), "v"(e[(eo) + 1]), "v"(e[(eo) + 2]), "v"(e[(eo) + 3]), "v"(e[(eo) + 4]), "v"(e[(eo) + 5]), "v"(e[(eo) + 6]), "v"(e[(eo) + 7]), "v"(e[(eo) + 8]), "v"(e[(eo) + 9]), "v"(e[(eo) + 10]), "v"(e[(eo) + 11]), "v"(e[(eo) + 12]), "v"(e[(eo) + 13]), "v"(e[(eo) + 14]), "v"(e[(eo) + 15])); \
        pw[(w0)] = x0_; pw[(w0) + 1] = x1_; pw[(w0) + 2] = x2_; pw[(w0) + 3] = x3_; } while (0)
#define ATT_MAXDEC2(P0, P1) do { \
        ATT_CVT_ASM(0, 0, P1); ATT_CVT_ASM(16, 4, P1); \
        float rmr_; { float ra_; \
        asm volatile("s_nop 1\n\tv_max3_f32 %0, %2, %3, %4\n\tv_max3_f32 %0, %0, %5, %6\n\tv_max3_f32 %0, %0, %7, %8\n\tv_max3_f32 %0, %0, %9, %10\n\tv_max3_f32 %0, %0, %11, %12\n\tv_max3_f32 %0, %0, %13, %14\n\tv_max3_f32 %0, %0, %15, %16\n\tv_max3_f32 %0, %0, %17, %17" \
            : "=&v"(ra_), "+v"(P1) : "v"(P0[0]), "v"(P0[1]), "v"(P0[2]), "v"(P0[3]), "v"(P0[4]), "v"(P0[5]), "v"(P0[6]), "v"(P0[7]), "v"(P0[8]), "v"(P0[9]), "v"(P0[10]), "v"(P0[11]), "v"(P0[12]), "v"(P0[13]), "v"(P0[14]), "v"(P0[15])); \
        asm volatile("v_max3_f32 %0, %1, %2, %3\n\tv_max3_f32 %0, %0, %4, %5\n\tv_max3_f32 %0, %0, %6, %7\n\tv_max3_f32 %0, %0, %8, %9\n\tv_max3_f32 %0, %0, %10, %11\n\tv_max3_f32 %0, %0, %12, %13\n\tv_max3_f32 %0, %0, %14, %15\n\tv_max3_f32 %0, %0, %16, %17\n\tv_mov_b32 %1, %0\n\ts_nop 1\n\tv_permlane32_swap_b32 %0, %1\n\tv_max_f32 %0, %0, %1" \
            : "=&v"(rmr_), "+v"(ra_) : "v"(P1[0]), "v"(P1[1]), "v"(P1[2]), "v"(P1[3]), "v"(P1[4]), "v"(P1[5]), "v"(P1[6]), "v"(P1[7]), "v"(P1[8]), "v"(P1[9]), "v"(P1[10]), "v"(P1[11]), "v"(P1[12]), "v"(P1[13]), "v"(P1[14]), "v"(P1[15])); } \
        if (__any(rmr_ > THR + 6.f)) { const float dl = fmaxf(rmr_ - 6.f, 0.f); const float nm_ = negm[0] - dl;     \
            _Pragma("unroll") for (int r = 0; r < 16; ++r) { P0[r] -= dl; P1[r] -= dl; negm[r] = nm_; } \
            const float f = __builtin_amdgcn_exp2f(-dl); la *= f; lb *= f; if (hi == 0) wsf[r32] = f; resc = true; } } while (0)
#define ATT_QK_NEXT(t) do { \
        ATT_QKM(pc0, 0); ATT_SB(); \
        ATT_QKM(pc1, 1); ATT_SB(); \
        ATT_MAXDEC2(pc0, pc1); } while (0)
    {
        ATT_ISSUE_DMA(0);
        if (1 <= tlast) ATT_KISSUE(1);
        ATT_ES8(pc0, 0, 0, la); ATT_ES8(pc0, 8, 8, lb); ATT_ES8(pc1, 0, 16, la); ATT_ES8(pc1, 8, 24, lb);
        ATT_VISSUE(0);
        if (1 <= tlast) ATT_QK_NEXT(0); else { ATT_CVT16(0, 0); ATT_CVT16(16, 4); }
        ATT_WAITN(nlast);
    }
    int t = 1;
#define ATT_KISSUE_S(sl) do { const LAS unsigned char* ka_ = kaddr0 + (sl) * KSL; \
        ATT_DSR128(kf[0][0], ka_ + fua, 0); ATT_DSR128(kf[0][1], ka_ + fub, 0); ATT_DSR128(kf[1][0], ka_ + fua, 2048); ATT_DSR128(kf[1][1], ka_ + fub, 2048); } while (0)
#define ATT_VISSUE_S(sl) do { const LAS unsigned char* va_ = vaddr0 + (sl) * KSL; \
        _Pragma("unroll") for (int d0 = 0; d0 < 4; ++d0) { ATT_DSR128(vf[d0][0], va_ + fua, d0 * 2048); ATT_DSR128(vf[d0][1], va_ + fub, d0 * 2048); } } while (0)
#define ATT_DMA_K_S(tt, sl) glds16(ksrc + (size_t)(tt) * 64 * 1024, (unsigned)__builtin_amdgcn_readfirstlane(lds0 + (unsigned)(sl) * KSL + wid * 1024))
#define ATT_DMA_V_S(tt, sl) glds16(vsrc + (size_t)(tt) * 8192, (unsigned)__builtin_amdgcn_readfirstlane(lds0 + VBASE + (unsigned)(sl) * KSL + wid * 1024))
#define ATT_STEP_S(tt, c) do { \
        ATT_KISSUE_S(((c) + 1) & 3); ATT_SB(); \
        ATT_PVM(0); ATT_SB(); ATT_DMA_K_S((tt) + 3, ((c) + 3) & 3); ATT_ES8(pc0, 0, 0, la); ATT_SB(); \
        ATT_PVM(1); ATT_SB(); ATT_ES8(pc0, 8, 8, lb); ATT_SB(); \
        ATT_PVM(2); ATT_SB(); ATT_DMA_V_S((tt) + 2, ((c) + 2) & 3); ATT_ES8(pc1, 0, 16, la); ATT_SB(); \
        ATT_PVM(3); ATT_SB(); ATT_ES8(pc1, 8, 24, lb); ATT_SB(); \
        ATT_RESC(); \
        ATT_VISSUE_S((c) & 3); \
        ATT_QK_NEXT(tt); \
        ATT_WB(2); ATT_SB(); } while (0)
    const int nst = tlast < NT - 3 ? tlast : NT - 3;
#pragma unroll 1
    for (; t + 3 < nst; t += 4) { ATT_STEP_S(t, 1); ATT_STEP_S(t + 1, 2); ATT_STEP_S(t + 2, 3); ATT_STEP_S(t + 3, 0); }
    for (; t < tlast && t + 3 < NT; ++t) {
        ATT_KISSUE(t + 1); ATT_SB();
        ATT_PV_EXP_D(t);
        ATT_RESC();
        ATT_VISSUE(t);
        ATT_QK_NEXT(t);
        ATT_WB(2); ATT_SB();
    }
    for (; t < tlast; ++t) {
        ATT_ISSUE_DMA(t);
        ATT_KISSUE(t + 1); ATT_SB();
        ATT_PV_EXP();
        ATT_RESC();
        ATT_VISSUE(t);
        ATT_QK_NEXT(t);
        ATT_WAITN(nlast);
    }
    if (tlast >= 1) {
        ATT_ISSUE_DMA(tlast);
        ATT_PV_EXP();
        ATT_RESC();
        ATT_VISSUE(tlast);
        ATT_CVT16(0, 0); ATT_CVT16(16, 4);
        ATT_WAITN(nlast);
    }
    if (tlast + 1 < NT) {
        ATT_ISSUE_DMA(tlast + 1);
        ATT_PVM(0); ATT_PVM(1); ATT_PVM(2); ATT_PVM(3);
        ATT_WAITN(nlast);
    } else { ATT_PVM(0); ATT_PVM(1); ATT_PVM(2); ATT_PVM(3); }
    float l_reg = xhalf_sum(la + lb);
    if (hi == 0) wsf[32 + r32] = l_reg;
    asm volatile("s_waitcnt lgkmcnt(0)" ::: "memory");
    float rli[16];
#pragma unroll
    for (int r = 0; r < 16; ++r) rli[r] = 0.0625f * __builtin_amdgcn_rcpf(wsf[32 + crow(r, hi)]);
    ATT_WAIT_BAR(0);
    LAS float* xo = (LAS float*)(lds + wq * 16384) + lane;
    if (mp == 1) {
#pragma unroll
        for (int d = 0; d < 4; ++d)
#pragma unroll
            for (int r = 0; r < 16; ++r) xo[(d * 16 + r) * 64] = o[d][r] * rli[r];
    }
    ATT_WAIT_BAR(0);
    float ss[16];
#pragma unroll
    for (int r = 0; r < 16; ++r) ss[r] = 0.f;
    if (mp == 0) {
#pragma unroll
        for (int d = 0; d < 4; ++d)
#pragma unroll
            for (int r = 0; r < 16; ++r) { const float v = o[d][r] * rli[r] - lam * xo[(d * 16 + r) * 64]; o[d][r] = v; ss[r] += v * v; }
#pragma unroll
        for (int r = 0; r < 16; ++r) { float s = ss[r]; s += __shfl_xor(s, 1); s += __shfl_xor(s, 2); s += __shfl_xor(s, 4); s += __shfl_xor(s, 8); s += __shfl_xor(s, 16);
            ss[r] = oscale * __builtin_amdgcn_rsqf(s * (1.f / 128.f) + LN_EPS); }
        asm volatile("s_waitcnt lgkmcnt(0)" ::: "memory");
    }
    ATT_WAIT_BAR(0);
    if (mp == 0) {
        LAS unsigned short* stg = (LAS unsigned short*)(lds + STG_OFF + wq * 8192);
#pragma unroll
        for (int d = 0; d < 4; ++d) { const float gsc = subg[d * 32 + r32];
#pragma unroll
            for (int r = 0; r < 16; ++r) stg[crow(r, hi) * 128 + d * 32 + r32] = (unsigned short)f2bf(o[d][r] * ss[r] * gsc); }
        asm volatile("s_waitcnt lgkmcnt(0)" ::: "memory");
        bf16* Ow = Og + (rowbase + q0 + wq * 32) * 1024 + h * 128;
#pragma unroll
        for (int i = 0; i < 8; ++i) { const int row = 4 * i + (lane >> 4), ch = lane & 15;
            const u32x4 v = *(const LAS u32x4*)(stg + row * 128 + ch * 8);
            *(u32x4*)(Ow + (size_t)row * 1024 + ch * 8) = v; }
    }
#undef ATT_DMA_K
#undef ATT_DMA_V
}
template <int VAR = 0>
__device__ __forceinline__ void attn_phase(const unsigned char* Q8, const unsigned char* K8, const unsigned char* VT, bf16* Og, float lam, const float* subg, float oscale, LAS unsigned char* lds) {
    const int G = gridDim.x, bx = blockIdx.x, vcu = (G % 8 == 0) ? (bx % 8) * (G / 8) + bx / 8 : bx;
    for (int v = vcu; v < 256; v += G) {
        const int bh = v >> 4, s = v & 15;
#pragma unroll 1
        for (int i = 0; i < 8; ++i) {
            const int qb = (i >> 1) * 32 + ((i & 1) ? 31 - s : s);
            attn_unit<VAR>(bh >> 3, bh & 7, qb, Q8, K8, VT, Og, lam, subg, oscale, lds);
        }
    }
}
}

namespace hgrn {
typedef short bf16x8 __attribute__((ext_vector_type(8)));
typedef short s16x4 __attribute__((ext_vector_type(4)));
typedef float f32x16 __attribute__((ext_vector_type(16)));
typedef unsigned u32x4 __attribute__((ext_vector_type(4)));
typedef unsigned u32x2 __attribute__((ext_vector_type(2)));
constexpr int L_WT = 0, L_BM = 4096, L_KT = 8192, L_VT = 24576, L_QB = 40960, L_KB = 57344, L_QT = 73728, L_SSQ = 90624;
constexpr int QT_PITCH = 264;
using attn::crow; using attn::vtr; using attn::cvtpk;

__device__ __forceinline__ void chunk_cumsum(float (&v)[16], int lane, int wave, int seg, LAS unsigned char* lds) {
    LAS float* WT = (LAS float*)(lds + L_WT);
#pragma unroll
    for (int off = 8; off < 64; off <<= 1)
#pragma unroll
        for (int i = 0; i < 16; ++i) { const float n = __shfl_up(v[i], off); if (lane >= off) v[i] += n; }
    if (lane >= 56) {
#pragma unroll
        for (int i = 0; i < 16; ++i) WT[wave * 128 + seg * 16 + i] = v[i];
    }
    __syncthreads();
    for (int w = 0; w < wave; ++w) {
#pragma unroll
        for (int i = 0; i < 16; i += 4) { const f32x4 a = *(const LAS f32x4*)(WT + w * 128 + seg * 16 + i); v[i] += a[0]; v[i + 1] += a[1]; v[i + 2] += a[2]; v[i + 3] += a[3]; }
    }
}
__device__ __forceinline__ void unpack16(const u32x4& a, const u32x4& b, float (&o)[16]) {
#pragma unroll
    for (int i = 0; i < 4; ++i) { o[2 * i] = __uint_as_float(a[i] << 16); o[2 * i + 1] = __uint_as_float(a[i] & 0xffff0000u); o[8 + 2 * i] = __uint_as_float(b[i] << 16); o[8 + 2 * i + 1] = __uint_as_float(b[i] & 0xffff0000u); }
}
__device__ __forceinline__ void pack16(const float (&v)[16], u32x4& a, u32x4& b) {
#pragma unroll
    for (int i = 0; i < 4; ++i) { a[i] = cvtpk(v[2 * i], v[2 * i + 1]); b[i] = cvtpk(v[8 + 2 * i], v[8 + 2 * i + 1]); }
}
__device__ __forceinline__ int tr_off(int s, int seg) { return ((seg >> 1) * 4 + (s >> 4)) * 1024 + (s & 15) * 64 + (seg & 1) * 32; }

__device__ __forceinline__ void passA(const bf16* Kh, const bf16* LG, const bf16* Vh, bf16* Ufrag, float* Dbuf, LAS unsigned char* lds) {
    int tid_l = threadIdx.x; asm volatile("" : "+v"(tid_l));
    const int tid = tid_l, lane = tid & 63, wave = __builtin_amdgcn_readfirstlane(tid >> 6), t = tid >> 3, seg = tid & 7, hi = lane >> 5;
    LAS float* BL = (LAS float*)(lds + L_BM);
    for (int unit = blockIdx.x; unit < 4096; unit += gridDim.x) {
        const int bh = unit >> 8, c = unit & 255;
        const size_t ro = ((size_t)(bh >> 3) * SEQ + c * 64 + t) * 1024 + (bh & 7) * 128 + seg * 16;
        float b[16];
        { const u32x4 l0 = *(const u32x4*)(LG + ro), l1 = *(const u32x4*)(LG + ro + 8); unpack16(l0, l1, b); }
        const u32x4 k0 = *(const u32x4*)(Kh + ro), k1 = *(const u32x4*)(Kh + ro + 8), v0 = *(const u32x4*)(Vh + ro), v1 = *(const u32x4*)(Vh + ro + 8);
        chunk_cumsum(b, lane, wave, seg, lds);
        if (t == 63) {
#pragma unroll
            for (int i = 0; i < 16; ++i) { BL[seg * 16 + i] = b[i]; Dbuf[(size_t)unit * 128 + seg * 16 + i] = __expf(b[i]); }
        }
        __syncthreads();
        float kk[16]; unpack16(k0, k1, kk);
#pragma unroll
        for (int i = 0; i < 16; ++i) kk[i] *= __expf(BL[seg * 16 + i] - b[i]);
        u32x4 ka, kb_; pack16(kk, ka, kb_);
        const int to = tr_off(t, seg);
        *(LAS u32x4*)(lds + L_KT + to) = ka; *(LAS u32x4*)(lds + L_KT + to + 16) = kb_;
        *(LAS u32x4*)(lds + L_VT + to) = v0; *(LAS u32x4*)(lds + L_VT + to + 16) = v1;
        __syncthreads();
        const int db = wave >> 1, eb0 = (wave & 1) * 2;
        const int fo = ((lane >> 4) & 1) * 32 + (lane & 3) * 8 + (4 * hi + ((lane & 15) >> 2)) * 64;
        f32x16 u[2];
#pragma unroll
        for (int x = 0; x < 2; ++x)
#pragma unroll
            for (int r = 0; r < 16; ++r) u[x][r] = 0.f;
#pragma unroll
        for (int ks = 0; ks < 4; ++ks) {
            const LAS unsigned char* ap = lds + L_KT + (db * 4 + ks) * 1024 + fo;
            const s16x4 al = vtr(ap), ah = vtr(ap + 512);
            const bf16x8 af = (bf16x8){al[0], al[1], al[2], al[3], ah[0], ah[1], ah[2], ah[3]};
#pragma unroll
            for (int x = 0; x < 2; ++x) {
                const LAS unsigned char* bp = lds + L_VT + ((eb0 + x) * 4 + ks) * 1024 + fo;
                const s16x4 bl = vtr(bp), bhh = vtr(bp + 512);
                const bf16x8 bfr = (bf16x8){bl[0], bl[1], bl[2], bl[3], bhh[0], bhh[1], bhh[2], bhh[3]};
                u[x] = __builtin_amdgcn_mfma_f32_32x32x16_bf16(af, bfr, u[x], 0, 0, 0);
            }
        }
#pragma unroll
        for (int x = 0; x < 2; ++x) {
            u32x4 a, b2;
#pragma unroll
            for (int i = 0; i < 4; ++i) { a[i] = cvtpk(u[x][2 * i], u[x][2 * i + 1]); b2[i] = cvtpk(u[x][8 + 2 * i], u[x][8 + 2 * i + 1]); }
            bf16* up = Ufrag + (((size_t)unit * 16 + db * 4 + eb0 + x) * 64 + lane) * 16;
            *(u32x4*)up = a; *(u32x4*)(up + 8) = b2;
        }
        __syncthreads();
    }
}
__device__ __forceinline__ void passB(const bf16* Ufrag, const float* Dbuf, bf16* Sfrag) {
    int tid_l = threadIdx.x; asm volatile("" : "+v"(tid_l));
    const int tid = tid_l;
    if (tid >= 256) return;
    for (int i = blockIdx.x * 256 + tid; i < 65536; i += gridDim.x * 256) {
        const int seq = i >> 12, rem = i & 4095, tile = rem >> 8, lane = (rem >> 2) & 63, g = rem & 3;
        const int d0 = 32 * (tile >> 2) + 8 * g + 4 * (lane >> 5);
        const size_t eo = (((size_t)seq * 256 * 16 + tile) * 64 + lane) * 16 + 4 * g;
        const float* dp = Dbuf + (size_t)seq * 256 * 128 + d0;
        float s0 = 0.f, s1 = 0.f, s2 = 0.f, s3 = 0.f;
        for (int c0 = 0; c0 < 256; c0 += 8) {
            u32x2 uu[8]; f32x4 dd[8];
#pragma unroll
            for (int j = 0; j < 8; ++j) { uu[j] = *(const u32x2*)(Ufrag + eo + (size_t)(c0 + j) * 16384); dd[j] = *(const f32x4*)(dp + (size_t)(c0 + j) * 128); }
#pragma unroll
            for (int j = 0; j < 8; ++j) {
                u32x2 so; so[0] = cvtpk(s0, s1); so[1] = cvtpk(s2, s3);
                *(u32x2*)(Sfrag + eo + (size_t)(c0 + j) * 16384) = so;
                s0 = dd[j][0] * s0 + __uint_as_float(uu[j][0] << 16); s1 = dd[j][1] * s1 + __uint_as_float(uu[j][0] & 0xffff0000u);
                s2 = dd[j][2] * s2 + __uint_as_float(uu[j][1] << 16); s3 = dd[j][3] * s3 + __uint_as_float(uu[j][1] & 0xffff0000u);
            }
        }
    }
}
template <int PARTS = 7>
__device__ __forceinline__ void passC(const bf16* Qh, const bf16* Kh, const bf16* LG, const bf16* Vh, const bf16* Gh, const bf16* Sfrag, const float* ng, bf16* Oh, LAS unsigned char* lds) {
    int tid_l = threadIdx.x; asm volatile("" : "+v"(tid_l));
    const int tid = tid_l, lane = tid & 63, wave = __builtin_amdgcn_readfirstlane(tid >> 6), t = tid >> 3, seg = tid & 7, hi = lane >> 5, r32 = lane & 31;
    const int tb = wave >> 2, eb = wave & 3;
    LAS float* BM = (LAS float*)(lds + L_BM); LAS float* SSQ = (LAS float*)(lds + L_SSQ);
    const float ngl = ng[eb * 32 + r32];
    for (int unit = blockIdx.x; unit < 4096; unit += gridDim.x) {
        const int bh = unit >> 8, c = unit & 255;
        const size_t rb = ((size_t)(bh >> 3) * SEQ + c * 64) * 1024 + (bh & 7) * 128;
        const size_t ro = rb + (size_t)t * 1024 + seg * 16;
        float b[16];
        { const u32x4 l0 = *(const u32x4*)(LG + ro), l1 = *(const u32x4*)(LG + ro + 8); unpack16(l0, l1, b); }
        const u32x4 q0 = *(const u32x4*)(Qh + ro), q1 = *(const u32x4*)(Qh + ro + 8), k0 = *(const u32x4*)(Kh + ro), k1 = *(const u32x4*)(Kh + ro + 8);
        const u32x4 v0 = *(const u32x4*)(Vh + ro), v1 = *(const u32x4*)(Vh + ro + 8);
        u32x4 sf[4][2];
#pragma unroll
        for (int db = 0; db < 4; ++db) { const bf16* sp = Sfrag + (((size_t)unit * 16 + db * 4 + eb) * 64 + lane) * 16; sf[db][0] = *(const u32x4*)sp; sf[db][1] = *(const u32x4*)(sp + 8); }
        float gate[16];
#pragma unroll
        for (int r = 0; r < 16; ++r) gate[r] = bf2f(Gh[rb + (size_t)(32 * tb + crow(r, hi)) * 1024 + eb * 32 + r32]);
        chunk_cumsum(b, lane, wave, seg, lds);
        if (t == 31) {
#pragma unroll
            for (int i = 0; i < 16; ++i) BM[seg * 16 + i] = b[i];
        }
        __syncthreads();
        {
            float qq[16], kk[16], qt[16]; unpack16(q0, q1, qq); unpack16(k0, k1, kk);
#pragma unroll
            for (int i = 0; i < 16; ++i) { const float bm = BM[seg * 16 + i]; qt[i] = qq[i] * __expf(b[i]); qq[i] *= __expf(b[i] - bm); kk[i] *= __expf(bm - b[i]); }
            u32x4 a0, a1; pack16(qq, a0, a1);
            *(LAS u32x4*)(lds + L_QB + (seg * 2) * 1024 + t * 16) = a0; *(LAS u32x4*)(lds + L_QB + (seg * 2 + 1) * 1024 + t * 16) = a1;
            pack16(kk, a0, a1);
            *(LAS u32x4*)(lds + L_KB + (seg * 2) * 1024 + t * 16) = a0; *(LAS u32x4*)(lds + L_KB + (seg * 2 + 1) * 1024 + t * 16) = a1;
            pack16(qt, a0, a1);
            LAS unsigned char* qp = lds + L_QT + t * QT_PITCH + seg * 32;
            *(LAS u32x2*)(qp) = (u32x2){a0[0], a0[1]}; *(LAS u32x2*)(qp + 8) = (u32x2){a0[2], a0[3]}; *(LAS u32x2*)(qp + 16) = (u32x2){a1[0], a1[1]}; *(LAS u32x2*)(qp + 24) = (u32x2){a1[2], a1[3]};
            const int to = tr_off(t, seg);
            *(LAS u32x4*)(lds + L_VT + to) = v0; *(LAS u32x4*)(lds + L_VT + to + 16) = v1;
        }
        __syncthreads();
        if constexpr ((PARTS & 2) == 0) { if (b[0] == 12345.678f) Oh[rb] = 1; __syncthreads(); continue; }
        f32x16 p[2];
#pragma unroll
        for (int x = 0; x < 2; ++x)
#pragma unroll
            for (int r = 0; r < 16; ++r) p[x][r] = 0.f;
#pragma unroll
        for (int sb = 0; sb < 2; ++sb) {
            if (sb <= tb) {
#pragma unroll
                for (int d0 = 0; d0 < 8; ++d0) {
                    const bf16x8 ka = *(const LAS bf16x8*)(lds + L_KB + (2 * d0 + hi) * 1024 + (32 * sb + r32) * 16);
                    const bf16x8 qb_ = *(const LAS bf16x8*)(lds + L_QB + (2 * d0 + hi) * 1024 + (32 * tb + r32) * 16);
                    p[sb] = __builtin_amdgcn_mfma_f32_32x32x16_bf16(ka, qb_, p[sb], 0, 0, 0);
                }
            }
        }
        if (tb == 0) {
#pragma unroll
            for (int r = 0; r < 16; ++r) if (crow(r, hi) > r32) p[0][r] = 0.f;
        } else {
#pragma unroll
            for (int r = 0; r < 16; ++r) if (crow(r, hi) > r32) p[1][r] = 0.f;
        }
        u32x4 pw[4];
#pragma unroll
        for (int i = 0; i < 4; ++i) { pw[0][i] = cvtpk(p[0][2 * i], p[0][2 * i + 1]); pw[1][i] = cvtpk(p[0][8 + 2 * i], p[0][8 + 2 * i + 1]); pw[2][i] = cvtpk(p[1][2 * i], p[1][2 * i + 1]); pw[3][i] = cvtpk(p[1][8 + 2 * i], p[1][8 + 2 * i + 1]); }
        f32x16 o;
#pragma unroll
        for (int r = 0; r < 16; ++r) o[r] = 0.f;
        const int fo = ((lane >> 4) & 1) * 32 + (lane & 3) * 8 + (4 * hi + ((lane & 15) >> 2)) * 64;
#pragma unroll
        for (int ks = 0; ks < 4; ++ks) {
            if (ks < 2 * (tb + 1)) {
                const LAS unsigned char* bp = lds + L_VT + (eb * 4 + ks) * 1024 + fo;
                const s16x4 bl = vtr(bp), bhh = vtr(bp + 512);
                const bf16x8 vf = (bf16x8){bl[0], bl[1], bl[2], bl[3], bhh[0], bhh[1], bhh[2], bhh[3]};
                o = __builtin_amdgcn_mfma_f32_32x32x16_bf16(__builtin_bit_cast(bf16x8, pw[ks]), vf, o, 0, 0, 0);
            }
        }
#pragma unroll
        for (int s8 = 0; s8 < 8; ++s8) {
            const int db = s8 >> 1, half = s8 & 1;
            const LAS unsigned char* qp = lds + L_QT + (32 * tb + r32) * QT_PITCH + (32 * db + 16 * half + 4 * hi) * 2;
            const u32x2 lo = *(const LAS u32x2*)qp, hh = *(const LAS u32x2*)(qp + 16);
            const u32x4 af = (u32x4){lo[0], lo[1], hh[0], hh[1]};
            o = __builtin_amdgcn_mfma_f32_32x32x16_bf16(__builtin_bit_cast(bf16x8, af), __builtin_bit_cast(bf16x8, sf[db][half]), o, 0, 0, 0);
        }
        if constexpr ((PARTS & 4) == 0) { if (o[0] == 12345.678f) Oh[rb] = 1; __syncthreads(); continue; }
        float ssr[16];
#pragma unroll
        for (int r = 0; r < 16; ++r) { float s = o[r] * o[r]; s += __shfl_xor(s, 1); s += __shfl_xor(s, 2); s += __shfl_xor(s, 4); s += __shfl_xor(s, 8); s += __shfl_xor(s, 16); ssr[r] = s; }
        if (r32 == 0) {
#pragma unroll
            for (int r = 0; r < 16; ++r) SSQ[wave * 32 + crow(r, hi)] = ssr[r];
        }
        __syncthreads();
        bf16* op = Oh + rb + (size_t)(32 * tb) * 1024 + eb * 32 + r32;
#pragma unroll
        for (int r = 0; r < 16; ++r) {
            const int row = crow(r, hi);
            const float tot = SSQ[(tb * 4 + 0) * 32 + row] + SSQ[(tb * 4 + 1) * 32 + row] + SSQ[(tb * 4 + 2) * 32 + row] + SSQ[(tb * 4 + 3) * 32 + row];
            const float rstd = __builtin_amdgcn_rsqf(tot * (1.f / 128.f) + LN_EPS);
            op[(size_t)row * 1024] = (bf16)f2bf(o[r] * rstd * ngl * gate[r]);
        }
        __syncthreads();
    }
}
}


#define XB_TMO      128
#define XB_XCNT(j)  (256  + 64 * (j))
#define XB_XSUB(j)  (1280 + 64 * (j))
#define XB_XGEN(j)  (2304 + 64 * (j))
#define XB_TOP      3328
#define XB_TOPGEN   3392
#define XCD_BAR_WORDS 3456
#define XB_SPIN_CAP (1u << 18)

__device__ __forceinline__ unsigned xb_ld(unsigned* p)              { return __hip_atomic_load(p, __ATOMIC_RELAXED, __HIP_MEMORY_SCOPE_AGENT); }
__device__ __forceinline__ unsigned xb_add(unsigned* p, unsigned v) { return __hip_atomic_fetch_add(p, v, __ATOMIC_RELAXED, __HIP_MEMORY_SCOPE_AGENT); }
__device__ __forceinline__ unsigned xb_xcc_id() { return (unsigned)__builtin_amdgcn_s_getreg((3 << 11) | 20) & 0xFu; }
#define XB_SPIN(cond, bar) do { unsigned _sp = 0; while (cond) { __builtin_amdgcn_s_sleep(1); \
    if ((++_sp & 255u) == 0u) { if (xb_ld(&(bar)[XB_TMO])) break; if (_sp > XB_SPIN_CAP) { atomicAdd(&(bar)[XB_TMO], 1u); break; } } } } while (0)

struct XcdBarrier {
    unsigned* bar; unsigned x;
    volatile LAS unsigned* st;
};

__device__ __forceinline__ XcdBarrier xcd_barrier_post(unsigned* bar, volatile LAS unsigned* st) {
    XcdBarrier b; b.bar = bar; b.x = xb_xcc_id(); b.st = st;
    if (threadIdx.x == 0) (void)xb_add(&bar[XB_XCNT(b.x)], 1u);
    return b;
}
__device__ __forceinline__ void xcd_barrier_complete(unsigned* bar, unsigned x, unsigned& nloc, unsigned& nx) {
    const unsigned G = gridDim.x * gridDim.y * gridDim.z;
    unsigned sum, cnt, mine, sp = 0u;
    for (;;) {
        sum = 0u; cnt = 0u; mine = 0u;
#pragma unroll
        for (unsigned j = 0; j < 16; ++j) { const unsigned c = xb_ld(&bar[XB_XCNT(j)]); sum += c; cnt += (c > 0u) ? 1u : 0u; mine = (j == x) ? c : mine; }
        if (sum == G) break;
        __builtin_amdgcn_s_sleep(1);
        if ((++sp & 255u) == 0u) { if (xb_ld(&bar[XB_TMO])) break; if (sp > XB_SPIN_CAP) { atomicAdd(&bar[XB_TMO], 1u); break; } }
    }
    nloc = mine > 0u ? mine : 1u; nx = cnt > 0u ? cnt : 1u;
}

__device__ __forceinline__ void xcd_barrier(const XcdBarrier& b) {
    asm volatile("s_waitcnt vmcnt(0)" ::: "memory");
    __syncthreads();
    if (threadIdx.x == 0) {
        unsigned* bar = b.bar;
        __builtin_amdgcn_s_waitcnt(0);
        unsigned nloc = b.st[0], nx = b.st[1];
        if (nloc == 0u) { xcd_barrier_complete(bar, b.x, nloc, nx); b.st[0] = nloc; b.st[1] = nx; }
        const unsigned old = xb_add(&bar[XB_XSUB(b.x)], 1u);
        const unsigned gen = old / nloc;
        if (old + 1u == (gen + 1u) * nloc) {
            __builtin_amdgcn_fence(__ATOMIC_RELEASE, "agent");
            asm volatile("s_waitcnt vmcnt(0)" ::: "memory");
            const unsigned og = xb_add(&bar[XB_TOP], 1u);
            const unsigned tg = og / nx;
            if (og + 1u == (tg + 1u) * nx) xb_add(&bar[XB_TOPGEN], 1u);
            else XB_SPIN(xb_ld(&bar[XB_TOPGEN]) == tg, bar);
            __builtin_amdgcn_fence(__ATOMIC_ACQUIRE, "agent");
            xb_add(&bar[XB_XGEN(b.x)], 1u);
            asm volatile("s_waitcnt vmcnt(0)" ::: "memory");
        } else {
            XB_SPIN(xb_ld(&bar[XB_XGEN(b.x)]) == gen, bar);
            __builtin_amdgcn_fence(__ATOMIC_ACQUIRE, "agent");
            asm volatile("s_waitcnt vmcnt(0)" ::: "memory");
        }
    }
    __syncthreads();
}

constexpr int BAR_LDS_OFF = LDS_BYTES - 64;
constexpr int CTL_BAR = 4096;

#ifndef HGC_PROBE_PARTS
#define HGC_PROBE_PARTS 7
#endif
#ifndef PROBE_MASK
#define PROBE_MASK 0
#endif
#define PROBE_REP(bit) for (int rep_ = 0; rep_ < (((PROBE_MASK) & (bit)) ? 2 : 1); ++rep_)
struct Params { Inputs in; WS w; float* X; };
typedef const __attribute__((address_space(4))) Params CParams;
template <int MODE>
__device__ __forceinline__ void mv_probe(int* ctl, int lane) {
    v8i_ A, B;
#pragma unroll
    for (int w = 0; w < 8; ++w) { A[w] = 0x30303030 + (lane & 7) * 0x01010101; B[w] = 0x31313131 + (lane & 3) * 0x01010101; }
    v16f_ acc[4];
#pragma unroll
    for (int d = 0; d < 4; ++d)
#pragma unroll
        for (int r = 0; r < 16; ++r) acc[d][r] = 0.f;
    float x[8];
#pragma unroll
    for (int i = 0; i < 8; ++i) x[i] = -(float)(lane + i) * 0.01f;
    float s = 0.f;
#pragma unroll 1
    for (int it = 0; it < 2048; ++it) {
#pragma unroll
        for (int d = 0; d < 4; ++d) {
            if constexpr ((MODE & 1) != 0) { acc[d] = __builtin_amdgcn_mfma_scale_f32_32x32x64_f8f6f4(A, B, acc[d], 0, 0, 0, 0x7F7F7F7F, 0, 0x7F7F7F7F); __builtin_amdgcn_sched_barrier(0); }
            if constexpr ((MODE & 2) != 0) {
                asm volatile("" : "+v"(x[0]), "+v"(x[1]), "+v"(x[2]), "+v"(x[3]), "+v"(x[4]), "+v"(x[5]), "+v"(x[6]), "+v"(x[7]));
                float e[8];
#pragma unroll
                for (int i = 0; i < 8; ++i) { e[i] = __builtin_amdgcn_exp2f(x[i]); s += e[i]; }
                asm volatile("" : "+v"(e[0]), "+v"(e[1]), "+v"(e[2]), "+v"(e[3]), "+v"(e[4]), "+v"(e[5]), "+v"(e[6]), "+v"(e[7]), "+v"(s));
                __builtin_amdgcn_sched_barrier(0);
            }
        }
    }
    float t = s;
#pragma unroll
    for (int d = 0; d < 4; ++d)
#pragma unroll
        for (int r = 0; r < 16; ++r) t += acc[d][r];
    if (t == 12345.678f) ctl[CTL_POISON + 8] = 1;
}
#define KP() ({ CParams* kp_ = (CParams*)__builtin_amdgcn_kernarg_segment_ptr(); asm volatile("" : "+s"(kp_)); kp_; })

__global__ void __launch_bounds__(NTHREADS, 2) k_fwd(Params unused_by_name) {
#if defined(__HIP_DEVICE_COMPILE__)
    extern __shared__ __attribute__((aligned(16))) unsigned char lds_raw[];
    LAS unsigned char* lds = (LAS unsigned char*)lds_raw;
    const int tid = threadIdx.x;
    volatile LAS unsigned* bst = (volatile LAS unsigned*)(lds + BAR_LDS_OFF);
    if (tid == 0) { bst[0] = 0u; bst[1] = 0u; }
    __syncthreads();
    (void)xcd_barrier_post((unsigned*)(KP()->w.ctl + CTL_BAR), bst);
#define GRID_BAR() do { XcdBarrier b_; b_.bar = (unsigned*)(KP()->w.ctl + CTL_BAR); b_.x = xb_xcc_id(); b_.st = bst; xcd_barrier(b_); } while (0)
    if constexpr (((PROBE_MASK) & 2048) != 0) { mv_probe<((PROBE_MASK) >> 12) & 3>(KP()->w.ctl, tid & 63); }
    PROBE_REP(256) { CParams* kp = KP(); const Inputs in = kp->in; const WS w = kp->w; prologue_phase(in, w, kp->X, lds); }
    GRID_BAR();
#pragma unroll 1
    for (int layer = 0; layer < DEPTH; ++layer) {
        const int j = layer >> 1;
        if ((layer & 1) == 0) {
            {
                CParams* kp = KP();
                pg8::Gemm g{kp->w.Xb, kp->w.Wqkv_t + (size_t)j * 3072 * D, T, 2048, D}; pg8::StaticOrder S; S.init(T, 2048, gridDim.x, blockIdx.x);
                pg8::EpiQK8 E{(unsigned char*)kp->w.Qb, kp->w.rot};
                pg8::gemm_phase<pg8::EpiQK8, pg8::StaticOrder, true, true>(lds, g, S, E);
            }
            {
                CParams* kp = KP();
                pg8::Gemm g{kp->w.Wqkv_t + (size_t)j * 3072 * D + (size_t)2048 * D, kp->w.Xb, D, T, D}; pg8::StaticOrder S; S.init(D, T, gridDim.x, blockIdx.x);
                pg8::EpiVT E{(unsigned char*)kp->w.Vb};
                pg8::gemm_phase<pg8::EpiVT, pg8::StaticOrder, true, true>(lds, g, S, E);
            }
            GRID_BAR();
#ifdef ATT_PROBE_VAR
            {
                CParams* kp = KP();
                attn::attn_phase<ATT_PROBE_VAR>((const unsigned char*)kp->w.Qb, (const unsigned char*)kp->w.Qb + (size_t)T * 1024, (const unsigned char*)kp->w.Vb, (bf16*)kp->w.V32, kp->w.lbtab[2048 + j], kp->in.p[4] + (size_t)j * 128, 1.f, lds);
            }
            GRID_BAR();
#endif
            PROBE_REP(1) {
                CParams* kp = KP();
                attn::attn_phase((const unsigned char*)kp->w.Qb, (const unsigned char*)kp->w.Qb + (size_t)T * 1024, (const unsigned char*)kp->w.Vb, kp->w.Ob, kp->w.lbtab[2048 + j], kp->in.p[4] + (size_t)j * 128, 1.f - (0.8f - 0.6f * __expf(-0.3f * (float)layer)), lds);
            }
            GRID_BAR();
        } else {
            PROBE_REP(8) {
                CParams* kp = KP();
                pg8::Gemm g{kp->w.Xb, kp->w.Hin_t + (size_t)j * 4096 * D, T, 4096, D}; pg8::StaticOrder S; S.init(T, 4096, gridDim.x, blockIdx.x);
                pg8::EpiHin E{kp->w.Qb, (bf16*)kp->w.LG, kp->w.lbtab + j * 1024};
                pg8::gemm_phase<pg8::EpiHin, pg8::StaticOrder, true, true>(lds, g, S, E);
            }
            GRID_BAR();
            PROBE_REP(16) { CParams* kp = KP(); hgrn::passA(kp->w.Kb, (const bf16*)kp->w.LG, kp->w.Vb, kp->w.Uf, kp->w.Dbuf, lds); }
            GRID_BAR();
            PROBE_REP(16) { CParams* kp = KP(); hgrn::passB(kp->w.Uf, kp->w.Dbuf, kp->w.Sf); }
            GRID_BAR();
            if constexpr (((PROBE_MASK) & 4096) != 0) { CParams* kp = KP(); hgrn::passC<HGC_PROBE_PARTS>(kp->w.Qb, kp->w.Kb, (const bf16*)kp->w.LG, kp->w.Vb, kp->w.Gb, kp->w.Sf, kp->in.p[8] + (size_t)j * 128, (bf16*)kp->w.V32, lds); GRID_BAR(); }
            PROBE_REP(16) { CParams* kp = KP(); hgrn::passC(kp->w.Qb, kp->w.Kb, (const bf16*)kp->w.LG, kp->w.Vb, kp->w.Gb, kp->w.Sf, kp->in.p[8] + (size_t)j * 128, kp->w.Ob, lds); }
            GRID_BAR();
        }
        PROBE_REP(4) {
            CParams* kp = KP();
            const bf16* Wt = ((layer & 1) == 0) ? kp->w.Wo_t + (size_t)j * D * D : kp->w.Hout_t + (size_t)j * D * D;
            pg8::Gemm g{kp->w.Ob, Wt, T, D, D}; pg8::StaticOrder S; S.init(T, D, gridDim.x, blockIdx.x);
            pg8::EpiRes E{kp->w.Xb, (bf16*)kp->w.V32};
            pg8::gemm_phase<pg8::EpiRes, pg8::StaticOrder, true, true>(lds, g, S, E);
        }
        GRID_BAR();
        if constexpr (((PROBE_MASK) & 32) != 0) {
            CParams* kp = KP();
            lnroute_phase(kp->w.V32, kp->X, kp->w.Xb, kp->in.p[15] + (size_t)(layer * 2) * D, kp->in.p[16] + (size_t)(layer * 2) * D, (const bf16*)kp->w.Wr_t + (size_t)layer * 2 * NE * D,
                          kp->in.p[10] + (size_t)layer * NE, kp->w.ctl + CNT_BASE + (4 + layer) * 64 * CNT_STRIDE, (int*)kp->w.H1, (float*)((char*)kp->w.H1 + (16u << 20)), (int*)((char*)kp->w.H1 + (32u << 20)), lds);
            GRID_BAR();
        }
        {
            CParams* kp = KP();
            lnroute_phase(kp->w.V32, kp->X, kp->w.Xb, kp->in.p[15] + (size_t)(layer * 2) * D, kp->in.p[16] + (size_t)(layer * 2) * D, (const bf16*)kp->w.Wr_t + (size_t)layer * 2 * NE * D,
                          kp->in.p[10] + (size_t)layer * NE, kp->w.ctl + CNT_BASE + layer * 64 * CNT_STRIDE, kp->w.rowlist, kp->w.tok_w, kp->w.tok_es, lds);
        }
        GRID_BAR();
        const pg8::MoeTabs tb = moe_tables(KP()->w.ctl + CNT_BASE + layer * 64 * CNT_STRIDE, lds, tid);
        PROBE_REP(64) {
            CParams* kp = KP();
            pg8::Gemm g{kp->w.Xb, kp->w.Wgu_t + (size_t)layer * 65 * 512 * D, 0, 0, D};
            pg8::MoeOrder<2> S{tb, (int)gridDim.x, (int)blockIdx.x, kp->w.rowlist};
            pg8::EpiSwiglu E{kp->w.H1};
            pg8::gemm_phase_g<pg8::EpiSwiglu, pg8::MoeOrder<2>, true, true>(lds, g, S, E);
        }
        GRID_BAR();
        PROBE_REP(128) {
            CParams* kp = KP();
            int kdim = 256; asm volatile("" : "+s"(kdim));
            pg8::Gemm g{kp->w.H1, kp->w.Wd_t + (size_t)layer * 65 * D * 256, 0, 0, kdim};
            pg8::MoeOrder<4> S{tb, (int)gridDim.x, (int)blockIdx.x, kp->w.rowlist};
            pg8::EpiDown E{(unsigned char*)kp->w.Y};
            pg8::gemm_phase<pg8::EpiDown, pg8::MoeOrder<4>, true, true>(lds, g, S, E);
        }
        GRID_BAR();
        if ((PROBE_MASK) & 1024) { CParams* kp = KP(); combine_phase((const unsigned char*)kp->w.Y, kp->w.tok_es, kp->w.tok_w, tb, kp->w.Xb, kp->w.V32, kp->w.Qb, kp->in.p[15], kp->in.p[16], kp->w.ctl + CTL_POISON); GRID_BAR(); }
        { CParams* kp = KP(); combine_phase((const unsigned char*)kp->w.Y, kp->w.tok_es, kp->w.tok_w, tb, kp->w.Xb, (layer + 1 < DEPTH) ? (float*)nullptr : kp->X, kp->w.Xb, kp->in.p[15] + (size_t)(layer * 2 + 1) * D, kp->in.p[16] + (size_t)(layer * 2 + 1) * D, kp->w.ctl + CTL_POISON); }
        if (layer + 1 < DEPTH) GRID_BAR();
    }
#endif
}
}

extern "C" void kernel_launch(void* const* d_in, const int* in_sizes, int n_in, void* d_out, int out_size, void* d_ws, size_t ws_size, hipStream_t stream) {
    Inputs in{}; for (int i = 0; i < 17; ++i) in.p[i] = (const float*)d_in[i];
    float* X = (float*)d_out;
    char* ws = (char*)d_ws; size_t o = 0;
    auto carve = [&](size_t bytes) { char* p = ws + o; o += (bytes + 255) & ~(size_t)255; return p; };
    WS w{};
    w.ctl = (int*)carve(1 << 20);
    w.Wqkv_t = (bf16*)carve((size_t)2 * 3072 * D * 2); w.Wo_t = (bf16*)carve((size_t)2 * D * D * 2);
    w.Hin_t = (bf16*)carve((size_t)2 * 4096 * D * 2); w.Hout_t = (bf16*)carve((size_t)2 * D * D * 2);
    w.rot = (float*)carve((size_t)SEQ * 16 * 4); w.lbtab = (float*)carve(4 * 1024 * 4);
    w.V32 = (float*)carve((size_t)T * D * 4);
    w.Xb = (bf16*)carve((size_t)T * D * 2); w.Qb = (bf16*)carve((size_t)T * D * 2); w.Kb = (bf16*)carve((size_t)T * D * 2);
    w.Vb = (bf16*)carve((size_t)T * D * 2); w.Gb = (bf16*)carve((size_t)T * D * 2); w.Ob = (bf16*)carve((size_t)T * D * 2);
    w.LG = (float*)carve((size_t)T * D * 4); w.Dbuf = (float*)carve((size_t)4096 * 128 * 4);
    w.Wgu_t = (bf16*)carve((size_t)DEPTH * 65 * 512 * D * 2); w.Wd_t = (bf16*)carve((size_t)DEPTH * 65 * D * 256 * 2);
    w.Wr_t = (float*)carve((size_t)DEPTH * NE * D * 4);
    w.H1 = (bf16*)carve((size_t)NROWS * 256 * 2); w.Y = (bf16*)carve((size_t)NROWS * 1024 * 2);
    w.Uf = w.Y; w.Sf = w.Y + (size_t)4096 * 16384;
    w.rowlist = (int*)carve((size_t)(NE + 1) * T * 4); w.tok_w = (float*)carve((size_t)T * 8 * 4); w.tok_es = (int*)carve((size_t)T * 8 * 4);
    if (o > ws_size || n_in != 17) { fprintf(stderr, "kernel_launch: workspace too small (need %zu, have %zu) or n_in %d != 17; nothing launched\n", o, ws_size, n_in); return; }
    static int grid = 0;
    if (grid == 0) {
        int dev = 0, cus = 0;
        if (hipGetDevice(&dev) != hipSuccess || hipDeviceGetAttribute(&cus, hipDeviceAttributeMultiprocessorCount, dev) != hipSuccess) { grid = -1; return; }
        if (hipFuncSetAttribute((const void*)k_fwd, hipFuncAttributeMaxDynamicSharedMemorySize, LDS_BYTES) != hipSuccess) { fprintf(stderr, "kernel_launch: hipFuncSetAttribute failed\n"); grid = -1; return; }
        int per_cu = 0;
        if (hipOccupancyMaxActiveBlocksPerMultiprocessor(&per_cu, (const void*)k_fwd, NTHREADS, LDS_BYTES) != hipSuccess || per_cu < 1) { fprintf(stderr, "kernel_launch: occupancy query says %d blocks per CU\n", per_cu); }
        (void)hipGetLastError();
        grid = cus < 256 ? cus : 256;
    }
    if (grid < 0) return;
    (void)hipMemsetAsync(w.ctl, 0, 1 << 20, stream);
    Params prm{}; prm.in = in; prm.w = w; prm.X = X;
    hipLaunchKernelGGL(k_fwd, dim3(grid), dim3(NTHREADS), LDS_BYTES, stream, prm);
}
```

```cpp
#include <hip/hip_runtime.h>
#include <stdint.h>
#include <stdio.h>
#include <math.h>

namespace cfg {
constexpr int D = 1024, NB = 2, SEQ = 16384, T = NB * SEQ, DEPTH = 4;
constexpr int NE = 64, TOPK = 8, EFF = 256;
constexpr int NPAD = T * TOPK + NE * 256;
constexpr float ALPHA = 1.6817928305074290f;
constexpr float LN_EPS = 1e-5f;
constexpr float ROUTED_SCALE = 2.5f;
constexpr float C2 = 0.125f * 1.4426950408889634f;
}
using namespace cfg;

namespace pg8 {
#define PG8_LAS __attribute__((address_space(3)))
typedef unsigned short bf16_t;
typedef short bf16x8 __attribute__((ext_vector_type(8)));
typedef float f32x4 __attribute__((ext_vector_type(4)));
typedef unsigned u32x4 __attribute__((ext_vector_type(4)));
constexpr int BM = 256, BK = 64, HALF = 128, HTB = HALF * BK * 2  , STAGE_BYTES = 8 * HTB, NXCD = 8, WGM = 8;

__host__ __device__ __forceinline__ int lds_byte(int r, int c) { const int st = (r >> 4) * 2 + (c >> 5), rr = r & 15, cc = c & 31, ob = rr * 64 + cc * 2; return st * 1024 + (ob ^ (((ob >> 9) & 1) << 5)); }
__host__ __device__ __forceinline__ void stage_rc(int b, int& R, int& C) { const int st = b / 1024, sb = b % 1024, swz = sb ^ (((sb >> 9) & 1) << 5); R = (st >> 1) * 16 + swz / 64; C = (st & 1) * 32 + (swz % 64) / 2; }
__host__ __device__ __forceinline__ int perm32(int rho) { const int n = rho >> 4, i = rho & 15; return 8 * (i >> 2) + 4 * n + (i & 3); }

struct Unit { int pm, pn, aux, e; };
struct Gemm { const bf16_t* A; const bf16_t* Bt; int M, N, K; };

struct StaticOrder {
    int nM, nN, nwg, G, c;
    __host__ __device__ void init(int M, int N, int G_, int c_) { nM = M / BM; nN = N / BM; nwg = nM * nN; G = G_; c = c_; }
    __host__ __device__ bool next(int i, Unit& u) const {
        const long L = (long)i * G + c; if (L >= nwg) return false;
        int wgid = (int)L; { const int q = nwg / NXCD, r = nwg % NXCD, xcd = wgid % NXCD, off = wgid / NXCD; wgid = (xcd < r ? xcd * (q + 1) : r * (q + 1) + (xcd - r) * q) + off; }
        const int nig = WGM * nN, gid = wgid / nig, fm = gid * WGM, gsz = (nM - fm) < WGM ? (nM - fm) : WGM;
        u.pm = fm + ((wgid % nig) % gsz); u.pn = (wgid % nig) / gsz; return true;
    }
    __device__ __forceinline__ void a_ready(const Unit&) const {}
    __device__ __forceinline__ void done(const Unit&) const {}
};


__device__ __forceinline__ unsigned cvt_pk_bf16(float lo, float hi) { unsigned r; asm volatile("v_cvt_pk_bf16_f32 %0, %1, %2" : "=v"(r) : "v"(lo), "v"(hi)); return r; }
__device__ __forceinline__ float sigm(float x) { return __builtin_amdgcn_rcpf(1.f + __expf(-x)); }

struct EpiQKV {
    static constexpr bool PERM = true, AFTER_DRAIN = false;
    bf16_t* QKV; const float* rot;
    __device__ __forceinline__ void operator()(const f32x4 (&acc)[2][2][4][2], const Unit& u, int wr, int wc, int fr, int fq) const {
        const int sec = u.pn >> 2;
        bf16_t* base = QKV + (size_t)sec * ((size_t)cfg::T * 1024);
        const float sc = sec == 0 ? cfg::C2 : 1.f;
        const bool rotl = (sec < 2) && ((wc & 1) == 0) && (fq < 2);
        const int col0 = (u.pn & 3) * 256 + wc * 32 + 8 * fq;
#pragma unroll
        for (int ai = 0; ai < 2; ++ai)
#pragma unroll
            for (int m = 0; m < 4; ++m) {
                const int row = u.pm * BM + ai * HALF + wr * 64 + m * 16 + fr;
                f32x4 t0 = (f32x4){1.f, 0.f, 1.f, 0.f}, t1 = (f32x4){1.f, 0.f, 1.f, 0.f};
                if (rotl) { const f32x4* rp = (const f32x4*)(rot + ((size_t)(row & (cfg::SEQ - 1)) * 8 + 4 * fq) * 2); t0 = rp[0]; t1 = rp[1]; }
#pragma unroll
                for (int bj = 0; bj < 2; ++bj) {
                    const f32x4 v0 = acc[ai][bj][m][0], v1 = acc[ai][bj][m][1];
                    f32x4 r0, r1;
                    r0[0] = v0[0] * t0[0] - v0[1] * t0[1]; r0[1] = v0[1] * t0[0] + v0[0] * t0[1];
                    r0[2] = v0[2] * t0[2] - v0[3] * t0[3]; r0[3] = v0[3] * t0[2] + v0[2] * t0[3];
                    r1[0] = v1[0] * t1[0] - v1[1] * t1[1]; r1[1] = v1[1] * t1[0] + v1[0] * t1[1];
                    r1[2] = v1[2] * t1[2] - v1[3] * t1[3]; r1[3] = v1[3] * t1[2] + v1[2] * t1[3];
                    r0 = r0 * sc; r1 = r1 * sc;
                    u32x4 w; w.x = cvt_pk_bf16(r0[0], r0[1]); w.y = cvt_pk_bf16(r0[2], r0[3]); w.z = cvt_pk_bf16(r1[0], r1[1]); w.w = cvt_pk_bf16(r1[2], r1[3]);
                    *(u32x4*)(base + (size_t)row * 1024 + col0 + bj * HALF) = w;
                }
                asm volatile("" ::: "memory");
            }
    }
};
struct EpiQK8 {
    static constexpr bool PERM = true, AFTER_DRAIN = false;
    unsigned char* QK; const float* rot;
    __device__ __forceinline__ void operator()(const f32x4 (&acc)[2][2][4][2], const Unit& u, int wr, int wc, int fr, int fq) const {
        const int sec = u.pn >> 2;
        unsigned char* base = QK + (size_t)sec * ((size_t)cfg::T * 1024);
        const float sc = sec == 0 ? cfg::C2 * 4.f : 0.25f;
        const bool rotl = ((wc & 1) == 0) && (fq < 2);
        const int col0 = (u.pn & 3) * 256 + wc * 32 + 8 * fq;
        typedef unsigned u32x2_ __attribute__((ext_vector_type(2)));
#pragma unroll
        for (int ai = 0; ai < 2; ++ai)
#pragma unroll
            for (int m = 0; m < 4; ++m) {
                const int row = u.pm * BM + ai * HALF + wr * 64 + m * 16 + fr;
                f32x4 t0 = (f32x4){1.f, 0.f, 1.f, 0.f}, t1 = (f32x4){1.f, 0.f, 1.f, 0.f};
                if (rotl) { const f32x4* rp = (const f32x4*)(rot + ((size_t)(row & (cfg::SEQ - 1)) * 8 + 4 * fq) * 2); t0 = rp[0]; t1 = rp[1]; }
#pragma unroll
                for (int bj = 0; bj < 2; ++bj) {
                    const f32x4 v0 = acc[ai][bj][m][0], v1 = acc[ai][bj][m][1];
                    f32x4 r0, r1;
                    r0[0] = v0[0] * t0[0] - v0[1] * t0[1]; r0[1] = v0[1] * t0[0] + v0[0] * t0[1];
                    r0[2] = v0[2] * t0[2] - v0[3] * t0[3]; r0[3] = v0[3] * t0[2] + v0[2] * t0[3];
                    r1[0] = v1[0] * t1[0] - v1[1] * t1[1]; r1[1] = v1[1] * t1[0] + v1[0] * t1[1];
                    r1[2] = v1[2] * t1[2] - v1[3] * t1[3]; r1[3] = v1[3] * t1[2] + v1[2] * t1[3];
                    r0 = r0 * sc; r1 = r1 * sc;
#pragma unroll
                    for (int i = 0; i < 4; ++i) { r0[i] = __builtin_amdgcn_fmed3f(r0[i], -448.f, 448.f); r1[i] = __builtin_amdgcn_fmed3f(r1[i], -448.f, 448.f); }
                    int w0 = 0, w1 = 0;
                    w0 = __builtin_amdgcn_cvt_pk_fp8_f32(r0[0], r0[1], w0, false); w0 = __builtin_amdgcn_cvt_pk_fp8_f32(r0[2], r0[3], w0, true);
                    w1 = __builtin_amdgcn_cvt_pk_fp8_f32(r1[0], r1[1], w1, false); w1 = __builtin_amdgcn_cvt_pk_fp8_f32(r1[2], r1[3], w1, true);
                    *(u32x2_*)(base + (size_t)row * 1024 + col0 + bj * HALF) = (u32x2_){(unsigned)w0, (unsigned)w1};
                }
                asm volatile("" ::: "memory");
            }
    }
};
struct EpiVT {
    static constexpr bool PERM = true, AFTER_DRAIN = false;
    unsigned char* VT;
    __device__ __forceinline__ void operator()(const f32x4 (&acc)[2][2][4][2], const Unit& u, int wr, int wc, int fr, int fq) const {
#pragma unroll
        for (int ai = 0; ai < 2; ++ai)
#pragma unroll
            for (int m = 0; m < 4; ++m) {
                const int eg = u.pm * BM + ai * HALF + wr * 64 + m * 16 + fr, hh = eg >> 7, e = eg & 127, sw = (e >> 2) & 3;
#pragma unroll
                for (int bj = 0; bj < 2; ++bj) {
                    const int tok = u.pn * BM + bj * HALF + wc * 32 + 8 * fq, b = tok >> 14, sq = tok & (cfg::SEQ - 1), tile = sq >> 6, g = (sq & 63) >> 3;
                    unsigned char* blk = VT + ((size_t)((b * 8 + hh) * 256 + tile)) * 8192 + e * 64;
                    f32x4 v0 = acc[ai][bj][m][0] * 16.f, v1 = acc[ai][bj][m][1] * 16.f;
#pragma unroll
                    for (int i = 0; i < 4; ++i) { v0[i] = __builtin_amdgcn_fmed3f(v0[i], -448.f, 448.f); v1[i] = __builtin_amdgcn_fmed3f(v1[i], -448.f, 448.f); }
                    int w0 = 0, w1 = 0;
                    w0 = __builtin_amdgcn_cvt_pk_fp8_f32(v0[0], v0[1], w0, false); w0 = __builtin_amdgcn_cvt_pk_fp8_f32(v0[2], v0[3], w0, true);
                    w1 = __builtin_amdgcn_cvt_pk_fp8_f32(v1[0], v1[1], w1, false); w1 = __builtin_amdgcn_cvt_pk_fp8_f32(v1[2], v1[3], w1, true);
                    const int p0 = 4 * g, p1 = 32 + 4 * g;
                    *(unsigned*)(blk + (((p0 >> 4) ^ sw) << 4) + (p0 & 15)) = (unsigned)w0;
                    *(unsigned*)(blk + (((p1 >> 4) ^ sw) << 4) + (p1 & 15)) = (unsigned)w1;
                }
            }
    }
};
struct EpiRes {
    static constexpr bool PERM = true, AFTER_DRAIN = false;
    const bf16_t* X; bf16_t* Vout;
    __device__ __forceinline__ void operator()(const f32x4 (&acc)[2][2][4][2], const Unit& u, int wr, int wc, int fr, int fq) const {
        const int col0 = u.pn * BM + wc * 32 + 8 * fq;
#pragma unroll
        for (int ai = 0; ai < 2; ++ai)
#pragma unroll
            for (int m = 0; m < 4; ++m) {
                const size_t ro = (size_t)(u.pm * BM + ai * HALF + wr * 64 + m * 16 + fr) * 1024 + col0;
#pragma unroll
                for (int bj = 0; bj < 2; ++bj) { const size_t off = ro + bj * HALF; const u32x4 xb = *(const u32x4*)(X + off);
                    const f32x4 x0 = (f32x4){__builtin_bit_cast(float, xb[0] << 16), __builtin_bit_cast(float, xb[0] & 0xffff0000u), __builtin_bit_cast(float, xb[1] << 16), __builtin_bit_cast(float, xb[1] & 0xffff0000u)};
                    const f32x4 x1 = (f32x4){__builtin_bit_cast(float, xb[2] << 16), __builtin_bit_cast(float, xb[2] & 0xffff0000u), __builtin_bit_cast(float, xb[3] << 16), __builtin_bit_cast(float, xb[3] & 0xffff0000u)};
                    const f32x4 v0 = x0 * cfg::ALPHA + acc[ai][bj][m][0], v1 = x1 * cfg::ALPHA + acc[ai][bj][m][1];
                    u32x4 w; w.x = cvt_pk_bf16(v0[0], v0[1]); w.y = cvt_pk_bf16(v0[2], v0[3]); w.z = cvt_pk_bf16(v1[0], v1[1]); w.w = cvt_pk_bf16(v1[2], v1[3]);
                    *(u32x4*)(Vout + off) = w; }
            }
    }
};
struct EpiHin {
    static constexpr bool PERM = true, AFTER_DRAIN = false;
    bf16_t* QKVG; bf16_t* LG; const float* lbtab;
    __device__ __forceinline__ void operator()(const f32x4 (&acc)[2][2][4][2], const Unit& u, int wr, int wc, int fr, int fq) const {
        const int sec = u.pn >> 2;
        const int col0 = (u.pn & 3) * 256 + wc * 32 + 8 * fq;
        bf16_t* base = QKVG + (size_t)sec * ((size_t)cfg::T * 1024);
#pragma unroll
        for (int ai = 0; ai < 2; ++ai)
#pragma unroll
            for (int m = 0; m < 4; ++m) {
                const size_t ro = (size_t)(u.pm * BM + ai * HALF + wr * 64 + m * 16 + fr) * 1024 + col0;
#pragma unroll
                for (int bj = 0; bj < 2; ++bj) {
                    f32x4 v0 = acc[ai][bj][m][0], v1 = acc[ai][bj][m][1];
                    if (sec == 0 || sec == 3) {
#pragma unroll
                        for (int i = 0; i < 4; ++i) { v0[i] = v0[i] * sigm(v0[i]); v1[i] = v1[i] * sigm(v1[i]); }
                    } else if (sec == 1) {
                        const f32x4 l0 = *(const f32x4*)(lbtab + col0 + bj * HALF), l1 = *(const f32x4*)(lbtab + col0 + bj * HALF + 4);
                        f32x4 g0, g1;
#pragma unroll
                        for (int i = 0; i < 4; ++i) {
                            const float s0 = sigm(v0[i]), os0 = 1.f - s0, s1 = sigm(v1[i]), os1 = 1.f - s1;
                            g0[i] = __logf(l0[i] + (1.f - l0[i]) * s0); v0[i] = (1.f - l0[i]) * os0;
                            g1[i] = __logf(l1[i] + (1.f - l1[i]) * s1); v1[i] = (1.f - l1[i]) * os1;
                        }
                        { u32x4 lw; lw.x = cvt_pk_bf16(g0[0], g0[1]); lw.y = cvt_pk_bf16(g0[2], g0[3]); lw.z = cvt_pk_bf16(g1[0], g1[1]); lw.w = cvt_pk_bf16(g1[2], g1[3]); *(u32x4*)(LG + ro + bj * HALF) = lw; }
                    }
                    u32x4 w; w.x = cvt_pk_bf16(v0[0], v0[1]); w.y = cvt_pk_bf16(v0[2], v0[3]); w.z = cvt_pk_bf16(v1[0], v1[1]); w.w = cvt_pk_bf16(v1[2], v1[3]);
                    *(u32x4*)(base + ro + bj * HALF) = w;
                }
            }
    }
};

struct MoeTabs { const PG8_LAS int* toff; const PG8_LAS int* cntv; const PG8_LAS unsigned char* tile_e; const PG8_LAS unsigned short* xl; int nxl; };
template <int NN> struct MoeOrder {
    MoeTabs tb; int G, c; const int* rowlist;
    __device__ __forceinline__ bool next(int i, Unit& u) const {
        const int L = i * (G >> 3) + (c >> 3); if (L >= tb.nxl * NN) return false;
        const int ti = L / NN, n = L - ti * NN, tile = __builtin_amdgcn_readfirstlane((int)tb.xl[ti]), e = __builtin_amdgcn_readfirstlane((int)tb.tile_e[tile]);
        u.pm = tile; u.pn = e * NN + n; u.aux = n; u.e = e; return true;
    }
    __device__ __forceinline__ int row_of(const Unit& u, int r) const {
        const int slot = (u.pm - __builtin_amdgcn_readfirstlane(tb.toff[u.e])) * 256 + r, last = __builtin_amdgcn_readfirstlane(tb.cntv[u.e]) - 1;
        return rowlist[(size_t)u.e * cfg::T + (slot < last ? slot : last)];
    }
    __device__ __forceinline__ void a_ready(const Unit&) const {}
    __device__ __forceinline__ void done(const Unit&) const {}
};
struct EpiSwiglu {
    static constexpr bool PERM = true, AFTER_DRAIN = false;
    bf16_t* H1;
    __device__ __forceinline__ void operator()(const f32x4 (&acc)[2][2][4][2], const Unit& u, int wr, int wc, int fr, int fq) const {
        const int col0 = u.aux * 128 + wc * 32 + 8 * fq;
#pragma unroll
        for (int ai = 0; ai < 2; ++ai)
#pragma unroll
            for (int m = 0; m < 4; ++m) {
                const size_t row = (size_t)u.pm * BM + ai * HALF + wr * 64 + m * 16 + fr;
                const f32x4 g0 = acc[ai][0][m][0], g1 = acc[ai][0][m][1], u0 = acc[ai][1][m][0], u1 = acc[ai][1][m][1];
                f32x4 h0, h1;
#pragma unroll
                for (int i = 0; i < 4; ++i) { h0[i] = g0[i] * sigm(g0[i]) * u0[i]; h1[i] = g1[i] * sigm(g1[i]) * u1[i]; }
                u32x4 w; w.x = cvt_pk_bf16(h0[0], h0[1]); w.y = cvt_pk_bf16(h0[2], h0[3]); w.z = cvt_pk_bf16(h1[0], h1[1]); w.w = cvt_pk_bf16(h1[2], h1[3]);
                *(u32x4*)(H1 + row * 256 + col0) = w;
            }
    }
};
struct EpiDown {
    static constexpr bool PERM = true, AFTER_DRAIN = false;
    unsigned char* Y;
    __device__ __forceinline__ void operator()(const f32x4 (&acc)[2][2][4][2], const Unit& u, int wr, int wc, int fr, int fq) const {
        const int col0 = u.aux * 256 + wc * 32 + 8 * fq;
        typedef unsigned u32x2_ __attribute__((ext_vector_type(2)));
#pragma unroll
        for (int ai = 0; ai < 2; ++ai)
#pragma unroll
            for (int m = 0; m < 4; ++m) {
                unsigned char* rowp = Y + ((size_t)u.pm * BM + ai * HALF + wr * 64 + m * 16 + fr) * 1024 + col0;
#pragma unroll
                for (int bj = 0; bj < 2; ++bj) {
                    f32x4 v0 = acc[ai][bj][m][0] * 64.f, v1 = acc[ai][bj][m][1] * 64.f;
#pragma unroll
                    for (int i = 0; i < 4; ++i) { v0[i] = __builtin_amdgcn_fmed3f(v0[i], -448.f, 448.f); v1[i] = __builtin_amdgcn_fmed3f(v1[i], -448.f, 448.f); }
                    int w0 = 0, w1 = 0;
                    w0 = __builtin_amdgcn_cvt_pk_fp8_f32(v0[0], v0[1], w0, false); w0 = __builtin_amdgcn_cvt_pk_fp8_f32(v0[2], v0[3], w0, true);
                    w1 = __builtin_amdgcn_cvt_pk_fp8_f32(v1[0], v1[1], w1, false); w1 = __builtin_amdgcn_cvt_pk_fp8_f32(v1[2], v1[3], w1, true);
                    *(u32x2_*)(rowp + bj * HALF) = (u32x2_){(unsigned)w0, (unsigned)w1};
                }
            }
    }
};
template <class Epi, class Sched, bool ALIGN_EPI = false, bool SP2 = false>
__device__ __forceinline__ void gemm_phase(PG8_LAS unsigned char* lds, const Gemm g, const Sched& S, const Epi& E) {
    int tid_l = threadIdx.x; asm volatile("" : "+v"(tid_l));
    const int tid = tid_l, wid = __builtin_amdgcn_readfirstlane(tid >> 6), lane = tid & 63, wr = wid >> 2, wc = wid & 3, fr = lane & 15, fq = lane >> 4;
    const int K = g.K, nt = K / BK;
    unsigned voffA[2], voffB[2];
#pragma unroll
    for (int i = 0; i < 2; ++i) { int R, C; stage_rc(tid * 16 + i * 8192, R, C); const int Rb = Epi::PERM ? ((R & ~31) + perm32(R & 31)) : R;
        voffA[i] = (unsigned)(R * K + C) * 2u; voffB[i] = (unsigned)(Rb * K + C) * 2u; }
    const size_t kstep = (size_t)(BK * 2);
    const size_t hstep = (size_t)HALF * K * 2;
    const size_t tstep = 2 * hstep;
    const unsigned ldsw = (unsigned)wid * 1024u;
    const int aoff = lds_byte(wr * 64 + fr, fq * 8), boff = lds_byte(wc * 32 + fr, fq * 8);
#define PG8_SA(b, h) (((b) * 2 + (h)) * HTB)
#define PG8_SB(b, h) ((4 + (b) * 2 + (h)) * HTB)
#define PG8_STAGE(bufoff, gbase, voff) do { _Pragma("unroll") for (int _i = 0; _i < 2; ++_i) \
        __builtin_amdgcn_global_load_lds((const unsigned*)((const char*)(gbase) + (voff)[_i]), (PG8_LAS unsigned*)(lds + (bufoff) + ldsw + _i * 8192), 16, 0, 0); } while (0)
#define PG8_LDA(dst, b, h) do { _Pragma("unroll") for (int m = 0; m < 4; ++m) _Pragma("unroll") for (int k = 0; k < 2; ++k) dst[m][k] = *(const PG8_LAS bf16x8*)(lds + PG8_SA(b, h) + aoff + m * 2048 + k * 1024); } while (0)
#define PG8_LDB(dst, b, h) do { _Pragma("unroll") for (int n = 0; n < 2; ++n) _Pragma("unroll") for (int k = 0; k < 2; ++k) dst[n][k] = *(const PG8_LAS bf16x8*)(lds + PG8_SB(b, h) + boff + n * 2048 + k * 1024); } while (0)
#define PG8_MMA(ai, bj, At, Bt) do { __builtin_amdgcn_s_setprio(1); _Pragma("unroll") for (int m = 0; m < 4; ++m) _Pragma("unroll") for (int n = 0; n < 2; ++n) _Pragma("unroll") for (int k = 0; k < 2; ++k) \
        acc[ai][bj][m][n] = __builtin_amdgcn_mfma_f32_16x16x32_bf16(Bt[n][k], At[m][k], acc[ai][bj][m][n], 0, 0, 0); __builtin_amdgcn_s_setprio(0); } while (0)
#define PG8_WAIT_V(n) asm volatile("s_waitcnt vmcnt(" #n ")" ::: "memory")
#define PG8_WAIT_L(n) asm volatile("s_waitcnt lgkmcnt(" #n ")" ::: "memory")
#define PG8_BAR __builtin_amdgcn_s_barrier()
#define PG8_SCHED __builtin_amdgcn_sched_barrier(0)
    Unit cur, nxt; int ui = 0;
    if (!S.next(0, cur)) return;
    f32x4 acc[2][2][4][2];
#pragma unroll
    for (int a = 0; a < 2; ++a)
#pragma unroll
        for (int b = 0; b < 2; ++b)
#pragma unroll
            for (int m = 0; m < 4; ++m)
#pragma unroll
                for (int n = 0; n < 2; ++n) acc[a][b][m][n] = (f32x4){0.f, 0.f, 0.f, 0.f};
    bf16x8 At[4][2], B0[2][2], B1[2][2];
    const char* cA = (const char*)g.A + (size_t)cur.pm * tstep; const char* cB = (const char*)g.Bt + (size_t)cur.pn * tstep;
    S.a_ready(cur);
    if constexpr (SP2) {
        PG8_STAGE(PG8_SB(0, 0), cB, voffB); PG8_STAGE(PG8_SB(0, 1), cB + hstep, voffB); PG8_STAGE(PG8_SA(0, 0), cA, voffA); PG8_STAGE(PG8_SA(0, 1), cA + hstep, voffA);
        if (wr == 1) PG8_BAR;
        PG8_WAIT_V(2); PG8_BAR;
        PG8_STAGE(PG8_SB(1, 0), cB + kstep, voffB); PG8_STAGE(PG8_SA(1, 0), cA + kstep, voffA); PG8_STAGE(PG8_SB(1, 1), cB + hstep + kstep, voffB);
        PG8_WAIT_V(6); PG8_BAR;
    } else {
        PG8_STAGE(PG8_SB(0, 0), cB, voffB); PG8_STAGE(PG8_SA(0, 0), cA, voffA); PG8_STAGE(PG8_SB(0, 1), cB + hstep, voffB); PG8_STAGE(PG8_SA(0, 1), cA + hstep, voffA);
        if (wr == 1) PG8_BAR;
        PG8_WAIT_V(4); PG8_BAR;
        PG8_STAGE(PG8_SB(1, 0), cB + kstep, voffB); PG8_STAGE(PG8_SA(1, 0), cA + kstep, voffA); PG8_STAGE(PG8_SB(1, 1), cB + hstep + kstep, voffB);
        PG8_WAIT_V(6); PG8_BAR;
    }
    for (;;) {
        const bool has_next = S.next(ui + 1, nxt);
        const char* nA = has_next ? (const char*)g.A + (size_t)nxt.pm * tstep : cA; const char* nB = has_next ? (const char*)g.Bt + (size_t)nxt.pn * tstep : cB;
        for (int t = 0; t < nt; t += 2) {
            const bool last = (t == nt - 2);
            const char* a1 = cA + (size_t)(t + 1) * kstep;
            const char* a2 = last ? nA : cA + (size_t)(t + 2) * kstep; const char* b2 = last ? nB : cB + (size_t)(t + 2) * kstep;
            const char* a3 = a2 + kstep; const char* b3 = b2 + kstep;
            if (last && has_next) S.a_ready(nxt);
            if constexpr (SP2) {
            PG8_LDB(B0, 0, 0); PG8_LDB(B1, 0, 1); PG8_SCHED; PG8_LDA(At, 0, 0); PG8_STAGE(PG8_SA(1, 1), a1 + hstep, voffA);
            PG8_WAIT_V(8); PG8_WAIT_L(0); PG8_BAR; PG8_MMA(0, 0, At, B0); PG8_MMA(0, 1, At, B1); PG8_BAR; PG8_SCHED;
            PG8_LDA(At, 0, 1); PG8_STAGE(PG8_SB(0, 0), b2, voffB); PG8_STAGE(PG8_SB(0, 1), b2 + hstep, voffB); PG8_STAGE(PG8_SA(0, 0), a2, voffA);
            PG8_WAIT_V(8); PG8_WAIT_L(0); PG8_BAR; PG8_MMA(1, 0, At, B0); PG8_MMA(1, 1, At, B1); PG8_BAR; PG8_SCHED;
            PG8_LDB(B0, 1, 0); PG8_LDB(B1, 1, 1); PG8_SCHED; PG8_LDA(At, 1, 0); PG8_STAGE(PG8_SA(0, 1), a2 + hstep, voffA);
            PG8_WAIT_V(8); PG8_WAIT_L(0); PG8_BAR; PG8_MMA(0, 0, At, B0); PG8_MMA(0, 1, At, B1); PG8_BAR; PG8_SCHED;
            PG8_LDA(At, 1, 1); PG8_STAGE(PG8_SB(1, 0), b3, voffB); PG8_STAGE(PG8_SB(1, 1), b3 + hstep, voffB); PG8_STAGE(PG8_SA(1, 0), a3, voffA);
            PG8_WAIT_V(8); PG8_WAIT_L(0); PG8_BAR; PG8_MMA(1, 0, At, B0); PG8_MMA(1, 1, At, B1); PG8_BAR; PG8_SCHED;
            } else {
            PG8_LDB(B0, 0, 0); PG8_SCHED; PG8_LDA(At, 0, 0); PG8_STAGE(PG8_SA(1, 1), a1 + hstep, voffA);
            PG8_WAIT_L(8); PG8_BAR; PG8_WAIT_L(0); PG8_MMA(0, 0, At, B0); PG8_BAR; PG8_SCHED;
            PG8_LDB(B1, 0, 1); PG8_STAGE(PG8_SB(0, 0), b2, voffB);
            PG8_BAR; PG8_WAIT_L(0); PG8_MMA(0, 1, At, B1); PG8_BAR;
            PG8_LDA(At, 0, 1); PG8_STAGE(PG8_SA(0, 0), a2, voffA);
            PG8_BAR; PG8_WAIT_L(0); PG8_MMA(1, 0, At, B0); PG8_BAR; PG8_SCHED;
            PG8_STAGE(PG8_SB(0, 1), b2 + hstep, voffB);
            PG8_WAIT_V(6); PG8_BAR; PG8_MMA(1, 1, At, B1); PG8_BAR;
            PG8_LDB(B0, 1, 0); PG8_SCHED; PG8_LDA(At, 1, 0); PG8_STAGE(PG8_SA(0, 1), a2 + hstep, voffA);
            PG8_WAIT_L(8); PG8_BAR; PG8_WAIT_L(0); PG8_MMA(0, 0, At, B0); PG8_BAR; PG8_SCHED;
            PG8_LDB(B1, 1, 1); PG8_STAGE(PG8_SB(1, 0), b3, voffB);
            PG8_BAR; PG8_WAIT_L(0); PG8_MMA(0, 1, At, B1); PG8_BAR;
            PG8_LDA(At, 1, 1); PG8_STAGE(PG8_SA(1, 0), a3, voffA);
            PG8_BAR; PG8_WAIT_L(0); PG8_MMA(1, 0, At, B0); PG8_BAR; PG8_SCHED;
            PG8_STAGE(PG8_SB(1, 1), b3 + hstep, voffB);
            PG8_WAIT_V(6); PG8_BAR; PG8_MMA(1, 1, At, B1); PG8_BAR;
            }
        }
        if constexpr (ALIGN_EPI) { if (wr == 0) PG8_BAR; }
        if constexpr (!Epi::AFTER_DRAIN) { E(acc, cur, wr, wc, fr, fq); S.done(cur); }
        if (!has_next) break;
#pragma unroll
        for (int a = 0; a < 2; ++a)
#pragma unroll
            for (int b = 0; b < 2; ++b)
#pragma unroll
                for (int m = 0; m < 4; ++m)
#pragma unroll
                    for (int n = 0; n < 2; ++n) acc[a][b][m][n] = (f32x4){0.f, 0.f, 0.f, 0.f};
        cur = nxt; cA = nA; cB = nB; ++ui;
        if constexpr (ALIGN_EPI) { if (wr == 1) PG8_BAR; }
    }
    PG8_WAIT_V(0);
    if constexpr (!ALIGN_EPI) { if (wr == 0) PG8_BAR; }
    PG8_BAR;
    if constexpr (Epi::AFTER_DRAIN) { E.fused(acc, cur, wr, wc, fr, fq, lds, wid, lane); S.done(cur); }
#undef PG8_SA
#undef PG8_SB
#undef PG8_STAGE
#undef PG8_LDA
#undef PG8_LDB
#undef PG8_MMA
#undef PG8_WAIT_V
#undef PG8_WAIT_L
#undef PG8_BAR
#undef PG8_SCHED
}


#define PG8_GOFF(dst, unit) do { _Pragma("unroll") for (int _h = 0; _h < 2; ++_h) _Pragma("unroll") for (int _i = 0; _i < 2; ++_i) { int R_, C_; stage_rc(tid * 16 + _i * 8192, R_, C_); \
        dst[_h][_i] = (unsigned)(S.row_of(unit, _h * HALF + R_) * K + C_) * 2u; } } while (0)
template <class Epi, class Sched, bool ALIGN_EPI = false, bool SP2 = false>
__device__ __forceinline__ void gemm_phase_g(PG8_LAS unsigned char* lds, const Gemm g, const Sched& S, const Epi& E) {
    int tid_l = threadIdx.x; asm volatile("" : "+v"(tid_l));
    const int tid = tid_l, wid = __builtin_amdgcn_readfirstlane(tid >> 6), lane = tid & 63, wr = wid >> 2, wc = wid & 3, fr = lane & 15, fq = lane >> 4;
    const int K = g.K, nt = K / BK;
    unsigned voffA[2], voffB[2];
#pragma unroll
    for (int i = 0; i < 2; ++i) { int R, C; stage_rc(tid * 16 + i * 8192, R, C); const int Rb = Epi::PERM ? ((R & ~31) + perm32(R & 31)) : R;
        voffA[i] = (unsigned)(R * K + C) * 2u; voffB[i] = (unsigned)(Rb * K + C) * 2u; }
    const size_t kstep = (size_t)(BK * 2);
    const size_t hstep = (size_t)HALF * K * 2;
    const size_t tstep = 2 * hstep;
    const unsigned ldsw = (unsigned)wid * 1024u;
    const int aoff = lds_byte(wr * 64 + fr, fq * 8), boff = lds_byte(wc * 32 + fr, fq * 8);
#define PG8_SA(b, h) (((b) * 2 + (h)) * HTB)
#define PG8_SB(b, h) ((4 + (b) * 2 + (h)) * HTB)
#define PG8_STAGE(bufoff, gbase, voff) do { _Pragma("unroll") for (int _i = 0; _i < 2; ++_i) \
        __builtin_amdgcn_global_load_lds((const unsigned*)((const char*)(gbase) + (voff)[_i]), (PG8_LAS unsigned*)(lds + (bufoff) + ldsw + _i * 8192), 16, 0, 0); } while (0)
#define PG8_LDA(dst, b, h) do { _Pragma("unroll") for (int m = 0; m < 4; ++m) _Pragma("unroll") for (int k = 0; k < 2; ++k) dst[m][k] = *(const PG8_LAS bf16x8*)(lds + PG8_SA(b, h) + aoff + m * 2048 + k * 1024); } while (0)
#define PG8_LDB(dst, b, h) do { _Pragma("unroll") for (int n = 0; n < 2; ++n) _Pragma("unroll") for (int k = 0; k < 2; ++k) dst[n][k] = *(const PG8_LAS bf16x8*)(lds + PG8_SB(b, h) + boff + n * 2048 + k * 1024); } while (0)
#define PG8_MMA(ai, bj, At, Bt) do { __builtin_amdgcn_s_setprio(1); _Pragma("unroll") for (int m = 0; m < 4; ++m) _Pragma("unroll") for (int n = 0; n < 2; ++n) _Pragma("unroll") for (int k = 0; k < 2; ++k) \
        acc[ai][bj][m][n] = __builtin_amdgcn_mfma_f32_16x16x32_bf16(Bt[n][k], At[m][k], acc[ai][bj][m][n], 0, 0, 0); __builtin_amdgcn_s_setprio(0); } while (0)
#define PG8_WAIT_V(n) asm volatile("s_waitcnt vmcnt(" #n ")" ::: "memory")
#define PG8_WAIT_L(n) asm volatile("s_waitcnt lgkmcnt(" #n ")" ::: "memory")
#define PG8_BAR __builtin_amdgcn_s_barrier()
#define PG8_SCHED __builtin_amdgcn_sched_barrier(0)
    Unit cur, nxt; int ui = 0;
    if (!S.next(0, cur)) return;
    f32x4 acc[2][2][4][2];
#pragma unroll
    for (int a = 0; a < 2; ++a)
#pragma unroll
        for (int b = 0; b < 2; ++b)
#pragma unroll
            for (int m = 0; m < 4; ++m)
#pragma unroll
                for (int n = 0; n < 2; ++n) acc[a][b][m][n] = (f32x4){0.f, 0.f, 0.f, 0.f};
    bf16x8 At[4][2], B0[2][2], B1[2][2];
    const char* cA = (const char*)g.A; unsigned vC[2][2], vN[2][2], vS[2][2]; PG8_GOFF(vC, cur); const char* cB = (const char*)g.Bt + (size_t)cur.pn * tstep;
    S.a_ready(cur);
    if constexpr (SP2) {
        PG8_STAGE(PG8_SB(0, 0), cB, voffB); PG8_STAGE(PG8_SB(0, 1), cB + hstep, voffB); PG8_STAGE(PG8_SA(0, 0), cA, vC[0]); PG8_STAGE(PG8_SA(0, 1), cA, vC[1]);
        if (wr == 1) PG8_BAR;
        PG8_WAIT_V(2); PG8_BAR;
        PG8_STAGE(PG8_SB(1, 0), cB + kstep, voffB); PG8_STAGE(PG8_SA(1, 0), cA + kstep, vC[0]); PG8_STAGE(PG8_SB(1, 1), cB + hstep + kstep, voffB);
        PG8_WAIT_V(6); PG8_BAR;
    } else {
        PG8_STAGE(PG8_SB(0, 0), cB, voffB); PG8_STAGE(PG8_SA(0, 0), cA, vC[0]); PG8_STAGE(PG8_SB(0, 1), cB + hstep, voffB); PG8_STAGE(PG8_SA(0, 1), cA, vC[1]);
        if (wr == 1) PG8_BAR;
        PG8_WAIT_V(4); PG8_BAR;
        PG8_STAGE(PG8_SB(1, 0), cB + kstep, voffB); PG8_STAGE(PG8_SA(1, 0), cA + kstep, vC[0]); PG8_STAGE(PG8_SB(1, 1), cB + hstep + kstep, voffB);
        PG8_WAIT_V(6); PG8_BAR;
    }
    for (;;) {
        const bool has_next = S.next(ui + 1, nxt);
        const char* nA = (const char*)g.A; if (has_next) { PG8_GOFF(vN, nxt); } else { _Pragma("unroll") for (int _h = 0; _h < 2; ++_h) _Pragma("unroll") for (int _i = 0; _i < 2; ++_i) vN[_h][_i] = vC[_h][_i]; } const char* nB = has_next ? (const char*)g.Bt + (size_t)nxt.pn * tstep : cB;
        for (int t = 0; t < nt; t += 2) {
            const bool last = (t == nt - 2); _Pragma("unroll") for (int _h = 0; _h < 2; ++_h) _Pragma("unroll") for (int _i = 0; _i < 2; ++_i) vS[_h][_i] = last ? vN[_h][_i] : vC[_h][_i];
            const char* a1 = cA + (size_t)(t + 1) * kstep;
            const char* a2 = last ? nA : cA + (size_t)(t + 2) * kstep; const char* b2 = last ? nB : cB + (size_t)(t + 2) * kstep;
            const char* a3 = a2 + kstep; const char* b3 = b2 + kstep;
            if (last && has_next) S.a_ready(nxt);
            if constexpr (SP2) {
            PG8_LDB(B0, 0, 0); PG8_LDB(B1, 0, 1); PG8_SCHED; PG8_LDA(At, 0, 0); PG8_STAGE(PG8_SA(1, 1), a1, vC[1]);
            PG8_WAIT_V(8); PG8_WAIT_L(0); PG8_BAR; PG8_MMA(0, 0, At, B0); PG8_MMA(0, 1, At, B1); PG8_BAR; PG8_SCHED;
            PG8_LDA(At, 0, 1); PG8_STAGE(PG8_SB(0, 0), b2, voffB); PG8_STAGE(PG8_SB(0, 1), b2 + hstep, voffB); PG8_STAGE(PG8_SA(0, 0), a2, vS[0]);
            PG8_WAIT_V(8); PG8_WAIT_L(0); PG8_BAR; PG8_MMA(1, 0, At, B0); PG8_MMA(1, 1, At, B1); PG8_BAR; PG8_SCHED;
            PG8_LDB(B0, 1, 0); PG8_LDB(B1, 1, 1); PG8_SCHED; PG8_LDA(At, 1, 0); PG8_STAGE(PG8_SA(0, 1), a2, vS[1]);
            PG8_WAIT_V(8); PG8_WAIT_L(0); PG8_BAR; PG8_MMA(0, 0, At, B0); PG8_MMA(0, 1, At, B1); PG8_BAR; PG8_SCHED;
            PG8_LDA(At, 1, 1); PG8_STAGE(PG8_SB(1, 0), b3, voffB); PG8_STAGE(PG8_SB(1, 1), b3 + hstep, voffB); PG8_STAGE(PG8_SA(1, 0), a3, vS[0]);
            PG8_WAIT_V(8); PG8_WAIT_L(0); PG8_BAR; PG8_MMA(1, 0, At, B0); PG8_MMA(1, 1, At, B1); PG8_BAR; PG8_SCHED;
            } else {
            PG8_LDB(B0, 0, 0); PG8_SCHED; PG8_LDA(At, 0, 0); PG8_STAGE(PG8_SA(1, 1), a1, vC[1]);
            PG8_WAIT_L(8); PG8_BAR; PG8_WAIT_L(0); PG8_MMA(0, 0, At, B0); PG8_BAR; PG8_SCHED;
            PG8_LDB(B1, 0, 1); PG8_STAGE(PG8_SB(0, 0), b2, voffB);
            PG8_BAR; PG8_WAIT_L(0); PG8_MMA(0, 1, At, B1); PG8_BAR;
            PG8_LDA(At, 0, 1); PG8_STAGE(PG8_SA(0, 0), a2, vS[0]);
            PG8_BAR; PG8_WAIT_L(0); PG8_MMA(1, 0, At, B0); PG8_BAR; PG8_SCHED;
            PG8_STAGE(PG8_SB(0, 1), b2 + hstep, voffB);
            PG8_WAIT_V(6); PG8_BAR; PG8_MMA(1, 1, At, B1); PG8_BAR;
            PG8_LDB(B0, 1, 0); PG8_SCHED; PG8_LDA(At, 1, 0); PG8_STAGE(PG8_SA(0, 1), a2, vS[1]);
            PG8_WAIT_L(8); PG8_BAR; PG8_WAIT_L(0); PG8_MMA(0, 0, At, B0); PG8_BAR; PG8_SCHED;
            PG8_LDB(B1, 1, 1); PG8_STAGE(PG8_SB(1, 0), b3, voffB);
            PG8_BAR; PG8_WAIT_L(0); PG8_MMA(0, 1, At, B1); PG8_BAR;
            PG8_LDA(At, 1, 1); PG8_STAGE(PG8_SA(1, 0), a3, vS[0]);
            PG8_BAR; PG8_WAIT_L(0); PG8_MMA(1, 0, At, B0); PG8_BAR; PG8_SCHED;
            PG8_STAGE(PG8_SB(1, 1), b3 + hstep, voffB);
            PG8_WAIT_V(6); PG8_BAR; PG8_MMA(1, 1, At, B1); PG8_BAR;
            }
        }
        if constexpr (ALIGN_EPI) { if (wr == 0) PG8_BAR; }
        if constexpr (!Epi::AFTER_DRAIN) { E(acc, cur, wr, wc, fr, fq); S.done(cur); }
        if (!has_next) break;
#pragma unroll
        for (int a = 0; a < 2; ++a)
#pragma unroll
            for (int b = 0; b < 2; ++b)
#pragma unroll
                for (int m = 0; m < 4; ++m)
#pragma unroll
                    for (int n = 0; n < 2; ++n) acc[a][b][m][n] = (f32x4){0.f, 0.f, 0.f, 0.f};
        cur = nxt; cA = nA; cB = nB; ++ui; _Pragma("unroll") for (int _h = 0; _h < 2; ++_h) _Pragma("unroll") for (int _i = 0; _i < 2; ++_i) vC[_h][_i] = vN[_h][_i];
        if constexpr (ALIGN_EPI) { if (wr == 1) PG8_BAR; }
    }
    PG8_WAIT_V(0);
    if constexpr (!ALIGN_EPI) { if (wr == 0) PG8_BAR; }
    PG8_BAR;
    if constexpr (Epi::AFTER_DRAIN) { E.fused(acc, cur, wr, wc, fr, fq, lds, wid, lane); S.done(cur); }
#undef PG8_SA
#undef PG8_SB
#undef PG8_STAGE
#undef PG8_LDA
#undef PG8_LDB
#undef PG8_MMA
#undef PG8_WAIT_V
#undef PG8_WAIT_L
#undef PG8_BAR
#undef PG8_SCHED
}
#undef PG8_GOFF

}


namespace {
#define GAS __attribute__((address_space(1)))
#define LAS __attribute__((address_space(3)))
typedef unsigned short bf16;
typedef unsigned v4u __attribute__((ext_vector_type(4)));
typedef float f32x4 __attribute__((ext_vector_type(4)));
constexpr int NWAVES = 8, NTHREADS = 512, LDS_BYTES = 147456;

__device__ __forceinline__ unsigned pk2(float lo, float hi) { typedef float f2_c __attribute__((ext_vector_type(2))); typedef __bf16 b2_c __attribute__((ext_vector_type(2))); const f2_c v = {lo, hi}; return __builtin_bit_cast(unsigned, __builtin_convertvector(v, b2_c)); }
__device__ __forceinline__ unsigned f2bf(float f) { return pk2(f, f) & 0xffffu; }
__device__ __forceinline__ float bf2f(bf16 h) { return __uint_as_float((unsigned)h << 16); }
__device__ __forceinline__ float wave_sum(float v) {
#pragma unroll
    for (int o = 1; o < 64; o <<= 1) v += __shfl_xor(v, o);
    return v;
}
__device__ __forceinline__ float sigmoidf_(float x) { return __builtin_amdgcn_rcpf(1.f + __expf(-x)); }
__device__ __forceinline__ int fkey_(float x) { const int b = (int)__float_as_uint(x); return b >= 0 ? b : (b ^ 0x7fffffff); }
__device__ __forceinline__ float fkey_inv_(int k) { return __uint_as_float((unsigned)(k >= 0 ? k : (k ^ 0x7fffffff))); }
constexpr int KEY_NEG_INF = (int)0x807fffff;
template <int CTRL> __device__ __forceinline__ int dppi_(int v) { return __builtin_amdgcn_update_dpp(v, v, CTRL, 0xF, 0xF, false); }
template <int CTRL> __device__ __forceinline__ float dppf_(float v) { return __uint_as_float((unsigned)__builtin_amdgcn_update_dpp((int)__float_as_uint(v), (int)__float_as_uint(v), CTRL, 0xF, 0xF, false)); }
__device__ __forceinline__ int imax_(int a, int b) { return a > b ? a : b; }
__device__ __forceinline__ int gmax8i_(int v) {
    asm volatile("s_nop 1\n\tv_max_i32_dpp %0, %0, %0 quad_perm:[1,0,3,2] row_mask:0xf bank_mask:0xf\n\ts_nop 1\n\tv_max_i32_dpp %0, %0, %0 quad_perm:[2,3,0,1] row_mask:0xf bank_mask:0xf\n\t"
                 "s_nop 1\n\tv_max_i32_dpp %0, %0, %0 row_half_mirror row_mask:0xf bank_mask:0xf" : "+v"(v));
    return v; }
__device__ __forceinline__ int wmaxi_(int v) { v = gmax8i_(v); asm volatile("s_nop 1\n\tv_max_i32_dpp %0, %0, %0 row_mirror row_mask:0xf bank_mask:0xf" : "+v"(v));
    const int a = __builtin_amdgcn_readlane(v, 0), b = __builtin_amdgcn_readlane(v, 16), c = __builtin_amdgcn_readlane(v, 32), d = __builtin_amdgcn_readlane(v, 48); return imax_(imax_(a, b), imax_(c, d)); }
__device__ __forceinline__ float wsumf_(float v) { v += dppf_<0xB1>(v); v += dppf_<0x4E>(v); v += dppf_<0x141>(v); v += dppf_<0x140>(v);
    const float a = __uint_as_float((unsigned)__builtin_amdgcn_readlane((int)__float_as_uint(v), 0)), b = __uint_as_float((unsigned)__builtin_amdgcn_readlane((int)__float_as_uint(v), 16)),
                c = __uint_as_float((unsigned)__builtin_amdgcn_readlane((int)__float_as_uint(v), 32)), d = __uint_as_float((unsigned)__builtin_amdgcn_readlane((int)__float_as_uint(v), 48)); return (a + b) + (c + d); }


struct WS {
    int* ctl;
    bf16 *Wqkv_t, *Wo_t, *Hin_t, *Hout_t, *Wgu_t, *Wd_t;
    float *rot, *lbtab;
    float *V32;
    bf16 *Xb, *Qb, *Kb, *Vb, *Ob, *Gb;
    float *LG;
    bf16 *Uf, *Sf; float *Dbuf;
    float *Wr_t;
    bf16 *H1, *Y;
    int *rowlist; float *tok_w; int *tok_es;
};
constexpr int NROWS = T * 9 + 65 * 256;
constexpr int TAB_OFF = 131072;


template <int PERMK> __device__ __forceinline__ int perm_row(int n) {
    if (PERMK == 1) { if (n < 2048) { const int p = n & 63; if (p < 16) return (n & ~63) + 2 * (p & 7) + (p >> 3); } return n; }
    if (PERMK == 2) { const int up = n >> 8, i = n & 255; return (i >> 7) * 256 + up * 128 + (i & 127); }
    return n;
}
template <int PERMK> __device__ __forceinline__ void transpose_item(const float* W, int K, int N, bf16* WT, LAS float* scr, int item, int lane) {
    const int nblk = N / 32, kb = item / nblk, nb = item % nblk, k0 = 64 * kb, n0 = 32 * nb;
#pragma unroll 8
    for (int i = 0; i < 32; ++i) { const int kk = 2 * i + (lane >> 5); scr[kk * 33 + (lane & 31)] = __builtin_nontemporal_load(W + (size_t)(k0 + kk) * N + n0 + (lane & 31)); }
    asm volatile("s_waitcnt lgkmcnt(0)" ::: "memory");
    const int c = lane & 7;
#pragma unroll
    for (int j = 0; j < 4; ++j) { const int n = (lane >> 3) + 8 * j; const LAS float* s = scr + (8 * c) * 33 + n;
        v4u o; o.x = pk2(s[0 * 33], s[1 * 33]); o.y = pk2(s[2 * 33], s[3 * 33]); o.z = pk2(s[4 * 33], s[5 * 33]); o.w = pk2(s[6 * 33], s[7 * 33]);
        *(GAS v4u*)(WT + (size_t)perm_row<PERMK>(n0 + n) * K + k0 + 8 * c) = o; }
    asm volatile("s_waitcnt lgkmcnt(0)" ::: "memory");
}
template <int PERMK> __device__ __forceinline__ void transpose_batch(const float* W, size_t sstride, bf16* WT, size_t dstride, int nmat, int K, int N, LAS float* scr, int gw, int ngw, int lane) {
    const int ipm = (K / 64) * (N / 32);
    for (int it = gw; it < nmat * ipm; it += ngw) { const int mat = it / ipm; transpose_item<PERMK>(W + (size_t)mat * sstride, K, N, WT + (size_t)mat * dstride, scr, it % ipm, lane); }
}
struct Inputs { const float* p[17]; };
constexpr int CNT_STRIDE = 520, CNT_BASE = 16384;
constexpr int CTL_POISON = 2048;
typedef int v8i_ __attribute__((ext_vector_type(8)));
typedef float v16f_ __attribute__((ext_vector_type(16)));
__device__ __forceinline__ bool fp8_mfma_selftest(int lane) {
    const int r32 = lane & 31, h = lane >> 5;
    v8i_ A, B;
#pragma unroll
    for (int w = 0; w < 8; ++w) {
        float av[4], bv[4];
#pragma unroll
        for (int b = 0; b < 4; ++b) { const int k = 32 * h + 4 * w + b; av[b] = (float)((r32 * 3 + k * 5) % 5); bv[b] = (float)((k * 7 + r32 * 2) % 4); }
        int aw = 0, bw = 0;
        aw = __builtin_amdgcn_cvt_pk_fp8_f32(av[0], av[1], aw, false); aw = __builtin_amdgcn_cvt_pk_fp8_f32(av[2], av[3], aw, true);
        bw = __builtin_amdgcn_cvt_pk_fp8_f32(bv[0], bv[1], bw, false); bw = __builtin_amdgcn_cvt_pk_fp8_f32(bv[2], bv[3], bw, true);
        A[w] = aw; B[w] = bw;
    }
    v16f_ C;
#pragma unroll
    for (int r = 0; r < 16; ++r) C[r] = 0.f;
    C = __builtin_amdgcn_mfma_scale_f32_32x32x64_f8f6f4(A, B, C, 0, 0, 0, 0x7F7F7F7F, 0, 0x7F7F7F7F);
    bool ok = true;
#pragma unroll
    for (int r = 0; r < 16; ++r) {
        const int i = (r & 3) + 8 * (r >> 2) + 4 * h, j = r32; float e = 0.f;
        for (int k = 0; k < 64; ++k) e += (float)((i * 3 + k * 5) % 5) * (float)((k * 7 + j * 2) % 4);
        ok = ok && (C[r] == e);
    }
    return __all(ok);
}

__device__ __forceinline__ void prologue_phase(const Inputs& in, const WS& w, float* X32, LAS unsigned char* lds) {
    int tid_l = threadIdx.x; asm volatile("" : "+v"(tid_l));
    const int tid = tid_l, lane = tid & 63, wave = tid >> 6;
    const int gw = blockIdx.x * NWAVES + wave, ngw = gridDim.x * NWAVES;
    LAS float* scr = (LAS float*)(lds + wave * 16384);
    transpose_batch<1>(in.p[1], (size_t)D * 3072, w.Wqkv_t, (size_t)3072 * D, 2, D, 3072, scr, gw, ngw, lane);
    transpose_batch<0>(in.p[2], (size_t)D * D, w.Wo_t, (size_t)D * D, 2, D, D, scr, gw, ngw, lane);
    transpose_batch<0>(in.p[5], (size_t)D * 4096, w.Hin_t, (size_t)4096 * D, 2, D, 4096, scr, gw, ngw, lane);
    transpose_batch<0>(in.p[6], (size_t)D * D, w.Hout_t, (size_t)D * D, 2, D, D, scr, gw, ngw, lane);
    for (int L = 0; L < DEPTH; ++L) {
        transpose_batch<2>(in.p[11] + (size_t)L * NE * D * 512, (size_t)D * 512, w.Wgu_t + (size_t)L * 65 * 512 * D, (size_t)512 * D, NE, D, 512, scr, gw, ngw, lane);
        transpose_batch<2>(in.p[13] + (size_t)L * D * 512, 0, w.Wgu_t + ((size_t)L * 65 + 64) * 512 * D, 0, 1, D, 512, scr, gw, ngw, lane);
        transpose_batch<0>(in.p[12] + (size_t)L * NE * 256 * D, (size_t)256 * D, w.Wd_t + (size_t)L * 65 * D * 256, (size_t)D * 256, NE, 256, D, scr, gw, ngw, lane);
        transpose_batch<0>(in.p[14] + (size_t)L * 256 * D, 0, w.Wd_t + ((size_t)L * 65 + 64) * D * 256, 0, 1, 256, D, scr, gw, ngw, lane);
    }
    if (blockIdx.x == 0 && wave == 0) { const bool ok = fp8_mfma_selftest(lane); if (!ok && lane == 0) w.ctl[CTL_POISON] = 1; }
    const int gt = blockIdx.x * NTHREADS + tid, ngt = gridDim.x * NTHREADS;
    for (int i = gt; i < SEQ * 8; i += ngt) {
        const int pos = i >> 3, j = i & 7;
        const float inv_freq = (float)pow(500000.0, -(double)(2 * j) / 16.0);
        float sn, cs; sincosf((float)pos * inv_freq, &sn, &cs);
        w.rot[2 * i] = cs; w.rot[2 * i + 1] = sn;
    }
    for (int i = gt; i < 2 * 1024; i += ngt) {
        const int col = i & 1023, L = (i >> 10) ? 3 : 1; const float* r = in.p[7];
        const float v0 = r[col], v1 = r[1024 + col], v2 = r[2048 + col], v3 = r[3072 + col];
        const float mx = fmaxf(fmaxf(v0, v1), fmaxf(v2, v3));
        const float e0 = expf(v0 - mx), e1 = expf(v1 - mx), e2 = expf(v2 - mx), e3 = expf(v3 - mx), den = e0 + e1 + e2 + e3;
        w.lbtab[i] = (L == 1) ? e1 / den : (e1 + e2 + e3) / den;
    }
    if (gt < 2) { const float* lp = in.p[3] + gt * 256; float d01 = 0.f, d23 = 0.f; for (int i = 0; i < 64; ++i) { d01 += lp[i] * lp[64 + i]; d23 += lp[128 + i] * lp[192 + i]; }
        w.lbtab[2048 + gt] = expf(d01) - expf(d23) + (0.8f - 0.6f * expf(-0.3f * (float)(2 * gt))); }
    for (int i = gt; i < T; i += ngt) w.rowlist[(size_t)NE * T + i] = i;
    for (int i = gt; i < DEPTH * NE * D; i += ngt) { const int L = i / (NE * D), r = i % (NE * D), e = r / D, k = r % D; const float v = in.p[9][(size_t)L * D * NE + (size_t)k * NE + e];
        const unsigned hb = f2bf(v); bf16* dst = (bf16*)w.Wr_t + (size_t)L * 2 * NE * D; dst[r] = (bf16)hb; dst[NE * D + r] = (bf16)f2bf(v - __uint_as_float(hb << 16)); }
    for (size_t i = gt; i < (size_t)T * D / 4; i += ngt) {
        const f32x4 v = ((const f32x4*)in.p[0])[i];
        uint2 o; o.x = pk2(v[0], v[1]); o.y = pk2(v[2], v[3]); ((uint2*)w.Xb)[i] = o;
    }
}

__device__ __forceinline__ void ln_row(const float* vrow, float* xrow, bf16* brow, const float* g, const float* b, int lane) {
    f32x4 v[4]; float s = 0.f;
#pragma unroll
    for (int j = 0; j < 4; ++j) { v[j] = ((const f32x4*)vrow)[lane + 64 * j]; s += (v[j][0] + v[j][1]) + (v[j][2] + v[j][3]); }
    const float mean = wsumf_(s) * (1.f / D); float q = 0.f;
#pragma unroll
    for (int j = 0; j < 4; ++j) { v[j] = v[j] - mean; q += (v[j][0] * v[j][0] + v[j][1] * v[j][1]) + (v[j][2] * v[j][2] + v[j][3] * v[j][3]); }
    const float rstd = __builtin_amdgcn_rsqf(wsumf_(q) * (1.f / D) + LN_EPS);
#pragma unroll
    for (int j = 0; j < 4; ++j) {
        const f32x4 g4 = ((const f32x4*)g)[lane + 64 * j], b4 = ((const f32x4*)b)[lane + 64 * j];
        const f32x4 o = v[j] * rstd * g4 + b4;
        ((f32x4*)xrow)[lane + 64 * j] = o;
        uint2 ob; ob.x = pk2(o[0], o[1]); ob.y = pk2(o[2], o[3]); ((uint2*)brow)[lane + 64 * j] = ob;
    }
}
typedef float f32x4_ __attribute__((ext_vector_type(4)));
__device__ __forceinline__ pg8::MoeTabs moe_tables(const int* cnt, LAS unsigned char* lds, int tid) {
    asm volatile("" : "+v"(tid));
    LAS int* toff = (LAS int*)(lds + TAB_OFF); LAS int* cntv = toff + 80; LAS unsigned char* tile_e = (LAS unsigned char*)(cntv + 80);
    __syncthreads();
    if (tid < 64) cntv[tid] = cnt[tid * CNT_STRIDE];
    if (tid == 64) cntv[64] = T;
    __syncthreads();
    if (tid == 0) { int a = 0; for (int e = 0; e < 65; ++e) { toff[e] = a; a += (cntv[e] + 255) >> 8; } toff[65] = a; }
    __syncthreads();
    if (tid < 65) for (int m = toff[tid]; m < toff[tid + 1]; ++m) tile_e[m] = (unsigned char)tid;
    LAS unsigned short* xl = (LAS unsigned short*)(lds + TAB_OFF + 4096); LAS int* nxl = (LAS int*)(lds + TAB_OFF + 4096 + 3072);
    if (tid == 0) {
        const int g = blockIdx.x & 7; int n = 0;
        for (int e = g; e < 64; e += 8) for (int m = toff[e]; m < toff[e + 1]; ++m) xl[n++] = (unsigned short)m;
        for (int m = toff[64] + g; m < toff[65]; m += 8) xl[n++] = (unsigned short)m;
        nxl[0] = n;
    }
    __syncthreads();
    pg8::MoeTabs tb{toff, cntv, tile_e, xl, nxl[0]}; return tb;
}
typedef short bf16x8r __attribute__((ext_vector_type(8)));
__device__ __forceinline__ void lnroute_phase(const float* V32, float* X32, bf16* Xb, const float* lg, const float* lb, const bf16* WrHL, const float* bias, int* cnt, int* rowlist, float* tok_w, int* tok_es, LAS unsigned char* lds) {
    int tid_l = threadIdx.x; asm volatile("" : "+v"(tid_l));
    const int tid = tid_l, lane = tid & 63, wave = tid >> 6;
    constexpr int WP = 144;
    LAS unsigned char* wt = lds;
    LAS float* logitS = (LAS float*)(lds + 40960) + wave * 1024;
    LAS float* selw = (LAS float*)(lds + 40960 + 32768) + wave * 1024;
    LAS int* cntL = (LAS int*)(lds + 40960 + 65536); LAS int* baseL = cntL + 64;
    const float bias_e = bias[lane];
    for (int grp = blockIdx.x; grp < T / 128; grp += gridDim.x) {
        if (tid < 64) cntL[tid] = 0;
        const int tok0 = grp * 128 + wave * 16;
#pragma unroll 1
        for (int rb = 0; rb < 16; rb += 4) {
            f32x4 v[4][4];
#pragma unroll
            for (int r = 0; r < 4; ++r)
#pragma unroll
                for (int j = 0; j < 4; ++j) { typedef unsigned u2v_ __attribute__((ext_vector_type(2))); const u2v_ d = __builtin_nontemporal_load((const u2v_*)((const bf16*)V32 + (size_t)(tok0 + rb + r) * D) + lane + 64 * j);
                    v[r][j] = (f32x4){__uint_as_float(d[0] << 16), __uint_as_float(d[0] & 0xffff0000u), __uint_as_float(d[1] << 16), __uint_as_float(d[1] & 0xffff0000u)}; }
#pragma unroll
            for (int r = 0; r < 4; ++r) {
                float sm = 0.f;
#pragma unroll
                for (int j = 0; j < 4; ++j) sm += (v[r][j][0] + v[r][j][1]) + (v[r][j][2] + v[r][j][3]);
                const float mean = wsumf_(sm) * (1.f / D); float q = 0.f;
#pragma unroll
                for (int j = 0; j < 4; ++j) { v[r][j] = v[r][j] - mean; q += (v[r][j][0] * v[r][j][0] + v[r][j][1] * v[r][j][1]) + (v[r][j][2] * v[r][j][2] + v[r][j][3] * v[r][j][3]); }
                const float rstd = __builtin_amdgcn_rsqf(wsumf_(q) * (1.f / D) + LN_EPS);
#pragma unroll
                for (int j = 0; j < 4; ++j) {
                    const f32x4 g4 = ((const f32x4*)lg)[lane + 64 * j], b4 = ((const f32x4*)lb)[lane + 64 * j];
                    const f32x4 o = v[r][j] * rstd * g4 + b4;
                    uint2 ob; ob.x = pk2(o[0], o[1]); ob.y = pk2(o[2], o[3]); ((uint2*)(Xb + (size_t)(tok0 + rb + r) * D))[lane + 64 * j] = ob;
                }
            }
        }
        asm volatile("s_waitcnt vmcnt(0)" ::: "memory");
        f32x4_ acc[4];
#pragma unroll
        for (int nb = 0; nb < 4; ++nb) acc[nb] = (f32x4_){0.f, 0.f, 0.f, 0.f};
        const bf16* xa = Xb + (size_t)(tok0 + (lane & 15)) * D + 8 * (lane >> 4);
        const bf16* wsrc = WrHL + (size_t)(tid >> 8) * NE * D + (size_t)((tid >> 2) & 63) * D + (tid & 3) * 16;
        const int wdst = ((tid >> 8) * 64 + ((tid >> 2) & 63)) * WP + (tid & 3) * 32;
        v4u w0 = *(const v4u*)(wsrc), w1 = *(const v4u*)(wsrc + 8);
        v4u xa0 = *(const v4u*)(xa), xa1 = *(const v4u*)(xa + 32);
        *(LAS v4u*)(wt + wdst) = w0; *(LAS v4u*)(wt + wdst + 16) = w1;
        __syncthreads();
#pragma unroll 1
        for (int kb = 0; kb < 16; ++kb) {
            const int cur = kb & 1;
            v4u xn0, xn1;
            if (kb + 1 < 16) { w0 = *(const v4u*)(wsrc + (kb + 1) * 64); w1 = *(const v4u*)(wsrc + (kb + 1) * 64 + 8);
                xn0 = *(const v4u*)(xa + (kb + 1) * 64); xn1 = *(const v4u*)(xa + (kb + 1) * 64 + 32); }
#pragma unroll
            for (int ss = 0; ss < 2; ++ss) {
                const v4u ah = ss ? xa1 : xa0;
                const LAS unsigned char* wp = wt + cur * (2 * 64 * WP) + (lane & 15) * WP + (ss * 32 + 8 * (lane >> 4)) * 2;
#pragma unroll
                for (int nb = 0; nb < 4; ++nb) {
                    const v4u bh = *(const LAS v4u*)(wp + nb * 16 * WP), bl = *(const LAS v4u*)(wp + 64 * WP + nb * 16 * WP);
                    acc[nb] = __builtin_amdgcn_mfma_f32_16x16x32_bf16(__builtin_bit_cast(bf16x8r, ah), __builtin_bit_cast(bf16x8r, bh), acc[nb], 0, 0, 0);
                    acc[nb] = __builtin_amdgcn_mfma_f32_16x16x32_bf16(__builtin_bit_cast(bf16x8r, ah), __builtin_bit_cast(bf16x8r, bl), acc[nb], 0, 0, 0);
                }
            }
            if (kb + 1 < 16) { *(LAS v4u*)(wt + (cur ^ 1) * (2 * 64 * WP) + wdst) = w0; *(LAS v4u*)(wt + (cur ^ 1) * (2 * 64 * WP) + wdst + 16) = w1; xa0 = xn0; xa1 = xn1; }
            __syncthreads();
        }
#pragma unroll
        for (int nb = 0; nb < 4; ++nb)
#pragma unroll
            for (int r = 0; r < 4; ++r) logitS[(4 * (lane >> 4) + r) * 64 + 16 * nb + (lane & 15)] = acc[nb][r];
        asm volatile("s_waitcnt lgkmcnt(0)" ::: "memory");
        int mycount = 0;
#pragma unroll 1
        for (int t = 0; t < 16; ++t) {
            const float logit = logitS[t * 64 + lane];
            const float s = sigmoidf_(logit), c = s + bias_e;
            const int kc = fkey_(c);
            const int k1 = gmax8i_(kc);
            const unsigned long long eq = __ballot(kc == k1);
            const int g = lane >> 3; const unsigned gm = (unsigned)((eq >> (g * 8)) & 0xFFull); const int first = __ffs(gm) - 1;
            const int k2 = gmax8i_(((lane & 7) == first) ? KEY_NEG_INF : kc);
            const float gs = fkey_inv_(k1) + fkey_inv_(k2);
            int grank = 0;
#pragma unroll
            for (int gp = 0; gp < 8; ++gp) { const float og = __uint_as_float((unsigned)__builtin_amdgcn_readlane((int)__float_as_uint(gs), gp * 8)); grank += (og > gs || (og == gs && gp < g)) ? 1 : 0; }
            int work = (grank < 4) ? kc : KEY_NEG_INF; unsigned long long selm = 0ull;
#pragma unroll
            for (int r = 0; r < TOPK; ++r) {
                const int mx = wmaxi_(work);
                const unsigned long long e = __ballot(work == mx);
                const int l = __builtin_ctzll(e);
                selm |= 1ull << l;
                work = (lane == l) ? KEY_NEG_INF : work;
            }
            const bool sel = ((selm >> lane) & 1ull) != 0ull;
            const float ssum = wsumf_(sel ? s : 0.f);
            selw[t * 64 + lane] = sel ? s * __builtin_amdgcn_rcpf(ssum + 1e-20f) * ROUTED_SCALE : -1.f;
            mycount += sel ? 1 : 0;
        }
        const int localbase = __hip_atomic_fetch_add(&cntL[lane], mycount, __ATOMIC_RELAXED, __HIP_MEMORY_SCOPE_WORKGROUP);
        __syncthreads();
        if (wave == 0) { const int c = cntL[lane]; baseL[lane] = c > 0 ? atomicAdd(&cnt[lane * CNT_STRIDE], c) : 0; }
        __syncthreads();
        int slot = baseL[lane] + localbase;
#pragma unroll 1
        for (int t = 0; t < 16; ++t) {
            const float wv = selw[t * 64 + lane]; const bool sel = wv >= 0.f;
            const unsigned long long sm = __ballot(sel);
            if (sel) {
                rowlist[(size_t)lane * T + slot] = tok0 + t;
                const int j = __popcll(sm & ((1ull << lane) - 1ull));
                tok_es[(size_t)(tok0 + t) * 8 + j] = (lane << 16) | slot; tok_w[(size_t)(tok0 + t) * 8 + j] = wv;
                ++slot;
            }
        }
        __syncthreads();
    }
}
__device__ __forceinline__ void combine_phase(const unsigned char* Y, const int* tok_es, const float* tok_w, pg8::MoeTabs tb, const bf16* Xin, float* X32, bf16* Xb, const float* g, const float* b, const int* poison) {
    int tid_l = threadIdx.x; asm volatile("" : "+v"(tid_l));
    const int lane = tid_l & 63, gw = blockIdx.x * NWAVES + (tid_l >> 6), ngw = gridDim.x * NWAVES;
    const bool bad = poison[0] != 0;
    for (int row = gw; row < T; row += ngw) {
        const int es = lane < 8 ? tok_es[(size_t)row * 8 + lane] : 0; const float ew = lane < 8 ? tok_w[(size_t)row * 8 + lane] : 0.f;
        const bf16* xin = Xin + (size_t)row * D;
        f32x4 v[4];
#pragma unroll
        for (int j = 0; j < 4; ++j) { const uint2 d = ((const uint2*)xin)[lane + 64 * j];
            v[j] = (f32x4){__uint_as_float(d.x << 16), __uint_as_float(d.x & 0xffff0000u), __uint_as_float(d.y << 16), __uint_as_float(d.y & 0xffff0000u)} * ALPHA; }
#pragma unroll
        for (int jj = 0; jj < 9; ++jj) {
            size_t pos; float gt = 1.f;
            if (jj < 8) { const int p = __shfl(es, jj); gt = __shfl(ew, jj); pos = (size_t)tb.toff[p >> 16] * 256 + (p & 0xffff); } else pos = (size_t)tb.toff[64] * 256 + row;
            const unsigned* yr = (const unsigned*)(Y + pos * 1024); gt *= (1.f / 64.f);
            typedef float f2_ __attribute__((ext_vector_type(2)));
#pragma unroll
            for (int j = 0; j < 4; ++j) { const unsigned d = __builtin_nontemporal_load(yr + lane + 64 * j);
                const f2_ a = __builtin_amdgcn_cvt_pk_f32_fp8((int)d, false), c = __builtin_amdgcn_cvt_pk_f32_fp8((int)d, true);
                v[j][0] += gt * a[0]; v[j][1] += gt * a[1]; v[j][2] += gt * c[0]; v[j][3] += gt * c[1]; }
        }
        float s = 0.f;
#pragma unroll
        for (int j = 0; j < 4; ++j) s += (v[j][0] + v[j][1]) + (v[j][2] + v[j][3]);
        const float mean = wsumf_(s) * (1.f / D); float q = 0.f;
#pragma unroll
        for (int j = 0; j < 4; ++j) { v[j] = v[j] - mean; q += (v[j][0] * v[j][0] + v[j][1] * v[j][1]) + (v[j][2] * v[j][2] + v[j][3] * v[j][3]); }
        const float rstd = __builtin_amdgcn_rsqf(wsumf_(q) * (1.f / D) + LN_EPS);
#pragma unroll
        for (int j = 0; j < 4; ++j) {
            const f32x4 g4 = ((const f32x4*)g)[lane + 64 * j], b4 = ((const f32x4*)b)[lane + 64 * j];
            f32x4 o = v[j] * rstd * g4 + b4;
            if (bad) { const float qn = __builtin_nanf(""); o = (f32x4){qn, qn, qn, qn}; }
            if (X32) ((f32x4*)(X32 + (size_t)row * D))[lane + 64 * j] = o;
            uint2 ob; ob.x = pk2(o[0], o[1]); ob.y = pk2(o[2], o[3]); ((uint2*)(Xb + (size_t)row * D))[lane + 64 * j] = ob;
        }
    }
}
namespace attn {
typedef float f32x16 __attribute__((ext_vector_type(16)));
typedef unsigned u32x4 __attribute__((ext_vector_type(4)));
typedef int v8i __attribute__((ext_vector_type(8)));
constexpr int SLOTB = 16384, NSLOT = 4, WSF_OFF = 65536;
constexpr float THR = 2.f;
constexpr int ONE = 0x7F7F7F7F; constexpr int STG_OFF = 69632;
__device__ __forceinline__ int crow(int r, int hi) { return (r & 3) + 8 * (r >> 2) + 4 * hi; }
__device__ __forceinline__ void glds16(const void* gsrc, unsigned lds_dst) { unsigned keep;
    asm volatile("s_mov_b32 %0, m0\n\ts_mov_b32 m0, %2\n\ts_nop 0\n\tglobal_load_lds_dwordx4 %1, off\n\ts_mov_b32 m0, %0" : "=&s"(keep) : "v"(gsrc), "s"(lds_dst) : "memory"); }
#define ATT_WAIT_BAR(N) asm volatile("s_waitcnt vmcnt(" #N ") lgkmcnt(0)\n\ts_barrier" ::: "memory")
typedef short v4i16_t __attribute__((ext_vector_type(4)));
typedef short s16x4 __attribute__((ext_vector_type(4)));
__device__ __forceinline__ s16x4 vtr(const LAS unsigned char* p) { return __builtin_bit_cast(s16x4, __builtin_amdgcn_ds_read_tr16_b64_v4i16((LAS v4i16_t*)p)); }
__device__ __forceinline__ unsigned cvtpk(float lo, float hi) { typedef float f2 __attribute__((ext_vector_type(2))); typedef __bf16 b2 __attribute__((ext_vector_type(2))); f2 v = {lo, hi}; b2 b = __builtin_convertvector(v, b2); return __builtin_bit_cast(unsigned, b); }
__device__ __forceinline__ float max3f(float a, float b, float c) { float r; asm("v_max3_f32 %0, %1, %2, %3" : "=v"(r) : "v"(a), "v"(b), "v"(c)); return r; }
__device__ __forceinline__ float xhalf_max(float m) { auto rr = __builtin_amdgcn_permlane32_swap(__float_as_uint(m), __float_as_uint(m), false, false); float r; asm("v_max_f32 %0, %1, %2" : "=v"(r) : "v"(rr[0]), "v"(rr[1])); return r; }
__device__ __forceinline__ float xhalf_sum(float m) { auto rr = __builtin_amdgcn_permlane32_swap(__float_as_uint(m), __float_as_uint(m), false, false); return __uint_as_float(rr[0]) + __uint_as_float(rr[1]); }
__device__ __forceinline__ v8i mk8(const u32x4& a, const u32x4& b) { return (v8i){(int)a[0], (int)a[1], (int)a[2], (int)a[3], (int)b[0], (int)b[1], (int)b[2], (int)b[3]}; }

template <int VAR>
__device__ __forceinline__ void attn_unit(int b, int h, int qb, const unsigned char* __restrict__ Q8, const unsigned char* __restrict__ K8, const unsigned char* __restrict__ VT, bf16* Og,
                                          float lam, const float* __restrict__ subg, float oscale, LAS unsigned char* lds) {
    int tid_l = threadIdx.x; asm volatile("" : "+v"(tid_l));
    const int tid = tid_l, lane = tid & 63, r32 = lane & 31, hi = lane >> 5;
    const int wid = __builtin_amdgcn_readfirstlane(tid >> 6), mp = wid >> 2, wq = wid & 3;
    const size_t rowbase = (size_t)b * SEQ; const int q0 = qb * 128;
    const unsigned lds0 = (unsigned)(uintptr_t)lds;
    LAS float* wsf = (LAS float*)(lds + WSF_OFF) + wid * 64;
    const int kkey = 16 * wq + (lane >> 2), kcc = lane & 3;
    const unsigned char* ksrc = K8 + (rowbase + kkey) * 1024 + (h * 2 + mp) * 64 + 16 * (kcc ^ ((kkey >> 2) & 3));
    const unsigned char* vsrc = VT + ((size_t)((b * 8 + h) * 256)) * 8192 + wid * 1024 + lane * 16;
#define ATT_DMA_K(t, slot) glds16(ksrc + (size_t)(t) * 64 * 1024, (unsigned)__builtin_amdgcn_readfirstlane(lds0 + (unsigned)(slot) * SLOTB + wid * 1024))
#define ATT_DMA_V(t, slot) glds16(vsrc + (size_t)(t) * 8192, (unsigned)__builtin_amdgcn_readfirstlane(lds0 + (unsigned)(slot) * SLOTB + 8192 + wid * 1024))
    const unsigned char* Qw = Q8 + (rowbase + q0 + wq * 32 + r32) * 1024 + (h * 2 + mp) * 64 + hi * 32;
    const u32x4 qa = *(const u32x4*)(Qw), qb_ = *(const u32x4*)(Qw + 16);
    const v8i qf = mk8(qa, qb_);
    const int NT = 2 * qb + 2, tlast = 2 * qb + (wq >> 1);
    constexpr int KSL = 8192, VBASE = 4 * 8192;
#undef ATT_DMA_K
#undef ATT_DMA_V
#define ATT_DMA_K(t) glds16(ksrc + (size_t)(t) * 64 * 1024, (unsigned)__builtin_amdgcn_readfirstlane(lds0 + (unsigned)((t) & 3) * KSL + wid * 1024))
#define ATT_DMA_V(t) glds16(vsrc + (size_t)(t) * 8192, (unsigned)__builtin_amdgcn_readfirstlane(lds0 + VBASE + (unsigned)((t) & 3) * KSL + wid * 1024))
    ATT_DMA_K(0); if (NT > 1) ATT_DMA_K(1); ATT_DMA_V(0);
    int nlast = 0; if (NT > 2) { ATT_DMA_K(2); nlast += 1; } if (NT > 1) { ATT_DMA_V(1); nlast += 1; }
    f32x16 o[4];
    float zero_ = 0.f; asm volatile("" : "+v"(zero_));
#pragma unroll
    for (int d = 0; d < 4; ++d)
#pragma unroll
        for (int r = 0; r < 16; ++r) o[d][r] = zero_;
    const int sw = (r32 >> 2) & 3;
    const unsigned fua = (unsigned)(((2 * hi) ^ sw) * 16), fub = (unsigned)(((2 * hi + 1) ^ sw) * 16);
    const LAS unsigned char* kaddr0 = lds + mp * 4096 + r32 * 64; const LAS unsigned char* vaddr0 = lds + VBASE + r32 * 64;
    u32x4 kf[2][2], vf[4][2];
#define ATT_DSR128(dst, addr, off) dst = *(const LAS u32x4*)((addr) + (off))
#define ATT_KISSUE(t) do { const LAS unsigned char* ka_ = kaddr0 + ((t) & 3) * KSL; \
        ATT_DSR128(kf[0][0], ka_ + fua, 0); ATT_DSR128(kf[0][1], ka_ + fub, 0); ATT_DSR128(kf[1][0], ka_ + fua, 2048); ATT_DSR128(kf[1][1], ka_ + fub, 2048); } while (0)
#define ATT_VISSUE(t) do { const LAS unsigned char* va_ = vaddr0 + ((t) & 3) * KSL; \
        _Pragma("unroll") for (int d0 = 0; d0 < 4; ++d0) { ATT_DSR128(vf[d0][0], va_ + fua, d0 * 2048); ATT_DSR128(vf[d0][1], va_ + fub, d0 * 2048); } } while (0)
#define ATT_WB(N) asm volatile("s_waitcnt vmcnt(" #N ") lgkmcnt(0)\n\ts_barrier" ::: "memory")
#define ATT_WAITN(n) do { if ((n) == 2) { ATT_WB(2); } else if ((n) == 1) { ATT_WB(1); } else { ATT_WB(0); } __builtin_amdgcn_sched_barrier(0); } while (0)
#define ATT_SB() __builtin_amdgcn_sched_barrier(0)
#define ATT_QKM(P, blk) do { P = __builtin_amdgcn_mfma_scale_f32_32x32x64_f8f6f4(mk8(kf[blk][0], kf[blk][1]), qf, negm, 0, 0, 0, ONE, 0, ONE); if constexpr (VAR & 64) P = __builtin_amdgcn_mfma_scale_f32_32x32x64_f8f6f4(mk8(kf[blk][0], kf[blk][1]), qf, P, 0, 0, 0, ONE, 0, ONE); } while (0)
#define ATT_PVM(d0) do { o[d0] = __builtin_amdgcn_mfma_scale_f32_32x32x64_f8f6f4(pw, mk8(vf[d0][0], vf[d0][1]), o[d0], 0, 0, 0, ONE, 0, ONE); if constexpr (VAR & 64) o[d0] = __builtin_amdgcn_mfma_scale_f32_32x32x64_f8f6f4(pw, mk8(vf[d0][0], vf[d0][1]), o[d0], 0, 0, 0, ONE, 0, ONE); } while (0)
#define ATT_EXP8(P, b0) do { _Pragma("unroll") for (int r = (b0); r < (b0) + 8; ++r) P[r] = __builtin_amdgcn_exp2f(P[r]); } while (0)
#define ATT_MAXDEC(P0, P1, first) do { \
        float rm; { float ra_; \
        asm volatile("s_nop 15\n\ts_nop 7\n\t"     \
            "v_max3_f32 %0, %2, %3, %4\n\tv_max3_f32 %0, %0, %5, %6\n\tv_max3_f32 %0, %0, %7, %8\n\tv_max3_f32 %0, %0, %9, %10\n\t" \
            "v_max3_f32 %0, %0, %11, %12\n\tv_max3_f32 %0, %0, %13, %14\n\tv_max3_f32 %0, %0, %15, %16\n\tv_max3_f32 %0, %0, %17, %17" \
            : "=&v"(ra_), "+v"(P1) : "v"(P0[0]), "v"(P0[1]), "v"(P0[2]), "v"(P0[3]), "v"(P0[4]), "v"(P0[5]), "v"(P0[6]), "v"(P0[7]), "v"(P0[8]), "v"(P0[9]), "v"(P0[10]), "v"(P0[11]), "v"(P0[12]), "v"(P0[13]), "v"(P0[14]), "v"(P0[15])); \
        asm volatile("v_max3_f32 %0, %1, %2, %3\n\tv_max3_f32 %0, %0, %4, %5\n\tv_max3_f32 %0, %0, %6, %7\n\tv_max3_f32 %0, %0, %8, %9\n\t" \
            "v_max3_f32 %0, %0, %10, %11\n\tv_max3_f32 %0, %0, %12, %13\n\tv_max3_f32 %0, %0, %14, %15\n\tv_max3_f32 %0, %0, %16, %17" \
            : "=&v"(rm) : "v"(ra_), "v"(P1[0]), "v"(P1[1]), "v"(P1[2]), "v"(P1[3]), "v"(P1[4]), "v"(P1[5]), "v"(P1[6]), "v"(P1[7]), "v"(P1[8]), "v"(P1[9]), "v"(P1[10]), "v"(P1[11]), "v"(P1[12]), "v"(P1[13]), "v"(P1[14]), "v"(P1[15])); } \
        rm = xhalf_max(rm) - 6.f; \
        if (first) { _Pragma("unroll") for (int r = 0; r < 16; ++r) { P0[r] -= rm; P1[r] -= rm; negm[r] = 6.f - rm; } } \
        else if (__any(rm > THR)) { const float dl = fmaxf(rm, 0.f); const float nm_ = negm[0] - dl; \
            _Pragma("unroll") for (int r = 0; r < 16; ++r) { P0[r] -= dl; P1[r] -= dl; negm[r] = nm_; } \
            const float f = __builtin_amdgcn_exp2f(-dl); la *= f; lb *= f; if (hi == 0) wsf[r32] = f; resc = true; } } while (0)
    f32x16 pc0, pc1, negm; v8i pw; bool resc = false; float e[32]; float la = 0.f, lb = 0.f;
#pragma unroll
    for (int w = 0; w < 8; ++w) pw[w] = 0;
    ATT_WAITN(nlast);
    ATT_KISSUE(0);
    asm volatile("s_waitcnt lgkmcnt(0)\n\ts_barrier" ::: "memory"); ATT_SB();
#pragma unroll
    for (int r = 0; r < 16; ++r) negm[r] = 6.f;
    ATT_QKM(pc0, 0); ATT_QKM(pc1, 1);
    ATT_MAXDEC(pc0, pc1, true);
#define ATT_ES8(P, b0, eo, L) do { _Pragma("unroll") for (int r = 0; r < 8; ++r) { e[(eo) + r] = __builtin_amdgcn_exp2f(P[(b0) + r]); L += e[(eo) + r]; } \
        asm volatile("" : "+v"(e[(eo)]), "+v"(e[(eo) + 1]), "+v"(e[(eo) + 2]), "+v"(e[(eo) + 3]), "+v"(e[(eo) + 4]), "+v"(e[(eo) + 5]), "+v"(e[(eo) + 6]), "+v"(e[(eo) + 7]), "+v"(L)); } while (0)
#define ATT_CVT16(eo, w0) do { _Pragma("unroll") for (int w = 0; w < 4; ++w) { int x; asm volatile("" : "=v"(x)); x = __builtin_amdgcn_cvt_pk_fp8_f32(e[(eo) + 4 * w], e[(eo) + 4 * w + 1], x, false); x = __builtin_amdgcn_cvt_pk_fp8_f32(e[(eo) + 4 * w + 2], e[(eo) + 4 * w + 3], x, true); pw[(w0) + w] = x; } \
        asm volatile("" : "+v"(pw)); } while (0)
#define ATT_ISSUE_DMA(t) do { nlast = 0; if ((t) + 3 < NT) { ATT_DMA_K((t) + 3); nlast += 1; } if ((t) + 2 < NT) { ATT_DMA_V((t) + 2); nlast += 1; } } while (0)
#define ATT_PV_EXP() do { \
        ATT_PVM(0); ATT_SB(); ATT_ES8(pc0, 0, 0, la); ATT_SB(); \
        ATT_PVM(1); ATT_SB(); ATT_ES8(pc0, 8, 8, lb); ATT_SB(); \
        ATT_PVM(2); ATT_SB(); ATT_ES8(pc1, 0, 16, la); ATT_SB(); \
        ATT_PVM(3); ATT_SB(); ATT_ES8(pc1, 8, 24, lb); ATT_SB(); } while (0)
#define ATT_PV_EXP_D(t) do { \
        ATT_PVM(0); ATT_SB(); if (mp == 0) ATT_DMA_K((t) + 3); ATT_ES8(pc0, 0, 0, la); ATT_SB(); \
        ATT_PVM(1); ATT_SB(); if (mp == 1) ATT_DMA_K((t) + 3); ATT_ES8(pc0, 8, 8, lb); ATT_SB(); \
        ATT_PVM(2); ATT_SB(); if (mp == 0) ATT_DMA_V((t) + 2); ATT_ES8(pc1, 0, 16, la); ATT_SB(); \
        ATT_PVM(3); ATT_SB(); if (mp == 1) ATT_DMA_V((t) + 2); ATT_ES8(pc1, 8, 24, lb); ATT_SB(); } while (0)
#define ATT_RESC() do { if (resc) { resc = false; \
        _Pragma("unroll") for (int r = 0; r < 16; ++r) { const float fr = wsf[crow(r, hi)]; \
            _Pragma("unroll") for (int d = 0; d < 4; ++d) o[d][r] *= fr; } } } while (0)
#define ATT_CVT_ASM(eo, w0, TIE) do { int x0_, x1_, x2_, x3_; \
        asm volatile("v_cvt_pk_fp8_f32 %0, %5, %6\n\tv_cvt_pk_fp8_f32 %1, %9, %10\n\tv_cvt_pk_fp8_f32 %2, %13, %14\n\tv_cvt_pk_fp8_f32 %3, %17, %18\n\tv_cvt_pk_fp8_f32 %0, %7, %8 op_sel:[0,0,1]\n\tv_cvt_pk_fp8_f32 %1, %11, %12 op_sel:[0,0,1]\n\tv_cvt_pk_fp8_f32 %2, %15, %16 op_sel:[0,0,1]\n\tv_cvt_pk_fp8_f32 %3, %19, %20 op_sel:[0,0,1]" \
            : "=&v"(x0_), "=&v"(x1_), "=&v"(x2_), "=&v"(x3_), "+v"(TIE) : "v"(e[(eo) + 0]), "v"(e[(eo) + 1]), "v"(e[(eo) + 2]), "v"(e[(eo) + 3]), "v"(e[(eo) + 4]), "v"(e[(eo) + 5]), "v"(e[(eo) + 6]), "v"(e[(eo) + 7]), "v"(e[(eo) + 8]), "v"(e[(eo) + 9]), "v"(e[(eo) + 10]), "v"(e[(eo) + 11]), "v"(e[(eo) + 12]), "v"(e[(eo) + 13]), "v"(e[(eo) + 14]), "v"(e[(eo) + 15])); \
        pw[(w0)] = x0_; pw[(w0) + 1] = x1_; pw[(w0) + 2] = x2_; pw[(w0) + 3] = x3_; } while (0)
#define ATT_MAXDEC2(P0, P1) do { \
        ATT_CVT_ASM(0, 0, P1); ATT_CVT_ASM(16, 4, P1); \
        float rmr_; { float ra_; \
        asm volatile("s_nop 1\n\tv_max3_f32 %0, %2, %3, %4\n\tv_max3_f32 %0, %0, %5, %6\n\tv_max3_f32 %0, %0, %7, %8\n\tv_max3_f32 %0, %0, %9, %10\n\tv_max3_f32 %0, %0, %11, %12\n\tv_max3_f32 %0, %0, %13, %14\n\tv_max3_f32 %0, %0, %15, %16\n\tv_max3_f32 %0, %0, %17, %17" \
            : "=&v"(ra_), "+v"(P1) : "v"(P0[0]), "v"(P0[1]), "v"(P0[2]), "v"(P0[3]), "v"(P0[4]), "v"(P0[5]), "v"(P0[6]), "v"(P0[7]), "v"(P0[8]), "v"(P0[9]), "v"(P0[10]), "v"(P0[11]), "v"(P0[12]), "v"(P0[13]), "v"(P0[14]), "v"(P0[15])); \
        asm volatile("v_max3_f32 %0, %1, %2, %3\n\tv_max3_f32 %0, %0, %4, %5\n\tv_max3_f32 %0, %0, %6, %7\n\tv_max3_f32 %0, %0, %8, %9\n\tv_max3_f32 %0, %0, %10, %11\n\tv_max3_f32 %0, %0, %12, %13\n\tv_max3_f32 %0, %0, %14, %15\n\tv_max3_f32 %0, %0, %16, %17\n\tv_mov_b32 %1, %0\n\ts_nop 1\n\tv_permlane32_swap_b32 %0, %1\n\tv_max_f32 %0, %0, %1" \
            : "=&v"(rmr_), "+v"(ra_) : "v"(P1[0]), "v"(P1[1]), "v"(P1[2]), "v"(P1[3]), "v"(P1[4]), "v"(P1[5]), "v"(P1[6]), "v"(P1[7]), "v"(P1[8]), "v"(P1[9]), "v"(P1[10]), "v"(P1[11]), "v"(P1[12]), "v"(P1[13]), "v"(P1[14]), "v"(P1[15])); } \
        if (__any(rmr_ > THR + 6.f)) { const float dl = fmaxf(rmr_ - 6.f, 0.f); const float nm_ = negm[0] - dl;     \
            _Pragma("unroll") for (int r = 0; r < 16; ++r) { P0[r] -= dl; P1[r] -= dl; negm[r] = nm_; } \
            const float f = __builtin_amdgcn_exp2f(-dl); la *= f; lb *= f; if (hi == 0) wsf[r32] = f; resc = true; } } while (0)
#define ATT_QK_NEXT(t) do { \
        ATT_QKM(pc0, 0); ATT_SB(); \
        ATT_QKM(pc1, 1); ATT_SB(); \
        ATT_MAXDEC2(pc0, pc1); } while (0)
    {
        ATT_ISSUE_DMA(0);
        if (1 <= tlast) ATT_KISSUE(1);
        ATT_ES8(pc0, 0, 0, la); ATT_ES8(pc0, 8, 8, lb); ATT_ES8(pc1, 0, 16, la); ATT_ES8(pc1, 8, 24, lb);
        ATT_VISSUE(0);
        if (1 <= tlast) ATT_QK_NEXT(0); else { ATT_CVT16(0, 0); ATT_CVT16(16, 4); }
        ATT_WAITN(nlast);
    }
    int t = 1;
#define ATT_KISSUE_S(sl) do { const LAS unsigned char* ka_ = kaddr0 + (sl) * KSL; \
        ATT_DSR128(kf[0][0], ka_ + fua, 0); ATT_DSR128(kf[0][1], ka_ + fub, 0); ATT_DSR128(kf[1][0], ka_ + fua, 2048); ATT_DSR128(kf[1][1], ka_ + fub, 2048); } while (0)
#define ATT_VISSUE_S(sl) do { const LAS unsigned char* va_ = vaddr0 + (sl) * KSL; \
        _Pragma("unroll") for (int d0 = 0; d0 < 4; ++d0) { ATT_DSR128(vf[d0][0], va_ + fua, d0 * 2048); ATT_DSR128(vf[d0][1], va_ + fub, d0 * 2048); } } while (0)
#define ATT_DMA_K_S(tt, sl) glds16(ksrc + (size_t)(tt) * 64 * 1024, (unsigned)__builtin_amdgcn_readfirstlane(lds0 + (unsigned)(sl) * KSL + wid * 1024))
#define ATT_DMA_V_S(tt, sl) glds16(vsrc + (size_t)(tt) * 8192, (unsigned)__builtin_amdgcn_readfirstlane(lds0 + VBASE + (unsigned)(sl) * KSL + wid * 1024))
#define ATT_STEP_S(tt, c) do { \
        ATT_KISSUE_S(((c) + 1) & 3); ATT_SB(); \
        ATT_PVM(0); ATT_SB(); ATT_DMA_K_S((tt) + 3, ((c) + 3) & 3); ATT_ES8(pc0, 0, 0, la); ATT_SB(); \
        ATT_PVM(1); ATT_SB(); ATT_ES8(pc0, 8, 8, lb); ATT_SB(); \
        ATT_PVM(2); ATT_SB(); ATT_DMA_V_S((tt) + 2, ((c) + 2) & 3); ATT_ES8(pc1, 0, 16, la); ATT_SB(); \
        ATT_PVM(3); ATT_SB(); ATT_ES8(pc1, 8, 24, lb); ATT_SB(); \
        ATT_RESC(); \
        ATT_VISSUE_S((c) & 3); \
        ATT_QK_NEXT(tt); \
        ATT_WB(2); ATT_SB(); } while (0)
    const int nst = tlast < NT - 3 ? tlast : NT - 3;
#pragma unroll 1
    for (; t + 3 < nst; t += 4) { ATT_STEP_S(t, 1); ATT_STEP_S(t + 1, 2); ATT_STEP_S(t + 2, 3); ATT_STEP_S(t + 3, 0); }
    for (; t < tlast && t + 3 < NT; ++t) {
        ATT_KISSUE(t + 1); ATT_SB();
        ATT_PV_EXP_D(t);
        ATT_RESC();
        ATT_VISSUE(t);
        ATT_QK_NEXT(t);
        ATT_WB(2); ATT_SB();
    }
    for (; t < tlast; ++t) {
        ATT_ISSUE_DMA(t);
        ATT_KISSUE(t + 1); ATT_SB();
        ATT_PV_EXP();
        ATT_RESC();
        ATT_VISSUE(t);
        ATT_QK_NEXT(t);
        ATT_WAITN(nlast);
    }
    if (tlast >= 1) {
        ATT_ISSUE_DMA(tlast);
        ATT_PV_EXP();
        ATT_RESC();
        ATT_VISSUE(tlast);
        ATT_CVT16(0, 0); ATT_CVT16(16, 4);
        ATT_WAITN(nlast);
    }
    if (tlast + 1 < NT) {
        ATT_ISSUE_DMA(tlast + 1);
        ATT_PVM(0); ATT_PVM(1); ATT_PVM(2); ATT_PVM(3);
        ATT_WAITN(nlast);
    } else { ATT_PVM(0); ATT_PVM(1); ATT_PVM(2); ATT_PVM(3); }
    float l_reg = xhalf_sum(la + lb);
    if (hi == 0) wsf[32 + r32] = l_reg;
    asm volatile("s_waitcnt lgkmcnt(0)" ::: "memory");
    float rli[16];
#pragma unroll
    for (int r = 0; r < 16; ++r) rli[r] = 0.0625f * __builtin_amdgcn_rcpf(wsf[32 + crow(r, hi)]);
    ATT_WAIT_BAR(0);
    LAS float* xo = (LAS float*)(lds + wq * 16384) + lane;
    if (mp == 1) {
#pragma unroll
        for (int d = 0; d < 4; ++d)
#pragma unroll
            for (int r = 0; r < 16; ++r) xo[(d * 16 + r) * 64] = o[d][r] * rli[r];
    }
    ATT_WAIT_BAR(0);
    float ss[16];
#pragma unroll
    for (int r = 0; r < 16; ++r) ss[r] = 0.f;
    if (mp == 0) {
#pragma unroll
        for (int d = 0; d < 4; ++d)
#pragma unroll
            for (int r = 0; r < 16; ++r) { const float v = o[d][r] * rli[r] - lam * xo[(d * 16 + r) * 64]; o[d][r] = v; ss[r] += v * v; }
#pragma unroll
        for (int r = 0; r < 16; ++r) { float s = ss[r]; s += __shfl_xor(s, 1); s += __shfl_xor(s, 2); s += __shfl_xor(s, 4); s += __shfl_xor(s, 8); s += __shfl_xor(s, 16);
            ss[r] = oscale * __builtin_amdgcn_rsqf(s * (1.f / 128.f) + LN_EPS); }
        asm volatile("s_waitcnt lgkmcnt(0)" ::: "memory");
    }
    ATT_WAIT_BAR(0);
    if (mp == 0) {
        LAS unsigned short* stg = (LAS unsigned short*)(lds + STG_OFF + wq * 8192);
#pragma unroll
        for (int d = 0; d < 4; ++d) { const float gsc = subg[d * 32 + r32];
#pragma unroll
            for (int r = 0; r < 16; ++r) stg[crow(r, hi) * 128 + d * 32 + r32] = (unsigned short)f2bf(o[d][r] * ss[r] * gsc); }
        asm volatile("s_waitcnt lgkmcnt(0)" ::: "memory");
        bf16* Ow = Og + (rowbase + q0 + wq * 32) * 1024 + h * 128;
#pragma unroll
        for (int i = 0; i < 8; ++i) { const int row = 4 * i + (lane >> 4), ch = lane & 15;
            const u32x4 v = *(const LAS u32x4*)(stg + row * 128 + ch * 8);
            *(u32x4*)(Ow + (size_t)row * 1024 + ch * 8) = v; }
    }
#undef ATT_DMA_K
#undef ATT_DMA_V
}
template <int VAR = 0>
__device__ __forceinline__ void attn_phase(const unsigned char* Q8, const unsigned char* K8, const unsigned char* VT, bf16* Og, float lam, const float* subg, float oscale, LAS unsigned char* lds) {
    const int G = gridDim.x, bx = blockIdx.x, vcu = (G % 8 == 0) ? (bx % 8) * (G / 8) + bx / 8 : bx;
    for (int v = vcu; v < 256; v += G) {
        const int bh = v >> 4, s = v & 15;
#pragma unroll 1
        for (int i = 0; i < 8; ++i) {
            const int qb = (i >> 1) * 32 + ((i & 1) ? 31 - s : s);
            attn_unit<VAR>(bh >> 3, bh & 7, qb, Q8, K8, VT, Og, lam, subg, oscale, lds);
        }
    }
}
}

namespace hgrn {
typedef short bf16x8 __attribute__((ext_vector_type(8)));
typedef short s16x4 __attribute__((ext_vector_type(4)));
typedef float f32x16 __attribute__((ext_vector_type(16)));
typedef unsigned u32x4 __attribute__((ext_vector_type(4)));
typedef unsigned u32x2 __attribute__((ext_vector_type(2)));
constexpr int L_WT = 0, L_BM = 4096, L_KT = 8192, L_VT = 24576, L_QB = 40960, L_KB = 57344, L_QT = 73728, L_SSQ = 90624;
constexpr int QT_PITCH = 264;
using attn::crow; using attn::vtr; using attn::cvtpk;

__device__ __forceinline__ void chunk_cumsum(float (&v)[16], int lane, int wave, int seg, LAS unsigned char* lds) {
    LAS float* WT = (LAS float*)(lds + L_WT);
#pragma unroll
    for (int off = 8; off < 64; off <<= 1)
#pragma unroll
        for (int i = 0; i < 16; ++i) { const float n = __shfl_up(v[i], off); if (lane >= off) v[i] += n; }
    if (lane >= 56) {
#pragma unroll
        for (int i = 0; i < 16; ++i) WT[wave * 128 + seg * 16 + i] = v[i];
    }
    __syncthreads();
    for (int w = 0; w < wave; ++w) {
#pragma unroll
        for (int i = 0; i < 16; i += 4) { const f32x4 a = *(const LAS f32x4*)(WT + w * 128 + seg * 16 + i); v[i] += a[0]; v[i + 1] += a[1]; v[i + 2] += a[2]; v[i + 3] += a[3]; }
    }
}
__device__ __forceinline__ void unpack16(const u32x4& a, const u32x4& b, float (&o)[16]) {
#pragma unroll
    for (int i = 0; i < 4; ++i) { o[2 * i] = __uint_as_float(a[i] << 16); o[2 * i + 1] = __uint_as_float(a[i] & 0xffff0000u); o[8 + 2 * i] = __uint_as_float(b[i] << 16); o[8 + 2 * i + 1] = __uint_as_float(b[i] & 0xffff0000u); }
}
__device__ __forceinline__ void pack16(const float (&v)[16], u32x4& a, u32x4& b) {
#pragma unroll
    for (int i = 0; i < 4; ++i) { a[i] = cvtpk(v[2 * i], v[2 * i + 1]); b[i] = cvtpk(v[8 + 2 * i], v[8 + 2 * i + 1]); }
}
__device__ __forceinline__ int tr_off(int s, int seg) { return ((seg >> 1) * 4 + (s >> 4)) * 1024 + (s & 15) * 64 + (seg & 1) * 32; }

__device__ __forceinline__ void passA(const bf16* Kh, const bf16* LG, const bf16* Vh, bf16* Ufrag, float* Dbuf, LAS unsigned char* lds) {
    int tid_l = threadIdx.x; asm volatile("" : "+v"(tid_l));
    const int tid = tid_l, lane = tid & 63, wave = __builtin_amdgcn_readfirstlane(tid >> 6), t = tid >> 3, seg = tid & 7, hi = lane >> 5;
    LAS float* BL = (LAS float*)(lds + L_BM);
    for (int unit = blockIdx.x; unit < 4096; unit += gridDim.x) {
        const int bh = unit >> 8, c = unit & 255;
        const size_t ro = ((size_t)(bh >> 3) * SEQ + c * 64 + t) * 1024 + (bh & 7) * 128 + seg * 16;
        float b[16];
        { const u32x4 l0 = *(const u32x4*)(LG + ro), l1 = *(const u32x4*)(LG + ro + 8); unpack16(l0, l1, b); }
        const u32x4 k0 = *(const u32x4*)(Kh + ro), k1 = *(const u32x4*)(Kh + ro + 8), v0 = *(const u32x4*)(Vh + ro), v1 = *(const u32x4*)(Vh + ro + 8);
        chunk_cumsum(b, lane, wave, seg, lds);
        if (t == 63) {
#pragma unroll
            for (int i = 0; i < 16; ++i) { BL[seg * 16 + i] = b[i]; Dbuf[(size_t)unit * 128 + seg * 16 + i] = __expf(b[i]); }
        }
        __syncthreads();
        float kk[16]; unpack16(k0, k1, kk);
#pragma unroll
        for (int i = 0; i < 16; ++i) kk[i] *= __expf(BL[seg * 16 + i] - b[i]);
        u32x4 ka, kb_; pack16(kk, ka, kb_);
        const int to = tr_off(t, seg);
        *(LAS u32x4*)(lds + L_KT + to) = ka; *(LAS u32x4*)(lds + L_KT + to + 16) = kb_;
        *(LAS u32x4*)(lds + L_VT + to) = v0; *(LAS u32x4*)(lds + L_VT + to + 16) = v1;
        __syncthreads();
        const int db = wave >> 1, eb0 = (wave & 1) * 2;
        const int fo = ((lane >> 4) & 1) * 32 + (lane & 3) * 8 + (4 * hi + ((lane & 15) >> 2)) * 64;
        f32x16 u[2];
#pragma unroll
        for (int x = 0; x < 2; ++x)
#pragma unroll
            for (int r = 0; r < 16; ++r) u[x][r] = 0.f;
#pragma unroll
        for (int ks = 0; ks < 4; ++ks) {
            const LAS unsigned char* ap = lds + L_KT + (db * 4 + ks) * 1024 + fo;
            const s16x4 al = vtr(ap), ah = vtr(ap + 512);
            const bf16x8 af = (bf16x8){al[0], al[1], al[2], al[3], ah[0], ah[1], ah[2], ah[3]};
#pragma unroll
            for (int x = 0; x < 2; ++x) {
                const LAS unsigned char* bp = lds + L_VT + ((eb0 + x) * 4 + ks) * 1024 + fo;
                const s16x4 bl = vtr(bp), bhh = vtr(bp + 512);
                const bf16x8 bfr = (bf16x8){bl[0], bl[1], bl[2], bl[3], bhh[0], bhh[1], bhh[2], bhh[3]};
                u[x] = __builtin_amdgcn_mfma_f32_32x32x16_bf16(af, bfr, u[x], 0, 0, 0);
            }
        }
#pragma unroll
        for (int x = 0; x < 2; ++x) {
            u32x4 a, b2;
#pragma unroll
            for (int i = 0; i < 4; ++i) { a[i] = cvtpk(u[x][2 * i], u[x][2 * i + 1]); b2[i] = cvtpk(u[x][8 + 2 * i], u[x][8 + 2 * i + 1]); }
            bf16* up = Ufrag + (((size_t)unit * 16 + db * 4 + eb0 + x) * 64 + lane) * 16;
            *(u32x4*)up = a; *(u32x4*)(up + 8) = b2;
        }
        __syncthreads();
    }
}
__device__ __forceinline__ void passB(const bf16* Ufrag, const float* Dbuf, bf16* Sfrag) {
    int tid_l = threadIdx.x; asm volatile("" : "+v"(tid_l));
    const int tid = tid_l;
    if (tid >= 256) return;
    for (int i = blockIdx.x * 256 + tid; i < 65536; i += gridDim.x * 256) {
        const int seq = i >> 12, rem = i & 4095, tile = rem >> 8, lane = (rem >> 2) & 63, g = rem & 3;
        const int d0 = 32 * (tile >> 2) + 8 * g + 4 * (lane >> 5);
        const size_t eo = (((size_t)seq * 256 * 16 + tile) * 64 + lane) * 16 + 4 * g;
        const float* dp = Dbuf + (size_t)seq * 256 * 128 + d0;
        float s0 = 0.f, s1 = 0.f, s2 = 0.f, s3 = 0.f;
        for (int c0 = 0; c0 < 256; c0 += 8) {
            u32x2 uu[8]; f32x4 dd[8];
#pragma unroll
            for (int j = 0; j < 8; ++j) { uu[j] = *(const u32x2*)(Ufrag + eo + (size_t)(c0 + j) * 16384); dd[j] = *(const f32x4*)(dp + (size_t)(c0 + j) * 128); }
#pragma unroll
            for (int j = 0; j < 8; ++j) {
                u32x2 so; so[0] = cvtpk(s0, s1); so[1] = cvtpk(s2, s3);
                *(u32x2*)(Sfrag + eo + (size_t)(c0 + j) * 16384) = so;
                s0 = dd[j][0] * s0 + __uint_as_float(uu[j][0] << 16); s1 = dd[j][1] * s1 + __uint_as_float(uu[j][0] & 0xffff0000u);
                s2 = dd[j][2] * s2 + __uint_as_float(uu[j][1] << 16); s3 = dd[j][3] * s3 + __uint_as_float(uu[j][1] & 0xffff0000u);
            }
        }
    }
}
template <int PARTS = 7>
__device__ __forceinline__ void passC(const bf16* Qh, const bf16* Kh, const bf16* LG, const bf16* Vh, const bf16* Gh, const bf16* Sfrag, const float* ng, bf16* Oh, LAS unsigned char* lds) {
    int tid_l = threadIdx.x; asm volatile("" : "+v"(tid_l));
    const int tid = tid_l, lane = tid & 63, wave = __builtin_amdgcn_readfirstlane(tid >> 6), t = tid >> 3, seg = tid & 7, hi = lane >> 5, r32 = lane & 31;
    const int tb = wave >> 2, eb = wave & 3;
    LAS float* BM = (LAS float*)(lds + L_BM); LAS float* SSQ = (LAS float*)(lds + L_SSQ);
    const float ngl = ng[eb * 32 + r32];
    for (int unit = blockIdx.x; unit < 4096; unit += gridDim.x) {
        const int bh = unit >> 8, c = unit & 255;
        const size_t rb = ((size_t)(bh >> 3) * SEQ + c * 64) * 1024 + (bh & 7) * 128;
        const size_t ro = rb + (size_t)t * 1024 + seg * 16;
        float b[16];
        { const u32x4 l0 = *(const u32x4*)(LG + ro), l1 = *(const u32x4*)(LG + ro + 8); unpack16(l0, l1, b); }
        const u32x4 q0 = *(const u32x4*)(Qh + ro), q1 = *(const u32x4*)(Qh + ro + 8), k0 = *(const u32x4*)(Kh + ro), k1 = *(const u32x4*)(Kh + ro + 8);
        const u32x4 v0 = *(const u32x4*)(Vh + ro), v1 = *(const u32x4*)(Vh + ro + 8);
        u32x4 sf[4][2];
#pragma unroll
        for (int db = 0; db < 4; ++db) { const bf16* sp = Sfrag + (((size_t)unit * 16 + db * 4 + eb) * 64 + lane) * 16; sf[db][0] = *(const u32x4*)sp; sf[db][1] = *(const u32x4*)(sp + 8); }
        float gate[16];
#pragma unroll
        for (int r = 0; r < 16; ++r) gate[r] = bf2f(Gh[rb + (size_t)(32 * tb + crow(r, hi)) * 1024 + eb * 32 + r32]);
        chunk_cumsum(b, lane, wave, seg, lds);
        if (t == 31) {
#pragma unroll
            for (int i = 0; i < 16; ++i) BM[seg * 16 + i] = b[i];
        }
        __syncthreads();
        {
            float qq[16], kk[16], qt[16]; unpack16(q0, q1, qq); unpack16(k0, k1, kk);
#pragma unroll
            for (int i = 0; i < 16; ++i) { const float bm = BM[seg * 16 + i]; qt[i] = qq[i] * __expf(b[i]); qq[i] *= __expf(b[i] - bm); kk[i] *= __expf(bm - b[i]); }
            u32x4 a0, a1; pack16(qq, a0, a1);
            *(LAS u32x4*)(lds + L_QB + (seg * 2) * 1024 + t * 16) = a0; *(LAS u32x4*)(lds + L_QB + (seg * 2 + 1) * 1024 + t * 16) = a1;
            pack16(kk, a0, a1);
            *(LAS u32x4*)(lds + L_KB + (seg * 2) * 1024 + t * 16) = a0; *(LAS u32x4*)(lds + L_KB + (seg * 2 + 1) * 1024 + t * 16) = a1;
            pack16(qt, a0, a1);
            LAS unsigned char* qp = lds + L_QT + t * QT_PITCH + seg * 32;
            *(LAS u32x2*)(qp) = (u32x2){a0[0], a0[1]}; *(LAS u32x2*)(qp + 8) = (u32x2){a0[2], a0[3]}; *(LAS u32x2*)(qp + 16) = (u32x2){a1[0], a1[1]}; *(LAS u32x2*)(qp + 24) = (u32x2){a1[2], a1[3]};
            const int to = tr_off(t, seg);
            *(LAS u32x4*)(lds + L_VT + to) = v0; *(LAS u32x4*)(lds + L_VT + to + 16) = v1;
        }
        __syncthreads();
        if constexpr ((PARTS & 2) == 0) { if (b[0] == 12345.678f) Oh[rb] = 1; __syncthreads(); continue; }
        f32x16 p[2];
#pragma unroll
        for (int x = 0; x < 2; ++x)
#pragma unroll
            for (int r = 0; r < 16; ++r) p[x][r] = 0.f;
#pragma unroll
        for (int sb = 0; sb < 2; ++sb) {
            if (sb <= tb) {
#pragma unroll
                for (int d0 = 0; d0 < 8; ++d0) {
                    const bf16x8 ka = *(const LAS bf16x8*)(lds + L_KB + (2 * d0 + hi) * 1024 + (32 * sb + r32) * 16);
                    const bf16x8 qb_ = *(const LAS bf16x8*)(lds + L_QB + (2 * d0 + hi) * 1024 + (32 * tb + r32) * 16);
                    p[sb] = __builtin_amdgcn_mfma_f32_32x32x16_bf16(ka, qb_, p[sb], 0, 0, 0);
                }
            }
        }
        if (tb == 0) {
#pragma unroll
            for (int r = 0; r < 16; ++r) if (crow(r, hi) > r32) p[0][r] = 0.f;
        } else {
#pragma unroll
            for (int r = 0; r < 16; ++r) if (crow(r, hi) > r32) p[1][r] = 0.f;
        }
        u32x4 pw[4];
#pragma unroll
        for (int i = 0; i < 4; ++i) { pw[0][i] = cvtpk(p[0][2 * i], p[0][2 * i + 1]); pw[1][i] = cvtpk(p[0][8 + 2 * i], p[0][8 + 2 * i + 1]); pw[2][i] = cvtpk(p[1][2 * i], p[1][2 * i + 1]); pw[3][i] = cvtpk(p[1][8 + 2 * i], p[1][8 + 2 * i + 1]); }
        f32x16 o;
#pragma unroll
        for (int r = 0; r < 16; ++r) o[r] = 0.f;
        const int fo = ((lane >> 4) & 1) * 32 + (lane & 3) * 8 + (4 * hi + ((lane & 15) >> 2)) * 64;
#pragma unroll
        for (int ks = 0; ks < 4; ++ks) {
            if (ks < 2 * (tb + 1)) {
                const LAS unsigned char* bp = lds + L_VT + (eb * 4 + ks) * 1024 + fo;
                const s16x4 bl = vtr(bp), bhh = vtr(bp + 512);
                const bf16x8 vf = (bf16x8){bl[0], bl[1], bl[2], bl[3], bhh[0], bhh[1], bhh[2], bhh[3]};
                o = __builtin_amdgcn_mfma_f32_32x32x16_bf16(__builtin_bit_cast(bf16x8, pw[ks]), vf, o, 0, 0, 0);
            }
        }
#pragma unroll
        for (int s8 = 0; s8 < 8; ++s8) {
            const int db = s8 >> 1, half = s8 & 1;
            const LAS unsigned char* qp = lds + L_QT + (32 * tb + r32) * QT_PITCH + (32 * db + 16 * half + 4 * hi) * 2;
            const u32x2 lo = *(const LAS u32x2*)qp, hh = *(const LAS u32x2*)(qp + 16);
            const u32x4 af = (u32x4){lo[0], lo[1], hh[0], hh[1]};
            o = __builtin_amdgcn_mfma_f32_32x32x16_bf16(__builtin_bit_cast(bf16x8, af), __builtin_bit_cast(bf16x8, sf[db][half]), o, 0, 0, 0);
        }
        if constexpr ((PARTS & 4) == 0) { if (o[0] == 12345.678f) Oh[rb] = 1; __syncthreads(); continue; }
        float ssr[16];
#pragma unroll
        for (int r = 0; r < 16; ++r) { float s = o[r] * o[r]; s += __shfl_xor(s, 1); s += __shfl_xor(s, 2); s += __shfl_xor(s, 4); s += __shfl_xor(s, 8); s += __shfl_xor(s, 16); ssr[r] = s; }
        if (r32 == 0) {
#pragma unroll
            for (int r = 0; r < 16; ++r) SSQ[wave * 32 + crow(r, hi)] = ssr[r];
        }
        __syncthreads();
        bf16* op = Oh + rb + (size_t)(32 * tb) * 1024 + eb * 32 + r32;
#pragma unroll
        for (int r = 0; r < 16; ++r) {
            const int row = crow(r, hi);
            const float tot = SSQ[(tb * 4 + 0) * 32 + row] + SSQ[(tb * 4 + 1) * 32 + row] + SSQ[(tb * 4 + 2) * 32 + row] + SSQ[(tb * 4 + 3) * 32 + row];
            const float rstd = __builtin_amdgcn_rsqf(tot * (1.f / 128.f) + LN_EPS);
            op[(size_t)row * 1024] = (bf16)f2bf(o[r] * rstd * ngl * gate[r]);
        }
        __syncthreads();
    }
}
}


#define XB_TMO      128
#define XB_XCNT(j)  (256  + 64 * (j))
#define XB_XSUB(j)  (1280 + 64 * (j))
#define XB_XGEN(j)  (2304 + 64 * (j))
#define XB_TOP      3328
#define XB_TOPGEN   3392
#define XCD_BAR_WORDS 3456
#define XB_SPIN_CAP (1u << 18)

__device__ __forceinline__ unsigned xb_ld(unsigned* p)              { return __hip_atomic_load(p, __ATOMIC_RELAXED, __HIP_MEMORY_SCOPE_AGENT); }
__device__ __forceinline__ unsigned xb_add(unsigned* p, unsigned v) { return __hip_atomic_fetch_add(p, v, __ATOMIC_RELAXED, __HIP_MEMORY_SCOPE_AGENT); }
__device__ __forceinline__ unsigned xb_xcc_id() { return (unsigned)__builtin_amdgcn_s_getreg((3 << 11) | 20) & 0xFu; }
#define XB_SPIN(cond, bar) do { unsigned _sp = 0; while (cond) { __builtin_amdgcn_s_sleep(1); \
    if ((++_sp & 255u) == 0u) { if (xb_ld(&(bar)[XB_TMO])) break; if (_sp > XB_SPIN_CAP) { atomicAdd(&(bar)[XB_TMO], 1u); break; } } } } while (0)

struct XcdBarrier {
    unsigned* bar; unsigned x;
    volatile LAS unsigned* st;
};

__device__ __forceinline__ XcdBarrier xcd_barrier_post(unsigned* bar, volatile LAS unsigned* st) {
    XcdBarrier b; b.bar = bar; b.x = xb_xcc_id(); b.st = st;
    if (threadIdx.x == 0) (void)xb_add(&bar[XB_XCNT(b.x)], 1u);
    return b;
}
__device__ __forceinline__ void xcd_barrier_complete(unsigned* bar, unsigned x, unsigned& nloc, unsigned& nx) {
    const unsigned G = gridDim.x * gridDim.y * gridDim.z;
    unsigned sum, cnt, mine, sp = 0u;
    for (;;) {
        sum = 0u; cnt = 0u; mine = 0u;
#pragma unroll
        for (unsigned j = 0; j < 16; ++j) { const unsigned c = xb_ld(&bar[XB_XCNT(j)]); sum += c; cnt += (c > 0u) ? 1u : 0u; mine = (j == x) ? c : mine; }
        if (sum == G) break;
        __builtin_amdgcn_s_sleep(1);
        if ((++sp & 255u) == 0u) { if (xb_ld(&bar[XB_TMO])) break; if (sp > XB_SPIN_CAP) { atomicAdd(&bar[XB_TMO], 1u); break; } }
    }
    nloc = mine > 0u ? mine : 1u; nx = cnt > 0u ? cnt : 1u;
}

__device__ __forceinline__ void xcd_barrier(const XcdBarrier& b) {
    asm volatile("s_waitcnt vmcnt(0)" ::: "memory");
    __syncthreads();
    if (threadIdx.x == 0) {
        unsigned* bar = b.bar;
        __builtin_amdgcn_s_waitcnt(0);
        unsigned nloc = b.st[0], nx = b.st[1];
        if (nloc == 0u) { xcd_barrier_complete(bar, b.x, nloc, nx); b.st[0] = nloc; b.st[1] = nx; }
        const unsigned old = xb_add(&bar[XB_XSUB(b.x)], 1u);
        const unsigned gen = old / nloc;
        if (old + 1u == (gen + 1u) * nloc) {
            __builtin_amdgcn_fence(__ATOMIC_RELEASE, "agent");
            asm volatile("s_waitcnt vmcnt(0)" ::: "memory");
            const unsigned og = xb_add(&bar[XB_TOP], 1u);
            const unsigned tg = og / nx;
            if (og + 1u == (tg + 1u) * nx) xb_add(&bar[XB_TOPGEN], 1u);
            else XB_SPIN(xb_ld(&bar[XB_TOPGEN]) == tg, bar);
            __builtin_amdgcn_fence(__ATOMIC_ACQUIRE, "agent");
            xb_add(&bar[XB_XGEN(b.x)], 1u);
            asm volatile("s_waitcnt vmcnt(0)" ::: "memory");
        } else {
            XB_SPIN(xb_ld(&bar[XB_XGEN(b.x)]) == gen, bar);
            __builtin_amdgcn_fence(__ATOMIC_ACQUIRE, "agent");
            asm volatile("s_waitcnt vmcnt(0)" ::: "memory");
        }
    }
    __syncthreads();
}

constexpr int BAR_LDS_OFF = LDS_BYTES - 64;
constexpr int CTL_BAR = 4096;

#ifndef HGC_PROBE_PARTS
#define HGC_PROBE_PARTS 7
#endif
#ifndef PROBE_MASK
#define PROBE_MASK 0
#endif
#define PROBE_REP(bit) for (int rep_ = 0; rep_ < (((PROBE_MASK) & (bit)) ? 2 : 1); ++rep_)
struct Params { Inputs in; WS w; float* X; };
typedef const __attribute__((address_space(4))) Params CParams;
template <int MODE>
__device__ __forceinline__ void mv_probe(int* ctl, int lane) {
    v8i_ A, B;
#pragma unroll
    for (int w = 0; w < 8; ++w) { A[w] = 0x30303030 + (lane & 7) * 0x01010101; B[w] = 0x31313131 + (lane & 3) * 0x01010101; }
    v16f_ acc[4];
#pragma unroll
    for (int d = 0; d < 4; ++d)
#pragma unroll
        for (int r = 0; r < 16; ++r) acc[d][r] = 0.f;
    float x[8];
#pragma unroll
    for (int i = 0; i < 8; ++i) x[i] = -(float)(lane + i) * 0.01f;
    float s = 0.f;
#pragma unroll 1
    for (int it = 0; it < 2048; ++it) {
#pragma unroll
        for (int d = 0; d < 4; ++d) {
            if constexpr ((MODE & 1) != 0) { acc[d] = __builtin_amdgcn_mfma_scale_f32_32x32x64_f8f6f4(A, B, acc[d], 0, 0, 0, 0x7F7F7F7F, 0, 0x7F7F7F7F); __builtin_amdgcn_sched_barrier(0); }
            if constexpr ((MODE & 2) != 0) {
                asm volatile("" : "+v"(x[0]), "+v"(x[1]), "+v"(x[2]), "+v"(x[3]), "+v"(x[4]), "+v"(x[5]), "+v"(x[6]), "+v"(x[7]));
                float e[8];
#pragma unroll
                for (int i = 0; i < 8; ++i) { e[i] = __builtin_amdgcn_exp2f(x[i]); s += e[i]; }
                asm volatile("" : "+v"(e[0]), "+v"(e[1]), "+v"(e[2]), "+v"(e[3]), "+v"(e[4]), "+v"(e[5]), "+v"(e[6]), "+v"(e[7]), "+v"(s));
                __builtin_amdgcn_sched_barrier(0);
            }
        }
    }
    float t = s;
#pragma unroll
    for (int d = 0; d < 4; ++d)
#pragma unroll
        for (int r = 0; r < 16; ++r) t += acc[d][r];
    if (t == 12345.678f) ctl[CTL_POISON + 8] = 1;
}
#define KP() ({ CParams* kp_ = (CParams*)__builtin_amdgcn_kernarg_segment_ptr(); asm volatile("" : "+s"(kp_)); kp_; })

__global__ void __launch_bounds__(NTHREADS, 2) k_fwd(Params unused_by_name) {
#if defined(__HIP_DEVICE_COMPILE__)
    extern __shared__ __attribute__((aligned(16))) unsigned char lds_raw[];
    LAS unsigned char* lds = (LAS unsigned char*)lds_raw;
    const int tid = threadIdx.x;
    volatile LAS unsigned* bst = (volatile LAS unsigned*)(lds + BAR_LDS_OFF);
    if (tid == 0) { bst[0] = 0u; bst[1] = 0u; }
    __syncthreads();
    (void)xcd_barrier_post((unsigned*)(KP()->w.ctl + CTL_BAR), bst);
#define GRID_BAR() do { XcdBarrier b_; b_.bar = (unsigned*)(KP()->w.ctl + CTL_BAR); b_.x = xb_xcc_id(); b_.st = bst; xcd_barrier(b_); } while (0)
    if constexpr (((PROBE_MASK) & 2048) != 0) { mv_probe<((PROBE_MASK) >> 12) & 3>(KP()->w.ctl, tid & 63); }
    PROBE_REP(256) { CParams* kp = KP(); const Inputs in = kp->in; const WS w = kp->w; prologue_phase(in, w, kp->X, lds); }
    GRID_BAR();
#pragma unroll 1
    for (int layer = 0; layer < DEPTH; ++layer) {
        const int j = layer >> 1;
        if ((layer & 1) == 0) {
            {
                CParams* kp = KP();
                pg8::Gemm g{kp->w.Xb, kp->w.Wqkv_t + (size_t)j * 3072 * D, T, 2048, D}; pg8::StaticOrder S; S.init(T, 2048, gridDim.x, blockIdx.x);
                pg8::EpiQK8 E{(unsigned char*)kp->w.Qb, kp->w.rot};
                pg8::gemm_phase<pg8::EpiQK8, pg8::StaticOrder, true, true>(lds, g, S, E);
            }
            {
                CParams* kp = KP();
                pg8::Gemm g{kp->w.Wqkv_t + (size_t)j * 3072 * D + (size_t)2048 * D, kp->w.Xb, D, T, D}; pg8::StaticOrder S; S.init(D, T, gridDim.x, blockIdx.x);
                pg8::EpiVT E{(unsigned char*)kp->w.Vb};
                pg8::gemm_phase<pg8::EpiVT, pg8::StaticOrder, true, true>(lds, g, S, E);
            }
            GRID_BAR();
#ifdef ATT_PROBE_VAR
            {
                CParams* kp = KP();
                attn::attn_phase<ATT_PROBE_VAR>((const unsigned char*)kp->w.Qb, (const unsigned char*)kp->w.Qb + (size_t)T * 1024, (const unsigned char*)kp->w.Vb, (bf16*)kp->w.V32, kp->w.lbtab[2048 + j], kp->in.p[4] + (size_t)j * 128, 1.f, lds);
            }
            GRID_BAR();
#endif
            PROBE_REP(1) {
                CParams* kp = KP();
                attn::attn_phase((const unsigned char*)kp->w.Qb, (const unsigned char*)kp->w.Qb + (size_t)T * 1024, (const unsigned char*)kp->w.Vb, kp->w.Ob, kp->w.lbtab[2048 + j], kp->in.p[4] + (size_t)j * 128, 1.f - (0.8f - 0.6f * __expf(-0.3f * (float)layer)), lds);
            }
            GRID_BAR();
        } else {
            PROBE_REP(8) {
                CParams* kp = KP();
                pg8::Gemm g{kp->w.Xb, kp->w.Hin_t + (size_t)j * 4096 * D, T, 4096, D}; pg8::StaticOrder S; S.init(T, 4096, gridDim.x, blockIdx.x);
                pg8::EpiHin E{kp->w.Qb, (bf16*)kp->w.LG, kp->w.lbtab + j * 1024};
                pg8::gemm_phase<pg8::EpiHin, pg8::StaticOrder, true, true>(lds, g, S, E);
            }
            GRID_BAR();
            PROBE_REP(16) { CParams* kp = KP(); hgrn::passA(kp->w.Kb, (const bf16*)kp->w.LG, kp->w.Vb, kp->w.Uf, kp->w.Dbuf, lds); }
            GRID_BAR();
            PROBE_REP(16) { CParams* kp = KP(); hgrn::passB(kp->w.Uf, kp->w.Dbuf, kp->w.Sf); }
            GRID_BAR();
            if constexpr (((PROBE_MASK) & 4096) != 0) { CParams* kp = KP(); hgrn::passC<HGC_PROBE_PARTS>(kp->w.Qb, kp->w.Kb, (const bf16*)kp->w.LG, kp->w.Vb, kp->w.Gb, kp->w.Sf, kp->in.p[8] + (size_t)j * 128, (bf16*)kp->w.V32, lds); GRID_BAR(); }
            PROBE_REP(16) { CParams* kp = KP(); hgrn::passC(kp->w.Qb, kp->w.Kb, (const bf16*)kp->w.LG, kp->w.Vb, kp->w.Gb, kp->w.Sf, kp->in.p[8] + (size_t)j * 128, kp->w.Ob, lds); }
            GRID_BAR();
        }
        PROBE_REP(4) {
            CParams* kp = KP();
            const bf16* Wt = ((layer & 1) == 0) ? kp->w.Wo_t + (size_t)j * D * D : kp->w.Hout_t + (size_t)j * D * D;
            pg8::Gemm g{kp->w.Ob, Wt, T, D, D}; pg8::StaticOrder S; S.init(T, D, gridDim.x, blockIdx.x);
            pg8::EpiRes E{kp->w.Xb, (bf16*)kp->w.V32};
            pg8::gemm_phase<pg8::EpiRes, pg8::StaticOrder, true, true>(lds, g, S, E);
        }
        GRID_BAR();
        if constexpr (((PROBE_MASK) & 32) != 0) {
            CParams* kp = KP();
            lnroute_phase(kp->w.V32, kp->X, kp->w.Xb, kp->in.p[15] + (size_t)(layer * 2) * D, kp->in.p[16] + (size_t)(layer * 2) * D, (const bf16*)kp->w.Wr_t + (size_t)layer * 2 * NE * D,
                          kp->in.p[10] + (size_t)layer * NE, kp->w.ctl + CNT_BASE + (4 + layer) * 64 * CNT_STRIDE, (int*)kp->w.H1, (float*)((char*)kp->w.H1 + (16u << 20)), (int*)((char*)kp->w.H1 + (32u << 20)), lds);
            GRID_BAR();
        }
        {
            CParams* kp = KP();
            lnroute_phase(kp->w.V32, kp->X, kp->w.Xb, kp->in.p[15] + (size_t)(layer * 2) * D, kp->in.p[16] + (size_t)(layer * 2) * D, (const bf16*)kp->w.Wr_t + (size_t)layer * 2 * NE * D,
                          kp->in.p[10] + (size_t)layer * NE, kp->w.ctl + CNT_BASE + layer * 64 * CNT_STRIDE, kp->w.rowlist, kp->w.tok_w, kp->w.tok_es, lds);
        }
        GRID_BAR();
        const pg8::MoeTabs tb = moe_tables(KP()->w.ctl + CNT_BASE + layer * 64 * CNT_STRIDE, lds, tid);
        PROBE_REP(64) {
            CParams* kp = KP();
            pg8::Gemm g{kp->w.Xb, kp->w.Wgu_t + (size_t)layer * 65 * 512 * D, 0, 0, D};
            pg8::MoeOrder<2> S{tb, (int)gridDim.x, (int)blockIdx.x, kp->w.rowlist};
            pg8::EpiSwiglu E{kp->w.H1};
            pg8::gemm_phase_g<pg8::EpiSwiglu, pg8::MoeOrder<2>, true, true>(lds, g, S, E);
        }
        GRID_BAR();
        PROBE_REP(128) {
            CParams* kp = KP();
            int kdim = 256; asm volatile("" : "+s"(kdim));
            pg8::Gemm g{kp->w.H1, kp->w.Wd_t + (size_t)layer * 65 * D * 256, 0, 0, kdim};
            pg8::MoeOrder<4> S{tb, (int)gridDim.x, (int)blockIdx.x, kp->w.rowlist};
            pg8::EpiDown E{(unsigned char*)kp->w.Y};
            pg8::gemm_phase<pg8::EpiDown, pg8::MoeOrder<4>, true, true>(lds, g, S, E);
        }
        GRID_BAR();
        if ((PROBE_MASK) & 1024) { CParams* kp = KP(); combine_phase((const unsigned char*)kp->w.Y, kp->w.tok_es, kp->w.tok_w, tb, kp->w.Xb, kp->w.V32, kp->w.Qb, kp->in.p[15], kp->in.p[16], kp->w.ctl + CTL_POISON); GRID_BAR(); }
        { CParams* kp = KP(); combine_phase((const unsigned char*)kp->w.Y, kp->w.tok_es, kp->w.tok_w, tb, kp->w.Xb, (layer + 1 < DEPTH) ? (float*)nullptr : kp->X, kp->w.Xb, kp->in.p[15] + (size_t)(layer * 2 + 1) * D, kp->in.p[16] + (size_t)(layer * 2 + 1) * D, kp->w.ctl + CTL_POISON); }
        if (layer + 1 < DEPTH) GRID_BAR();
    }
#endif
}
}

extern "C" void kernel_launch(void* const* d_in, const int* in_sizes, int n_in, void* d_out, int out_size, void* d_ws, size_t ws_size, hipStream_t stream) {
    Inputs in{}; for (int i = 0; i < 17; ++i) in.p[i] = (const float*)d_in[i];
    float* X = (float*)d_out;
    char* ws = (char*)d_ws; size_t o = 0;
    auto carve = [&](size_t bytes) { char* p = ws + o; o += (bytes + 255) & ~(size_t)255; return p; };
    WS w{};
    w.ctl = (int*)carve(1 << 20);
    w.Wqkv_t = (bf16*)carve((size_t)2 * 3072 * D * 2); w.Wo_t = (bf16*)carve((size_t)2 * D * D * 2);
    w.Hin_t = (bf16*)carve((size_t)2 * 4096 * D * 2); w.Hout_t = (bf16*)carve((size_t)2 * D * D * 2);
    w.rot = (float*)carve((size_t)SEQ * 16 * 4); w.lbtab = (float*)carve(4 * 1024 * 4);
    w.V32 = (float*)carve((size_t)T * D * 4);
    w.Xb = (bf16*)carve((size_t)T * D * 2); w.Qb = (bf16*)carve((size_t)T * D * 2); w.Kb = (bf16*)carve((size_t)T * D * 2);
    w.Vb = (bf16*)carve((size_t)T * D * 2); w.Gb = (bf16*)carve((size_t)T * D * 2); w.Ob = (bf16*)carve((size_t)T * D * 2);
    w.LG = (float*)carve((size_t)T * D * 4); w.Dbuf = (float*)carve((size_t)4096 * 128 * 4);
    w.Wgu_t = (bf16*)carve((size_t)DEPTH * 65 * 512 * D * 2); w.Wd_t = (bf16*)carve((size_t)DEPTH * 65 * D * 256 * 2);
    w.Wr_t = (float*)carve((size_t)DEPTH * NE * D * 4);
    w.H1 = (bf16*)carve((size_t)NROWS * 256 * 2); w.Y = (bf16*)carve((size_t)NROWS * 1024 * 2);
    w.Uf = w.Y; w.Sf = w.Y + (size_t)4096 * 16384;
    w.rowlist = (int*)carve((size_t)(NE + 1) * T * 4); w.tok_w = (float*)carve((size_t)T * 8 * 4); w.tok_es = (int*)carve((size_t)T * 8 * 4);
    if (o > ws_size || n_in != 17) { fprintf(stderr, "kernel_launch: workspace too small (need %zu, have %zu) or n_in %d != 17; nothing launched\n", o, ws_size, n_in); return; }
    static int grid = 0;
    if (grid == 0) {
        int dev = 0, cus = 0;
        if (hipGetDevice(&dev) != hipSuccess || hipDeviceGetAttribute(&cus, hipDeviceAttributeMultiprocessorCount, dev) != hipSuccess) { grid = -1; return; }
        if (hipFuncSetAttribute((const void*)k_fwd, hipFuncAttributeMaxDynamicSharedMemorySize, LDS_BYTES) != hipSuccess) { fprintf(stderr, "kernel_launch: hipFuncSetAttribute failed\n"); grid = -1; return; }
        int per_cu = 0;
        if (hipOccupancyMaxActiveBlocksPerMultiprocessor(&per_cu, (const void*)k_fwd, NTHREADS, LDS_BYTES) != hipSuccess || per_cu < 1) { fprintf(stderr, "kernel_launch: occupancy query says %d blocks per CU\n", per_cu); }
        (void)hipGetLastError();
        grid = cus < 256 ? cus : 256;
    }
    if (grid < 0) return;
    (void)hipMemsetAsync(w.ctl, 0, 1 << 20, stream);
    Params prm{}; prm.in = in; prm.w = w; prm.X = X;
    hipLaunchKernelGGL(k_fwd, dim3(grid), dim3(NTHREADS), LDS_BYTES, stream, prm);
}
```

```cpp
#include <hip/hip_runtime.h>
#include <stdint.h>
#include <stdio.h>
#include <math.h>

namespace cfg {
constexpr int D = 1024, NB = 2, SEQ = 16384, T = NB * SEQ, DEPTH = 4;
constexpr int NE = 64, TOPK = 8, EFF = 256;
constexpr int NPAD = T * TOPK + NE * 256;
constexpr float ALPHA = 1.6817928305074290f;
constexpr float LN_EPS = 1e-5f;
constexpr float ROUTED_SCALE = 2.5f;
constexpr float C2 = 0.125f * 1.4426950408889634f;
}
using namespace cfg;

namespace pg8 {
#define PG8_LAS __attribute__((address_space(3)))
typedef unsigned short bf16_t;
typedef short bf16x8 __attribute__((ext_vector_type(8)));
typedef float f32x4 __attribute__((ext_vector_type(4)));
typedef unsigned u32x4 __attribute__((ext_vector_type(4)));
constexpr int BM = 256, BK = 64, HALF = 128, HTB = HALF * BK * 2  , STAGE_BYTES = 8 * HTB, NXCD = 8, WGM = 8;

__host__ __device__ __forceinline__ int lds_byte(int r, int c) { const int st = (r >> 4) * 2 + (c >> 5), rr = r & 15, cc = c & 31, ob = rr * 64 + cc * 2; return st * 1024 + (ob ^ (((ob >> 9) & 1) << 5)); }
__host__ __device__ __forceinline__ void stage_rc(int b, int& R, int& C) { const int st = b / 1024, sb = b % 1024, swz = sb ^ (((sb >> 9) & 1) << 5); R = (st >> 1) * 16 + swz / 64; C = (st & 1) * 32 + (swz % 64) / 2; }
__host__ __device__ __forceinline__ int perm32(int rho) { const int n = rho >> 4, i = rho & 15; return 8 * (i >> 2) + 4 * n + (i & 3); }

struct Unit { int pm, pn, aux, e; };
struct Gemm { const bf16_t* A; const bf16_t* Bt; int M, N, K; };

struct StaticOrder {
    int nM, nN, nwg, G, c;
    __host__ __device__ void init(int M, int N, int G_, int c_) { nM = M / BM; nN = N / BM; nwg = nM * nN; G = G_; c = c_; }
    __host__ __device__ bool next(int i, Unit& u) const {
        const long L = (long)i * G + c; if (L >= nwg) return false;
        int wgid = (int)L; { const int q = nwg / NXCD, r = nwg % NXCD, xcd = wgid % NXCD, off = wgid / NXCD; wgid = (xcd < r ? xcd * (q + 1) : r * (q + 1) + (xcd - r) * q) + off; }
        const int nig = WGM * nN, gid = wgid / nig, fm = gid * WGM, gsz = (nM - fm) < WGM ? (nM - fm) : WGM;
        u.pm = fm + ((wgid % nig) % gsz); u.pn = (wgid % nig) / gsz; return true;
    }
    __device__ __forceinline__ void a_ready(const Unit&) const {}
    __device__ __forceinline__ void done(const Unit&) const {}
};


__device__ __forceinline__ unsigned cvt_pk_bf16(float lo, float hi) { unsigned r; asm volatile("v_cvt_pk_bf16_f32 %0, %1, %2" : "=v"(r) : "v"(lo), "v"(hi)); return r; }
__device__ __forceinline__ float sigm(float x) { return __builtin_amdgcn_rcpf(1.f + __expf(-x)); }

struct EpiQKV {
    static constexpr bool PERM = true, AFTER_DRAIN = false;
    bf16_t* QKV; const float* rot;
    __device__ __forceinline__ void operator()(const f32x4 (&acc)[2][2][4][2], const Unit& u, int wr, int wc, int fr, int fq) const {
        const int sec = u.pn >> 2;
        bf16_t* base = QKV + (size_t)sec * ((size_t)cfg::T * 1024);
        const float sc = sec == 0 ? cfg::C2 : 1.f;
        const bool rotl = (sec < 2) && ((wc & 1) == 0) && (fq < 2);
        const int col0 = (u.pn & 3) * 256 + wc * 32 + 8 * fq;
#pragma unroll
        for (int ai = 0; ai < 2; ++ai)
#pragma unroll
            for (int m = 0; m < 4; ++m) {
                const int row = u.pm * BM + ai * HALF + wr * 64 + m * 16 + fr;
                f32x4 t0 = (f32x4){1.f, 0.f, 1.f, 0.f}, t1 = (f32x4){1.f, 0.f, 1.f, 0.f};
                if (rotl) { const f32x4* rp = (const f32x4*)(rot + ((size_t)(row & (cfg::SEQ - 1)) * 8 + 4 * fq) * 2); t0 = rp[0]; t1 = rp[1]; }
#pragma unroll
                for (int bj = 0; bj < 2; ++bj) {
                    const f32x4 v0 = acc[ai][bj][m][0], v1 = acc[ai][bj][m][1];
                    f32x4 r0, r1;
                    r0[0] = v0[0] * t0[0] - v0[1] * t0[1]; r0[1] = v0[1] * t0[0] + v0[0] * t0[1];
                    r0[2] = v0[2] * t0[2] - v0[3] * t0[3]; r0[3] = v0[3] * t0[2] + v0[2] * t0[3];
                    r1[0] = v1[0] * t1[0] - v1[1] * t1[1]; r1[1] = v1[1] * t1[0] + v1[0] * t1[1];
                    r1[2] = v1[2] * t1[2] - v1[3] * t1[3]; r1[3] = v1[3] * t1[2] + v1[2] * t1[3];
                    r0 = r0 * sc; r1 = r1 * sc;
                    u32x4 w; w.x = cvt_pk_bf16(r0[0], r0[1]); w.y = cvt_pk_bf16(r0[2], r0[3]); w.z = cvt_pk_bf16(r1[0], r1[1]); w.w = cvt_pk_bf16(r1[2], r1[3]);
                    *(u32x4*)(base + (size_t)row * 1024 + col0 + bj * HALF) = w;
                }
                asm volatile("" ::: "memory");
            }
    }
};
struct EpiQK8 {
    static constexpr bool PERM = true, AFTER_DRAIN = false;
    unsigned char* QK; const float* rot;
    __device__ __forceinline__ void operator()(const f32x4 (&acc)[2][2][4][2], const Unit& u, int wr, int wc, int fr, int fq) const {
        const int sec = u.pn >> 2;
        unsigned char* base = QK + (size_t)sec * ((size_t)cfg::T * 1024);
        const float sc = sec == 0 ? cfg::C2 * 4.f : 0.25f;
        const bool rotl = ((wc & 1) == 0) && (fq < 2);
        const int col0 = (u.pn & 3) * 256 + wc * 32 + 8 * fq;
        typedef unsigned u32x2_ __attribute__((ext_vector_type(2)));
#pragma unroll
        for (int ai = 0; ai < 2; ++ai)
#pragma unroll
            for (int m = 0; m < 4; ++m) {
                const int row = u.pm * BM + ai * HALF + wr * 64 + m * 16 + fr;
                f32x4 t0 = (f32x4){1.f, 0.f, 1.f, 0.f}, t1 = (f32x4){1.f, 0.f, 1.f, 0.f};
                if (rotl) { const f32x4* rp = (const f32x4*)(rot + ((size_t)(row & (cfg::SEQ - 1)) * 8 + 4 * fq) * 2); t0 = rp[0]; t1 = rp[1]; }
#pragma unroll
                for (int bj = 0; bj < 2; ++bj) {
                    const f32x4 v0 = acc[ai][bj][m][0], v1 = acc[ai][bj][m][1];
                    f32x4 r0, r1;
                    r0[0] = v0[0] * t0[0] - v0[1] * t0[1]; r0[1] = v0[1] * t0[0] + v0[0] * t0[1];
                    r0[2] = v0[2] * t0[2] - v0[3] * t0[3]; r0[3] = v0[3] * t0[2] + v0[2] * t0[3];
                    r1[0] = v1[0] * t1[0] - v1[1] * t1[1]; r1[1] = v1[1] * t1[0] + v1[0] * t1[1];
                    r1[2] = v1[2] * t1[2] - v1[3] * t1[3]; r1[3] = v1[3] * t1[2] + v1[2] * t1[3];
                    r0 = r0 * sc; r1 = r1 * sc;
#pragma unroll
                    for (int i = 0; i < 4; ++i) { r0[i] = __builtin_amdgcn_fmed3f(r0[i], -448.f, 448.f); r1[i] = __builtin_amdgcn_fmed3f(r1[i], -448.f, 448.f); }
                    int w0 = 0, w1 = 0;
                    w0 = __builtin_amdgcn_cvt_pk_fp8_f32(r0[0], r0[1], w0, false); w0 = __builtin_amdgcn_cvt_pk_fp8_f32(r0[2], r0[3], w0, true);
                    w1 = __builtin_amdgcn_cvt_pk_fp8_f32(r1[0], r1[1], w1, false); w1 = __builtin_amdgcn_cvt_pk_fp8_f32(r1[2], r1[3], w1, true);
                    *(u32x2_*)(base + (size_t)row * 1024 + col0 + bj * HALF) = (u32x2_){(unsigned)w0, (unsigned)w1};
                }
                asm volatile("" ::: "memory");
            }
    }
};
struct EpiVT {
    static constexpr bool PERM = true, AFTER_DRAIN = false;
    unsigned char* VT;
    __device__ __forceinline__ void operator()(const f32x4 (&acc)[2][2][4][2], const Unit& u, int wr, int wc, int fr, int fq) const {
#pragma unroll
        for (int ai = 0; ai < 2; ++ai)
#pragma unroll
            for (int m = 0; m < 4; ++m) {
                const int eg = u.pm * BM + ai * HALF + wr * 64 + m * 16 + fr, hh = eg >> 7, e = eg & 127, sw = (e >> 2) & 3;
#pragma unroll
                for (int bj = 0; bj < 2; ++bj) {
                    const int tok = u.pn * BM + bj * HALF + wc * 32 + 8 * fq, b = tok >> 14, sq = tok & (cfg::SEQ - 1), tile = sq >> 6, g = (sq & 63) >> 3;
                    unsigned char* blk = VT + ((size_t)((b * 8 + hh) * 256 + tile)) * 8192 + e * 64;
                    f32x4 v0 = acc[ai][bj][m][0] * 16.f, v1 = acc[ai][bj][m][1] * 16.f;
#pragma unroll
                    for (int i = 0; i < 4; ++i) { v0[i] = __builtin_amdgcn_fmed3f(v0[i], -448.f, 448.f); v1[i] = __builtin_amdgcn_fmed3f(v1[i], -448.f, 448.f); }
                    int w0 = 0, w1 = 0;
                    w0 = __builtin_amdgcn_cvt_pk_fp8_f32(v0[0], v0[1], w0, false); w0 = __builtin_amdgcn_cvt_pk_fp8_f32(v0[2], v0[3], w0, true);
                    w1 = __builtin_amdgcn_cvt_pk_fp8_f32(v1[0], v1[1], w1, false); w1 = __builtin_amdgcn_cvt_pk_fp8_f32(v1[2], v1[3], w1, true);
                    const int p0 = 4 * g, p1 = 32 + 4 * g;
                    *(unsigned*)(blk + (((p0 >> 4) ^ sw) << 4) + (p0 & 15)) = (unsigned)w0;
                    *(unsigned*)(blk + (((p1 >> 4) ^ sw) << 4) + (p1 & 15)) = (unsigned)w1;
                }
            }
    }
};
struct EpiRes {
    static constexpr bool PERM = true, AFTER_DRAIN = false;
    const bf16_t* X; bf16_t* Vout;
    __device__ __forceinline__ void operator()(const f32x4 (&acc)[2][2][4][2], const Unit& u, int wr, int wc, int fr, int fq) const {
        const int col0 = u.pn * BM + wc * 32 + 8 * fq;
#pragma unroll
        for (int ai = 0; ai < 2; ++ai)
#pragma unroll
            for (int m = 0; m < 4; ++m) {
                const size_t ro = (size_t)(u.pm * BM + ai * HALF + wr * 64 + m * 16 + fr) * 1024 + col0;
#pragma unroll
                for (int bj = 0; bj < 2; ++bj) { const size_t off = ro + bj * HALF; const u32x4 xb = *(const u32x4*)(X + off);
                    const f32x4 x0 = (f32x4){__builtin_bit_cast(float, xb[0] << 16), __builtin_bit_cast(float, xb[0] & 0xffff0000u), __builtin_bit_cast(float, xb[1] << 16), __builtin_bit_cast(float, xb[1] & 0xffff0000u)};
                    const f32x4 x1 = (f32x4){__builtin_bit_cast(float, xb[2] << 16), __builtin_bit_cast(float, xb[2] & 0xffff0000u), __builtin_bit_cast(float, xb[3] << 16), __builtin_bit_cast(float, xb[3] & 0xffff0000u)};
                    const f32x4 v0 = x0 * cfg::ALPHA + acc[ai][bj][m][0], v1 = x1 * cfg::ALPHA + acc[ai][bj][m][1];
                    u32x4 w; w.x = cvt_pk_bf16(v0[0], v0[1]); w.y = cvt_pk_bf16(v0[2], v0[3]); w.z = cvt_pk_bf16(v1[0], v1[1]); w.w = cvt_pk_bf16(v1[2], v1[3]);
                    *(u32x4*)(Vout + off) = w; }
            }
    }
};
struct EpiHin {
    static constexpr bool PERM = true, AFTER_DRAIN = false;
    bf16_t* QKVG; bf16_t* LG; const float* lbtab;
    __device__ __forceinline__ void operator()(const f32x4 (&acc)[2][2][4][2], const Unit& u, int wr, int wc, int fr, int fq) const {
        const int sec = u.pn >> 2;
        const int col0 = (u.pn & 3) * 256 + wc * 32 + 8 * fq;
        bf16_t* base = QKVG + (size_t)sec * ((size_t)cfg::T * 1024);
#pragma unroll
        for (int ai = 0; ai < 2; ++ai)
#pragma unroll
            for (int m = 0; m < 4; ++m) {
                const size_t ro = (size_t)(u.pm * BM + ai * HALF + wr * 64 + m * 16 + fr) * 1024 + col0;
#pragma unroll
                for (int bj = 0; bj < 2; ++bj) {
                    f32x4 v0 = acc[ai][bj][m][0], v1 = acc[ai][bj][m][1];
                    if (sec == 0 || sec == 3) {
#pragma unroll
                        for (int i = 0; i < 4; ++i) { v0[i] = v0[i] * sigm(v0[i]); v1[i] = v1[i] * sigm(v1[i]); }
                    } else if (sec == 1) {
                        const f32x4 l0 = *(const f32x4*)(lbtab + col0 + bj * HALF), l1 = *(const f32x4*)(lbtab + col0 + bj * HALF + 4);
                        f32x4 g0, g1;
#pragma unroll
                        for (int i = 0; i < 4; ++i) {
                            const float s0 = sigm(v0[i]), os0 = 1.f - s0, s1 = sigm(v1[i]), os1 = 1.f - s1;
                            g0[i] = __logf(l0[i] + (1.f - l0[i]) * s0); v0[i] = (1.f - l0[i]) * os0;
                            g1[i] = __logf(l1[i] + (1.f - l1[i]) * s1); v1[i] = (1.f - l1[i]) * os1;
                        }
                        { u32x4 lw; lw.x = cvt_pk_bf16(g0[0], g0[1]); lw.y = cvt_pk_bf16(g0[2], g0[3]); lw.z = cvt_pk_bf16(g1[0], g1[1]); lw.w = cvt_pk_bf16(g1[2], g1[3]); *(u32x4*)(LG + ro + bj * HALF) = lw; }
                    }
                    u32x4 w; w.x = cvt_pk_bf16(v0[0], v0[1]); w.y = cvt_pk_bf16(v0[2], v0[3]); w.z = cvt_pk_bf16(v1[0], v1[1]); w.w = cvt_pk_bf16(v1[2], v1[3]);
                    *(u32x4*)(base + ro + bj * HALF) = w;
                }
            }
    }
};

struct MoeTabs { const PG8_LAS int* toff; const PG8_LAS int* cntv; const PG8_LAS unsigned char* tile_e; const PG8_LAS unsigned short* xl; int nxl; };
template <int NN> struct MoeOrder {
    MoeTabs tb; int G, c; const int* rowlist;
    __device__ __forceinline__ bool next(int i, Unit& u) const {
        const int L = i * (G >> 3) + (c >> 3); if (L >= tb.nxl * NN) return false;
        const int ti = L / NN, n = L - ti * NN, tile = __builtin_amdgcn_readfirstlane((int)tb.xl[ti]), e = __builtin_amdgcn_readfirstlane((int)tb.tile_e[tile]);
        u.pm = tile; u.pn = e * NN + n; u.aux = n; u.e = e; return true;
    }
    __device__ __forceinline__ int row_of(const Unit& u, int r) const {
        const int slot = (u.pm - __builtin_amdgcn_readfirstlane(tb.toff[u.e])) * 256 + r, last = __builtin_amdgcn_readfirstlane(tb.cntv[u.e]) - 1;
        return rowlist[(size_t)u.e * cfg::T + (slot < last ? slot : last)];
    }
    __device__ __forceinline__ void a_ready(const Unit&) const {}
    __device__ __forceinline__ void done(const Unit&) const {}
};
struct EpiSwiglu {
    static constexpr bool PERM = true, AFTER_DRAIN = false;
    bf16_t* H1;
    __device__ __forceinline__ void operator()(const f32x4 (&acc)[2][2][4][2], const Unit& u, int wr, int wc, int fr, int fq) const {
        const int col0 = u.aux * 128 + wc * 32 + 8 * fq;
#pragma unroll
        for (int ai = 0; ai < 2; ++ai)
#pragma unroll
            for (int m = 0; m < 4; ++m) {
                const size_t row = (size_t)u.pm * BM + ai * HALF + wr * 64 + m * 16 + fr;
                const f32x4 g0 = acc[ai][0][m][0], g1 = acc[ai][0][m][1], u0 = acc[ai][1][m][0], u1 = acc[ai][1][m][1];
                f32x4 h0, h1;
#pragma unroll
                for (int i = 0; i < 4; ++i) { h0[i] = g0[i] * sigm(g0[i]) * u0[i]; h1[i] = g1[i] * sigm(g1[i]) * u1[i]; }
                u32x4 w; w.x = cvt_pk_bf16(h0[0], h0[1]); w.y = cvt_pk_bf16(h0[2], h0[3]); w.z = cvt_pk_bf16(h1[0], h1[1]); w.w = cvt_pk_bf16(h1[2], h1[3]);
                *(u32x4*)(H1 + row * 256 + col0) = w;
            }
    }
};
struct EpiDown {
    static constexpr bool PERM = true, AFTER_DRAIN = false, PERM16 = true;
    unsigned char* Y;
    __device__ __forceinline__ void operator()(const f32x4 (&acc)[2][2][4][2], const Unit& u, int wr, int wc, int fr, int fq) const {
        const int col0 = u.aux * 256 + wc * 64 + 16 * fq;
#pragma unroll
        for (int ai = 0; ai < 2; ++ai)
#pragma unroll
            for (int m = 0; m < 4; ++m) {
                unsigned char* rowp = Y + ((size_t)u.pm * BM + ai * HALF + wr * 64 + m * 16 + fr) * 1024 + col0;
                u32x4 w;
#pragma unroll
                for (int bj = 0; bj < 2; ++bj) {
                    f32x4 v0 = acc[ai][bj][m][0] * 64.f, v1 = acc[ai][bj][m][1] * 64.f;
#pragma unroll
                    for (int i = 0; i < 4; ++i) { v0[i] = __builtin_amdgcn_fmed3f(v0[i], -448.f, 448.f); v1[i] = __builtin_amdgcn_fmed3f(v1[i], -448.f, 448.f); }
                    int w0 = 0, w1 = 0;
                    w0 = __builtin_amdgcn_cvt_pk_fp8_f32(v0[0], v0[1], w0, false); w0 = __builtin_amdgcn_cvt_pk_fp8_f32(v0[2], v0[3], w0, true);
                    w1 = __builtin_amdgcn_cvt_pk_fp8_f32(v1[0], v1[1], w1, false); w1 = __builtin_amdgcn_cvt_pk_fp8_f32(v1[2], v1[3], w1, true);
                    w[2 * bj] = (unsigned)w0; w[2 * bj + 1] = (unsigned)w1;
                }
                *(u32x4*)rowp = w;
            }
    }
};
template <class E, class = void> struct Perm16 { static constexpr bool v = false; };
template <class E> struct Perm16<E, decltype((void)E::PERM16)> { static constexpr bool v = E::PERM16; };
template <class Epi, class Sched, bool ALIGN_EPI = false, bool SP2 = false>
__device__ __forceinline__ void gemm_phase(PG8_LAS unsigned char* lds, const Gemm g, const Sched& S, const Epi& E) {
    int tid_l = threadIdx.x; asm volatile("" : "+v"(tid_l));
    const int tid = tid_l, wid = __builtin_amdgcn_readfirstlane(tid >> 6), lane = tid & 63, wr = wid >> 2, wc = wid & 3, fr = lane & 15, fq = lane >> 4;
    const int K = g.K, nt = K / BK;
    unsigned voffA[2], voffB[2];
#pragma unroll
    for (int i = 0; i < 2; ++i) { int R, C; stage_rc(tid * 16 + i * 8192, R, C); const int Rb = Perm16<Epi>::v ? ((R >> 5) * 64 + ((R & 15) >> 2) * 16 + ((R >> 4) & 1) * 4 + (R & 3)) : Epi::PERM ? ((R & ~31) + perm32(R & 31)) : R;
        voffA[i] = (unsigned)(R * K + C) * 2u; voffB[i] = (unsigned)(Rb * K + C) * 2u; }
    const size_t kstep = (size_t)(BK * 2);
    const size_t hstep = (size_t)HALF * K * 2;
    const size_t tstep = 2 * hstep;
    const size_t hstepB = Perm16<Epi>::v ? (size_t)8 * K * 2 : hstep;
    const unsigned ldsw = (unsigned)wid * 1024u;
    const int aoff = lds_byte(wr * 64 + fr, fq * 8), boff = lds_byte(wc * 32 + fr, fq * 8);
#define PG8_SA(b, h) (((b) * 2 + (h)) * HTB)
#define PG8_SB(b, h) ((4 + (b) * 2 + (h)) * HTB)
#define PG8_STAGE(bufoff, gbase, voff) do { _Pragma("unroll") for (int _i = 0; _i < 2; ++_i) \
        __builtin_amdgcn_global_load_lds((const unsigned*)((const char*)(gbase) + (voff)[_i]), (PG8_LAS unsigned*)(lds + (bufoff) + ldsw + _i * 8192), 16, 0, 0); } while (0)
#define PG8_LDA(dst, b, h) do { _Pragma("unroll") for (int m = 0; m < 4; ++m) _Pragma("unroll") for (int k = 0; k < 2; ++k) dst[m][k] = *(const PG8_LAS bf16x8*)(lds + PG8_SA(b, h) + aoff + m * 2048 + k * 1024); } while (0)
#define PG8_LDB(dst, b, h) do { _Pragma("unroll") for (int n = 0; n < 2; ++n) _Pragma("unroll") for (int k = 0; k < 2; ++k) dst[n][k] = *(const PG8_LAS bf16x8*)(lds + PG8_SB(b, h) + boff + n * 2048 + k * 1024); } while (0)
#define PG8_MMA(ai, bj, At, Bt) do { __builtin_amdgcn_s_setprio(1); _Pragma("unroll") for (int m = 0; m < 4; ++m) _Pragma("unroll") for (int n = 0; n < 2; ++n) _Pragma("unroll") for (int k = 0; k < 2; ++k) \
        acc[ai][bj][m][n] = __builtin_amdgcn_mfma_f32_16x16x32_bf16(Bt[n][k], At[m][k], acc[ai][bj][m][n], 0, 0, 0); __builtin_amdgcn_s_setprio(0); } while (0)
#define PG8_WAIT_V(n) asm volatile("s_waitcnt vmcnt(" #n ")" ::: "memory")
#define PG8_WAIT_L(n) asm volatile("s_waitcnt lgkmcnt(" #n ")" ::: "memory")
#define PG8_BAR __builtin_amdgcn_s_barrier()
#define PG8_SCHED __builtin_amdgcn_sched_barrier(0)
    Unit cur, nxt; int ui = 0;
    if (!S.next(0, cur)) return;
    f32x4 acc[2][2][4][2];
#pragma unroll
    for (int a = 0; a < 2; ++a)
#pragma unroll
        for (int b = 0; b < 2; ++b)
#pragma unroll
            for (int m = 0; m < 4; ++m)
#pragma unroll
                for (int n = 0; n < 2; ++n) acc[a][b][m][n] = (f32x4){0.f, 0.f, 0.f, 0.f};
    bf16x8 At[4][2], B0[2][2], B1[2][2];
    const char* cA = (const char*)g.A + (size_t)cur.pm * tstep; const char* cB = (const char*)g.Bt + (size_t)cur.pn * tstep;
    S.a_ready(cur);
    if constexpr (SP2) {
        PG8_STAGE(PG8_SB(0, 0), cB, voffB); PG8_STAGE(PG8_SB(0, 1), cB + hstepB, voffB); PG8_STAGE(PG8_SA(0, 0), cA, voffA); PG8_STAGE(PG8_SA(0, 1), cA + hstep, voffA);
        if (wr == 1) PG8_BAR;
        PG8_WAIT_V(2); PG8_BAR;
        PG8_STAGE(PG8_SB(1, 0), cB + kstep, voffB); PG8_STAGE(PG8_SA(1, 0), cA + kstep, voffA); PG8_STAGE(PG8_SB(1, 1), cB + hstepB + kstep, voffB);
        PG8_WAIT_V(6); PG8_BAR;
    } else {
        PG8_STAGE(PG8_SB(0, 0), cB, voffB); PG8_STAGE(PG8_SA(0, 0), cA, voffA); PG8_STAGE(PG8_SB(0, 1), cB + hstepB, voffB); PG8_STAGE(PG8_SA(0, 1), cA + hstep, voffA);
        if (wr == 1) PG8_BAR;
        PG8_WAIT_V(4); PG8_BAR;
        PG8_STAGE(PG8_SB(1, 0), cB + kstep, voffB); PG8_STAGE(PG8_SA(1, 0), cA + kstep, voffA); PG8_STAGE(PG8_SB(1, 1), cB + hstepB + kstep, voffB);
        PG8_WAIT_V(6); PG8_BAR;
    }
    for (;;) {
        const bool has_next = S.next(ui + 1, nxt);
        const char* nA = has_next ? (const char*)g.A + (size_t)nxt.pm * tstep : cA; const char* nB = has_next ? (const char*)g.Bt + (size_t)nxt.pn * tstep : cB;
        for (int t = 0; t < nt; t += 2) {
            const bool last = (t == nt - 2);
            const char* a1 = cA + (size_t)(t + 1) * kstep;
            const char* a2 = last ? nA : cA + (size_t)(t + 2) * kstep; const char* b2 = last ? nB : cB + (size_t)(t + 2) * kstep;
            const char* a3 = a2 + kstep; const char* b3 = b2 + kstep;
            if (last && has_next) S.a_ready(nxt);
            if constexpr (SP2) {
            PG8_LDB(B0, 0, 0); PG8_LDB(B1, 0, 1); PG8_SCHED; PG8_LDA(At, 0, 0); PG8_STAGE(PG8_SA(1, 1), a1 + hstep, voffA);
            PG8_WAIT_V(8); PG8_WAIT_L(0); PG8_BAR; PG8_MMA(0, 0, At, B0); PG8_MMA(0, 1, At, B1); PG8_BAR; PG8_SCHED;
            PG8_LDA(At, 0, 1); PG8_STAGE(PG8_SB(0, 0), b2, voffB); PG8_STAGE(PG8_SB(0, 1), b2 + hstepB, voffB); PG8_STAGE(PG8_SA(0, 0), a2, voffA);
            PG8_WAIT_V(8); PG8_WAIT_L(0); PG8_BAR; PG8_MMA(1, 0, At, B0); PG8_MMA(1, 1, At, B1); PG8_BAR; PG8_SCHED;
            PG8_LDB(B0, 1, 0); PG8_LDB(B1, 1, 1); PG8_SCHED; PG8_LDA(At, 1, 0); PG8_STAGE(PG8_SA(0, 1), a2 + hstep, voffA);
            PG8_WAIT_V(8); PG8_WAIT_L(0); PG8_BAR; PG8_MMA(0, 0, At, B0); PG8_MMA(0, 1, At, B1); PG8_BAR; PG8_SCHED;
            PG8_LDA(At, 1, 1); PG8_STAGE(PG8_SB(1, 0), b3, voffB); PG8_STAGE(PG8_SB(1, 1), b3 + hstepB, voffB); PG8_STAGE(PG8_SA(1, 0), a3, voffA);
            PG8_WAIT_V(8); PG8_WAIT_L(0); PG8_BAR; PG8_MMA(1, 0, At, B0); PG8_MMA(1, 1, At, B1); PG8_BAR; PG8_SCHED;
            } else {
            PG8_LDB(B0, 0, 0); PG8_SCHED; PG8_LDA(At, 0, 0); PG8_STAGE(PG8_SA(1, 1), a1 + hstep, voffA);
            PG8_WAIT_L(8); PG8_BAR; PG8_WAIT_L(0); PG8_MMA(0, 0, At, B0); PG8_BAR; PG8_SCHED;
            PG8_LDB(B1, 0, 1); PG8_STAGE(PG8_SB(0, 0), b2, voffB);
            PG8_BAR; PG8_WAIT_L(0); PG8_MMA(0, 1, At, B1); PG8_BAR;
            PG8_LDA(At, 0, 1); PG8_STAGE(PG8_SA(0, 0), a2, voffA);
            PG8_BAR; PG8_WAIT_L(0); PG8_MMA(1, 0, At, B0); PG8_BAR; PG8_SCHED;
            PG8_STAGE(PG8_SB(0, 1), b2 + hstepB, voffB);
            PG8_WAIT_V(6); PG8_BAR; PG8_MMA(1, 1, At, B1); PG8_BAR;
            PG8_LDB(B0, 1, 0); PG8_SCHED; PG8_LDA(At, 1, 0); PG8_STAGE(PG8_SA(0, 1), a2 + hstep, voffA);
            PG8_WAIT_L(8); PG8_BAR; PG8_WAIT_L(0); PG8_MMA(0, 0, At, B0); PG8_BAR; PG8_SCHED;
            PG8_LDB(B1, 1, 1); PG8_STAGE(PG8_SB(1, 0), b3, voffB);
            PG8_BAR; PG8_WAIT_L(0); PG8_MMA(0, 1, At, B1); PG8_BAR;
            PG8_LDA(At, 1, 1); PG8_STAGE(PG8_SA(1, 0), a3, voffA);
            PG8_BAR; PG8_WAIT_L(0); PG8_MMA(1, 0, At, B0); PG8_BAR; PG8_SCHED;
            PG8_STAGE(PG8_SB(1, 1), b3 + hstepB, voffB);
            PG8_WAIT_V(6); PG8_BAR; PG8_MMA(1, 1, At, B1); PG8_BAR;
            }
        }
        if constexpr (ALIGN_EPI) { if (wr == 0) PG8_BAR; }
        if constexpr (!Epi::AFTER_DRAIN) { E(acc, cur, wr, wc, fr, fq); S.done(cur); }
        if (!has_next) break;
#pragma unroll
        for (int a = 0; a < 2; ++a)
#pragma unroll
            for (int b = 0; b < 2; ++b)
#pragma unroll
                for (int m = 0; m < 4; ++m)
#pragma unroll
                    for (int n = 0; n < 2; ++n) acc[a][b][m][n] = (f32x4){0.f, 0.f, 0.f, 0.f};
        cur = nxt; cA = nA; cB = nB; ++ui;
        if constexpr (ALIGN_EPI) { if (wr == 1) PG8_BAR; }
    }
    PG8_WAIT_V(0);
    if constexpr (!ALIGN_EPI) { if (wr == 0) PG8_BAR; }
    PG8_BAR;
    if constexpr (Epi::AFTER_DRAIN) { E.fused(acc, cur, wr, wc, fr, fq, lds, wid, lane); S.done(cur); }
#undef PG8_SA
#undef PG8_SB
#undef PG8_STAGE
#undef PG8_LDA
#undef PG8_LDB
#undef PG8_MMA
#undef PG8_WAIT_V
#undef PG8_WAIT_L
#undef PG8_BAR
#undef PG8_SCHED
}


#define PG8_GOFF(dst, unit) do { _Pragma("unroll") for (int _h = 0; _h < 2; ++_h) _Pragma("unroll") for (int _i = 0; _i < 2; ++_i) { int R_, C_; stage_rc(tid * 16 + _i * 8192, R_, C_); \
        dst[_h][_i] = (unsigned)(S.row_of(unit, _h * HALF + R_) * K + C_) * 2u; } } while (0)
template <class Epi, class Sched, bool ALIGN_EPI = false, bool SP2 = false>
__device__ __forceinline__ void gemm_phase_g(PG8_LAS unsigned char* lds, const Gemm g, const Sched& S, const Epi& E) {
    int tid_l = threadIdx.x; asm volatile("" : "+v"(tid_l));
    const int tid = tid_l, wid = __builtin_amdgcn_readfirstlane(tid >> 6), lane = tid & 63, wr = wid >> 2, wc = wid & 3, fr = lane & 15, fq = lane >> 4;
    const int K = g.K, nt = K / BK;
    unsigned voffA[2], voffB[2];
#pragma unroll
    for (int i = 0; i < 2; ++i) { int R, C; stage_rc(tid * 16 + i * 8192, R, C); const int Rb = Epi::PERM ? ((R & ~31) + perm32(R & 31)) : R;
        voffA[i] = (unsigned)(R * K + C) * 2u; voffB[i] = (unsigned)(Rb * K + C) * 2u; }
    const size_t kstep = (size_t)(BK * 2);
    const size_t hstep = (size_t)HALF * K * 2;
    const size_t tstep = 2 * hstep;
    const unsigned ldsw = (unsigned)wid * 1024u;
    const int aoff = lds_byte(wr * 64 + fr, fq * 8), boff = lds_byte(wc * 32 + fr, fq * 8);
#define PG8_SA(b, h) (((b) * 2 + (h)) * HTB)
#define PG8_SB(b, h) ((4 + (b) * 2 + (h)) * HTB)
#define PG8_STAGE(bufoff, gbase, voff) do { _Pragma("unroll") for (int _i = 0; _i < 2; ++_i) \
        __builtin_amdgcn_global_load_lds((const unsigned*)((const char*)(gbase) + (voff)[_i]), (PG8_LAS unsigned*)(lds + (bufoff) + ldsw + _i * 8192), 16, 0, 0); } while (0)
#define PG8_LDA(dst, b, h) do { _Pragma("unroll") for (int m = 0; m < 4; ++m) _Pragma("unroll") for (int k = 0; k < 2; ++k) dst[m][k] = *(const PG8_LAS bf16x8*)(lds + PG8_SA(b, h) + aoff + m * 2048 + k * 1024); } while (0)
#define PG8_LDB(dst, b, h) do { _Pragma("unroll") for (int n = 0; n < 2; ++n) _Pragma("unroll") for (int k = 0; k < 2; ++k) dst[n][k] = *(const PG8_LAS bf16x8*)(lds + PG8_SB(b, h) + boff + n * 2048 + k * 1024); } while (0)
#define PG8_MMA(ai, bj, At, Bt) do { __builtin_amdgcn_s_setprio(1); _Pragma("unroll") for (int m = 0; m < 4; ++m) _Pragma("unroll") for (int n = 0; n < 2; ++n) _Pragma("unroll") for (int k = 0; k < 2; ++k) \
        acc[ai][bj][m][n] = __builtin_amdgcn_mfma_f32_16x16x32_bf16(Bt[n][k], At[m][k], acc[ai][bj][m][n], 0, 0, 0); __builtin_amdgcn_s_setprio(0); } while (0)
#define PG8_WAIT_V(n) asm volatile("s_waitcnt vmcnt(" #n ")" ::: "memory")
#define PG8_WAIT_L(n) asm volatile("s_waitcnt lgkmcnt(" #n ")" ::: "memory")
#define PG8_BAR __builtin_amdgcn_s_barrier()
#define PG8_SCHED __builtin_amdgcn_sched_barrier(0)
    Unit cur, nxt; int ui = 0;
    if (!S.next(0, cur)) return;
    f32x4 acc[2][2][4][2];
#pragma unroll
    for (int a = 0; a < 2; ++a)
#pragma unroll
        for (int b = 0; b < 2; ++b)
#pragma unroll
            for (int m = 0; m < 4; ++m)
#pragma unroll
                for (int n = 0; n < 2; ++n) acc[a][b][m][n] = (f32x4){0.f, 0.f, 0.f, 0.f};
    bf16x8 At[4][2], B0[2][2], B1[2][2];
    const char* cA = (const char*)g.A; unsigned vC[2][2], vN[2][2], vS[2][2]; PG8_GOFF(vC, cur); const char* cB = (const char*)g.Bt + (size_t)cur.pn * tstep;
    S.a_ready(cur);
    if constexpr (SP2) {
        PG8_STAGE(PG8_SB(0, 0), cB, voffB); PG8_STAGE(PG8_SB(0, 1), cB + hstep, voffB); PG8_STAGE(PG8_SA(0, 0), cA, vC[0]); PG8_STAGE(PG8_SA(0, 1), cA, vC[1]);
        if (wr == 1) PG8_BAR;
        PG8_WAIT_V(2); PG8_BAR;
        PG8_STAGE(PG8_SB(1, 0), cB + kstep, voffB); PG8_STAGE(PG8_SA(1, 0), cA + kstep, vC[0]); PG8_STAGE(PG8_SB(1, 1), cB + hstep + kstep, voffB);
        PG8_WAIT_V(6); PG8_BAR;
    } else {
        PG8_STAGE(PG8_SB(0, 0), cB, voffB); PG8_STAGE(PG8_SA(0, 0), cA, vC[0]); PG8_STAGE(PG8_SB(0, 1), cB + hstep, voffB); PG8_STAGE(PG8_SA(0, 1), cA, vC[1]);
        if (wr == 1) PG8_BAR;
        PG8_WAIT_V(4); PG8_BAR;
        PG8_STAGE(PG8_SB(1, 0), cB + kstep, voffB); PG8_STAGE(PG8_SA(1, 0), cA + kstep, vC[0]); PG8_STAGE(PG8_SB(1, 1), cB + hstep + kstep, voffB);
        PG8_WAIT_V(6); PG8_BAR;
    }
    for (;;) {
        const bool has_next = S.next(ui + 1, nxt);
        const char* nA = (const char*)g.A; if (has_next) { PG8_GOFF(vN, nxt); } else { _Pragma("unroll") for (int _h = 0; _h < 2; ++_h) _Pragma("unroll") for (int _i = 0; _i < 2; ++_i) vN[_h][_i] = vC[_h][_i]; } const char* nB = has_next ? (const char*)g.Bt + (size_t)nxt.pn * tstep : cB;
        for (int t = 0; t < nt; t += 2) {
            const bool last = (t == nt - 2); _Pragma("unroll") for (int _h = 0; _h < 2; ++_h) _Pragma("unroll") for (int _i = 0; _i < 2; ++_i) vS[_h][_i] = last ? vN[_h][_i] : vC[_h][_i];
            const char* a1 = cA + (size_t)(t + 1) * kstep;
            const char* a2 = last ? nA : cA + (size_t)(t + 2) * kstep; const char* b2 = last ? nB : cB + (size_t)(t + 2) * kstep;
            const char* a3 = a2 + kstep; const char* b3 = b2 + kstep;
            if (last && has_next) S.a_ready(nxt);
            if constexpr (SP2) {
            PG8_LDB(B0, 0, 0); PG8_LDB(B1, 0, 1); PG8_SCHED; PG8_LDA(At, 0, 0); PG8_STAGE(PG8_SA(1, 1), a1, vC[1]);
            PG8_WAIT_V(8); PG8_WAIT_L(0); PG8_BAR; PG8_MMA(0, 0, At, B0); PG8_MMA(0, 1, At, B1); PG8_BAR; PG8_SCHED;
            PG8_LDA(At, 0, 1); PG8_STAGE(PG8_SB(0, 0), b2, voffB); PG8_STAGE(PG8_SB(0, 1), b2 + hstep, voffB); PG8_STAGE(PG8_SA(0, 0), a2, vS[0]);
            PG8_WAIT_V(8); PG8_WAIT_L(0); PG8_BAR; PG8_MMA(1, 0, At, B0); PG8_MMA(1, 1, At, B1); PG8_BAR; PG8_SCHED;
            PG8_LDB(B0, 1, 0); PG8_LDB(B1, 1, 1); PG8_SCHED; PG8_LDA(At, 1, 0); PG8_STAGE(PG8_SA(0, 1), a2, vS[1]);
            PG8_WAIT_V(8); PG8_WAIT_L(0); PG8_BAR; PG8_MMA(0, 0, At, B0); PG8_MMA(0, 1, At, B1); PG8_BAR; PG8_SCHED;
            PG8_LDA(At, 1, 1); PG8_STAGE(PG8_SB(1, 0), b3, voffB); PG8_STAGE(PG8_SB(1, 1), b3 + hstep, voffB); PG8_STAGE(PG8_SA(1, 0), a3, vS[0]);
            PG8_WAIT_V(8); PG8_WAIT_L(0); PG8_BAR; PG8_MMA(1, 0, At, B0); PG8_MMA(1, 1, At, B1); PG8_BAR; PG8_SCHED;
            } else {
            PG8_LDB(B0, 0, 0); PG8_SCHED; PG8_LDA(At, 0, 0); PG8_STAGE(PG8_SA(1, 1), a1, vC[1]);
            PG8_WAIT_L(8); PG8_BAR; PG8_WAIT_L(0); PG8_MMA(0, 0, At, B0); PG8_BAR; PG8_SCHED;
            PG8_LDB(B1, 0, 1); PG8_STAGE(PG8_SB(0, 0), b2, voffB);
            PG8_BAR; PG8_WAIT_L(0); PG8_MMA(0, 1, At, B1); PG8_BAR;
            PG8_LDA(At, 0, 1); PG8_STAGE(PG8_SA(0, 0), a2, vS[0]);
            PG8_BAR; PG8_WAIT_L(0); PG8_MMA(1, 0, At, B0); PG8_BAR; PG8_SCHED;
            PG8_STAGE(PG8_SB(0, 1), b2 + hstep, voffB);
            PG8_WAIT_V(6); PG8_BAR; PG8_MMA(1, 1, At, B1); PG8_BAR;
            PG8_LDB(B0, 1, 0); PG8_SCHED; PG8_LDA(At, 1, 0); PG8_STAGE(PG8_SA(0, 1), a2, vS[1]);
            PG8_WAIT_L(8); PG8_BAR; PG8_WAIT_L(0); PG8_MMA(0, 0, At, B0); PG8_BAR; PG8_SCHED;
            PG8_LDB(B1, 1, 1); PG8_STAGE(PG8_SB(1, 0), b3, voffB);
            PG8_BAR; PG8_WAIT_L(0); PG8_MMA(0, 1, At, B1); PG8_BAR;
            PG8_LDA(At, 1, 1); PG8_STAGE(PG8_SA(1, 0), a3, vS[0]);
            PG8_BAR; PG8_WAIT_L(0); PG8_MMA(1, 0, At, B0); PG8_BAR; PG8_SCHED;
            PG8_STAGE(PG8_SB(1, 1), b3 + hstep, voffB);
            PG8_WAIT_V(6); PG8_BAR; PG8_MMA(1, 1, At, B1); PG8_BAR;
            }
        }
        if constexpr (ALIGN_EPI) { if (wr == 0) PG8_BAR; }
        if constexpr (!Epi::AFTER_DRAIN) { E(acc, cur, wr, wc, fr, fq); S.done(cur); }
        if (!has_next) break;
#pragma unroll
        for (int a = 0; a < 2; ++a)
#pragma unroll
            for (int b = 0; b < 2; ++b)
#pragma unroll
                for (int m = 0; m < 4; ++m)
#pragma unroll
                    for (int n = 0; n < 2; ++n) acc[a][b][m][n] = (f32x4){0.f, 0.f, 0.f, 0.f};
        cur = nxt; cA = nA; cB = nB; ++ui; _Pragma("unroll") for (int _h = 0; _h < 2; ++_h) _Pragma("unroll") for (int _i = 0; _i < 2; ++_i) vC[_h][_i] = vN[_h][_i];
        if constexpr (ALIGN_EPI) { if (wr == 1) PG8_BAR; }
    }
    PG8_WAIT_V(0);
    if constexpr (!ALIGN_EPI) { if (wr == 0) PG8_BAR; }
    PG8_BAR;
    if constexpr (Epi::AFTER_DRAIN) { E.fused(acc, cur, wr, wc, fr, fq, lds, wid, lane); S.done(cur); }
#undef PG8_SA
#undef PG8_SB
#undef PG8_STAGE
#undef PG8_LDA
#undef PG8_LDB
#undef PG8_MMA
#undef PG8_WAIT_V
#undef PG8_WAIT_L
#undef PG8_BAR
#undef PG8_SCHED
}
#undef PG8_GOFF

}


namespace {
#define GAS __attribute__((address_space(1)))
#define LAS __attribute__((address_space(3)))
typedef unsigned short bf16;
typedef unsigned v4u __attribute__((ext_vector_type(4)));
typedef float f32x4 __attribute__((ext_vector_type(4)));
constexpr int NWAVES = 8, NTHREADS = 512, LDS_BYTES = 147456;

__device__ __forceinline__ unsigned pk2(float lo, float hi) { typedef float f2_c __attribute__((ext_vector_type(2))); typedef __bf16 b2_c __attribute__((ext_vector_type(2))); const f2_c v = {lo, hi}; return __builtin_bit_cast(unsigned, __builtin_convertvector(v, b2_c)); }
__device__ __forceinline__ unsigned f2bf(float f) { return pk2(f, f) & 0xffffu; }
__device__ __forceinline__ float bf2f(bf16 h) { return __uint_as_float((unsigned)h << 16); }
__device__ __forceinline__ float wave_sum(float v) {
#pragma unroll
    for (int o = 1; o < 64; o <<= 1) v += __shfl_xor(v, o);
    return v;
}
__device__ __forceinline__ float sigmoidf_(float x) { return __builtin_amdgcn_rcpf(1.f + __expf(-x)); }
__device__ __forceinline__ int fkey_(float x) { const int b = (int)__float_as_uint(x); return b >= 0 ? b : (b ^ 0x7fffffff); }
__device__ __forceinline__ float fkey_inv_(int k) { return __uint_as_float((unsigned)(k >= 0 ? k : (k ^ 0x7fffffff))); }
constexpr int KEY_NEG_INF = (int)0x807fffff;
template <int CTRL> __device__ __forceinline__ int dppi_(int v) { return __builtin_amdgcn_update_dpp(v, v, CTRL, 0xF, 0xF, false); }
template <int CTRL> __device__ __forceinline__ float dppf_(float v) { return __uint_as_float((unsigned)__builtin_amdgcn_update_dpp((int)__float_as_uint(v), (int)__float_as_uint(v), CTRL, 0xF, 0xF, false)); }
__device__ __forceinline__ int imax_(int a, int b) { return a > b ? a : b; }
__device__ __forceinline__ int gmax8i_(int v) {
    asm volatile("s_nop 1\n\tv_max_i32_dpp %0, %0, %0 quad_perm:[1,0,3,2] row_mask:0xf bank_mask:0xf\n\ts_nop 1\n\tv_max_i32_dpp %0, %0, %0 quad_perm:[2,3,0,1] row_mask:0xf bank_mask:0xf\n\t"
                 "s_nop 1\n\tv_max_i32_dpp %0, %0, %0 row_half_mirror row_mask:0xf bank_mask:0xf" : "+v"(v));
    return v; }
__device__ __forceinline__ int wmaxi_(int v) { v = gmax8i_(v); asm volatile("s_nop 1\n\tv_max_i32_dpp %0, %0, %0 row_mirror row_mask:0xf bank_mask:0xf" : "+v"(v));
    const int a = __builtin_amdgcn_readlane(v, 0), b = __builtin_amdgcn_readlane(v, 16), c = __builtin_amdgcn_readlane(v, 32), d = __builtin_amdgcn_readlane(v, 48); return imax_(imax_(a, b), imax_(c, d)); }
__device__ __forceinline__ float wsumf_(float v) { v += dppf_<0xB1>(v); v += dppf_<0x4E>(v); v += dppf_<0x141>(v); v += dppf_<0x140>(v);
    const float a = __uint_as_float((unsigned)__builtin_amdgcn_readlane((int)__float_as_uint(v), 0)), b = __uint_as_float((unsigned)__builtin_amdgcn_readlane((int)__float_as_uint(v), 16)),
                c = __uint_as_float((unsigned)__builtin_amdgcn_readlane((int)__float_as_uint(v), 32)), d = __uint_as_float((unsigned)__builtin_amdgcn_readlane((int)__float_as_uint(v), 48)); return (a + b) + (c + d); }


struct WS {
    int* ctl;
    bf16 *Wqkv_t, *Wo_t, *Hin_t, *Hout_t, *Wgu_t, *Wd_t;
    float *rot, *lbtab;
    float *V32;
    bf16 *Xb, *Qb, *Kb, *Vb, *Ob, *Gb;
    float *LG;
    bf16 *Uf, *Sf; float *Dbuf;
    float *Wr_t;
    bf16 *H1, *Y;
    int *rowlist; float *tok_w; int *tok_es;
};
constexpr int NROWS = T * 9 + 65 * 256;
constexpr int TAB_OFF = 131072;


template <int PERMK> __device__ __forceinline__ int perm_row(int n) {
    if (PERMK == 1) { if (n < 2048) { const int p = n & 63; if (p < 16) return (n & ~63) + 2 * (p & 7) + (p >> 3); } return n; }
    if (PERMK == 2) { const int up = n >> 8, i = n & 255; return (i >> 7) * 256 + up * 128 + (i & 127); }
    return n;
}
template <int PERMK> __device__ __forceinline__ void transpose_item(const float* W, int K, int N, bf16* WT, LAS float* scr, int item, int lane) {
    const int nblk = N / 32, kb = item / nblk, nb = item % nblk, k0 = 64 * kb, n0 = 32 * nb;
#pragma unroll 8
    for (int i = 0; i < 32; ++i) { const int kk = 2 * i + (lane >> 5); scr[kk * 33 + (lane & 31)] = __builtin_nontemporal_load(W + (size_t)(k0 + kk) * N + n0 + (lane & 31)); }
    asm volatile("s_waitcnt lgkmcnt(0)" ::: "memory");
    const int c = lane & 7;
#pragma unroll
    for (int j = 0; j < 4; ++j) { const int n = (lane >> 3) + 8 * j; const LAS float* s = scr + (8 * c) * 33 + n;
        v4u o; o.x = pk2(s[0 * 33], s[1 * 33]); o.y = pk2(s[2 * 33], s[3 * 33]); o.z = pk2(s[4 * 33], s[5 * 33]); o.w = pk2(s[6 * 33], s[7 * 33]);
        *(GAS v4u*)(WT + (size_t)perm_row<PERMK>(n0 + n) * K + k0 + 8 * c) = o; }
    asm volatile("s_waitcnt lgkmcnt(0)" ::: "memory");
}
template <int PERMK> __device__ __forceinline__ void transpose_batch(const float* W, size_t sstride, bf16* WT, size_t dstride, int nmat, int K, int N, LAS float* scr, int gw, int ngw, int lane) {
    const int ipm = (K / 64) * (N / 32);
    for (int it = gw; it < nmat * ipm; it += ngw) { const int mat = it / ipm; transpose_item<PERMK>(W + (size_t)mat * sstride, K, N, WT + (size_t)mat * dstride, scr, it % ipm, lane); }
}
struct Inputs { const float* p[17]; };
constexpr int CNT_STRIDE = 520, CNT_BASE = 16384;
constexpr int CTL_POISON = 2048;
typedef int v8i_ __attribute__((ext_vector_type(8)));
typedef float v16f_ __attribute__((ext_vector_type(16)));
__device__ __forceinline__ bool fp8_mfma_selftest(int lane) {
    const int r32 = lane & 31, h = lane >> 5;
    v8i_ A, B;
#pragma unroll
    for (int w = 0; w < 8; ++w) {
        float av[4], bv[4];
#pragma unroll
        for (int b = 0; b < 4; ++b) { const int k = 32 * h + 4 * w + b; av[b] = (float)((r32 * 3 + k * 5) % 5); bv[b] = (float)((k * 7 + r32 * 2) % 4); }
        int aw = 0, bw = 0;
        aw = __builtin_amdgcn_cvt_pk_fp8_f32(av[0], av[1], aw, false); aw = __builtin_amdgcn_cvt_pk_fp8_f32(av[2], av[3], aw, true);
        bw = __builtin_amdgcn_cvt_pk_fp8_f32(bv[0], bv[1], bw, false); bw = __builtin_amdgcn_cvt_pk_fp8_f32(bv[2], bv[3], bw, true);
        A[w] = aw; B[w] = bw;
    }
    v16f_ C;
#pragma unroll
    for (int r = 0; r < 16; ++r) C[r] = 0.f;
    C = __builtin_amdgcn_mfma_scale_f32_32x32x64_f8f6f4(A, B, C, 0, 0, 0, 0x7F7F7F7F, 0, 0x7F7F7F7F);
    bool ok = true;
#pragma unroll
    for (int r = 0; r < 16; ++r) {
        const int i = (r & 3) + 8 * (r >> 2) + 4 * h, j = r32; float e = 0.f;
        for (int k = 0; k < 64; ++k) e += (float)((i * 3 + k * 5) % 5) * (float)((k * 7 + j * 2) % 4);
        ok = ok && (C[r] == e);
    }
    return __all(ok);
}

__device__ __forceinline__ void prologue_phase(const Inputs& in, const WS& w, float* X32, LAS unsigned char* lds) {
    int tid_l = threadIdx.x; asm volatile("" : "+v"(tid_l));
    const int tid = tid_l, lane = tid & 63, wave = tid >> 6;
    const int gw = blockIdx.x * NWAVES + wave, ngw = gridDim.x * NWAVES;
    LAS float* scr = (LAS float*)(lds + wave * 16384);
    transpose_batch<1>(in.p[1], (size_t)D * 3072, w.Wqkv_t, (size_t)3072 * D, 2, D, 3072, scr, gw, ngw, lane);
    transpose_batch<0>(in.p[2], (size_t)D * D, w.Wo_t, (size_t)D * D, 2, D, D, scr, gw, ngw, lane);
    transpose_batch<0>(in.p[5], (size_t)D * 4096, w.Hin_t, (size_t)4096 * D, 2, D, 4096, scr, gw, ngw, lane);
    transpose_batch<0>(in.p[6], (size_t)D * D, w.Hout_t, (size_t)D * D, 2, D, D, scr, gw, ngw, lane);
    for (int L = 0; L < DEPTH; ++L) {
        transpose_batch<2>(in.p[11] + (size_t)L * NE * D * 512, (size_t)D * 512, w.Wgu_t + (size_t)L * 65 * 512 * D, (size_t)512 * D, NE, D, 512, scr, gw, ngw, lane);
        transpose_batch<2>(in.p[13] + (size_t)L * D * 512, 0, w.Wgu_t + ((size_t)L * 65 + 64) * 512 * D, 0, 1, D, 512, scr, gw, ngw, lane);
        transpose_batch<0>(in.p[12] + (size_t)L * NE * 256 * D, (size_t)256 * D, w.Wd_t + (size_t)L * 65 * D * 256, (size_t)D * 256, NE, 256, D, scr, gw, ngw, lane);
        transpose_batch<0>(in.p[14] + (size_t)L * 256 * D, 0, w.Wd_t + ((size_t)L * 65 + 64) * D * 256, 0, 1, 256, D, scr, gw, ngw, lane);
    }
    if (blockIdx.x == 0 && wave == 0) { const bool ok = fp8_mfma_selftest(lane); if (!ok && lane == 0) w.ctl[CTL_POISON] = 1; }
    const int gt = blockIdx.x * NTHREADS + tid, ngt = gridDim.x * NTHREADS;
    for (int i = gt; i < SEQ * 8; i += ngt) {
        const int pos = i >> 3, j = i & 7;
        const float inv_freq = (float)pow(500000.0, -(double)(2 * j) / 16.0);
        float sn, cs; sincosf((float)pos * inv_freq, &sn, &cs);
        w.rot[2 * i] = cs; w.rot[2 * i + 1] = sn;
    }
    for (int i = gt; i < 2 * 1024; i += ngt) {
        const int col = i & 1023, L = (i >> 10) ? 3 : 1; const float* r = in.p[7];
        const float v0 = r[col], v1 = r[1024 + col], v2 = r[2048 + col], v3 = r[3072 + col];
        const float mx = fmaxf(fmaxf(v0, v1), fmaxf(v2, v3));
        const float e0 = expf(v0 - mx), e1 = expf(v1 - mx), e2 = expf(v2 - mx), e3 = expf(v3 - mx), den = e0 + e1 + e2 + e3;
        w.lbtab[i] = (L == 1) ? e1 / den : (e1 + e2 + e3) / den;
    }
    if (gt < 2) { const float* lp = in.p[3] + gt * 256; float d01 = 0.f, d23 = 0.f; for (int i = 0; i < 64; ++i) { d01 += lp[i] * lp[64 + i]; d23 += lp[128 + i] * lp[192 + i]; }
        w.lbtab[2048 + gt] = expf(d01) - expf(d23) + (0.8f - 0.6f * expf(-0.3f * (float)(2 * gt))); }
    for (int i = gt; i < T; i += ngt) w.rowlist[(size_t)NE * T + i] = i;
    for (int i = gt; i < DEPTH * NE * D; i += ngt) { const int L = i / (NE * D), r = i % (NE * D), e = r / D, k = r % D; const float v = in.p[9][(size_t)L * D * NE + (size_t)k * NE + e];
        const unsigned hb = f2bf(v); bf16* dst = (bf16*)w.Wr_t + (size_t)L * 2 * NE * D; dst[r] = (bf16)hb; dst[NE * D + r] = (bf16)f2bf(v - __uint_as_float(hb << 16)); }
    for (size_t i = gt; i < (size_t)T * D / 4; i += ngt) {
        const f32x4 v = ((const f32x4*)in.p[0])[i];
        uint2 o; o.x = pk2(v[0], v[1]); o.y = pk2(v[2], v[3]); ((uint2*)w.Xb)[i] = o;
    }
}

__device__ __forceinline__ void ln_row(const float* vrow, float* xrow, bf16* brow, const float* g, const float* b, int lane) {
    f32x4 v[4]; float s = 0.f;
#pragma unroll
    for (int j = 0; j < 4; ++j) { v[j] = ((const f32x4*)vrow)[lane + 64 * j]; s += (v[j][0] + v[j][1]) + (v[j][2] + v[j][3]); }
    const float mean = wsumf_(s) * (1.f / D); float q = 0.f;
#pragma unroll
    for (int j = 0; j < 4; ++j) { v[j] = v[j] - mean; q += (v[j][0] * v[j][0] + v[j][1] * v[j][1]) + (v[j][2] * v[j][2] + v[j][3] * v[j][3]); }
    const float rstd = __builtin_amdgcn_rsqf(wsumf_(q) * (1.f / D) + LN_EPS);
#pragma unroll
    for (int j = 0; j < 4; ++j) {
        const f32x4 g4 = ((const f32x4*)g)[lane + 64 * j], b4 = ((const f32x4*)b)[lane + 64 * j];
        const f32x4 o = v[j] * rstd * g4 + b4;
        ((f32x4*)xrow)[lane + 64 * j] = o;
        uint2 ob; ob.x = pk2(o[0], o[1]); ob.y = pk2(o[2], o[3]); ((uint2*)brow)[lane + 64 * j] = ob;
    }
}
typedef float f32x4_ __attribute__((ext_vector_type(4)));
__device__ __forceinline__ pg8::MoeTabs moe_tables(const int* cnt, LAS unsigned char* lds, int tid) {
    asm volatile("" : "+v"(tid));
    LAS int* toff = (LAS int*)(lds + TAB_OFF); LAS int* cntv = toff + 80; LAS unsigned char* tile_e = (LAS unsigned char*)(cntv + 80);
    __syncthreads();
    if (tid < 64) cntv[tid] = cnt[tid * CNT_STRIDE];
    if (tid == 64) cntv[64] = T;
    __syncthreads();
    if (tid == 0) { int a = 0; for (int e = 0; e < 65; ++e) { toff[e] = a; a += (cntv[e] + 255) >> 8; } toff[65] = a; }
    __syncthreads();
    if (tid < 65) for (int m = toff[tid]; m < toff[tid + 1]; ++m) tile_e[m] = (unsigned char)tid;
    LAS unsigned short* xl = (LAS unsigned short*)(lds + TAB_OFF + 4096); LAS int* nxl = (LAS int*)(lds + TAB_OFF + 4096 + 3072);
    if (tid == 0) {
        const int g = blockIdx.x & 7; int n = 0;
        for (int e = g; e < 64; e += 8) for (int m = toff[e]; m < toff[e + 1]; ++m) xl[n++] = (unsigned short)m;
        for (int m = toff[64] + g; m < toff[65]; m += 8) xl[n++] = (unsigned short)m;
        nxl[0] = n;
    }
    __syncthreads();
    pg8::MoeTabs tb{toff, cntv, tile_e, xl, nxl[0]}; return tb;
}
typedef short bf16x8r __attribute__((ext_vector_type(8)));
__device__ __forceinline__ void lnroute_phase(const float* V32, float* X32, bf16* Xb, const float* lg, const float* lb, const bf16* WrHL, const float* bias, int* cnt, int* rowlist, float* tok_w, int* tok_es, LAS unsigned char* lds) {
    int tid_l = threadIdx.x; asm volatile("" : "+v"(tid_l));
    const int tid = tid_l, lane = tid & 63, wave = tid >> 6;
    constexpr int WP = 144;
    LAS unsigned char* wt = lds;
    LAS float* logitS = (LAS float*)(lds + 40960) + wave * 1024;
    LAS float* selw = (LAS float*)(lds + 40960 + 32768) + wave * 1024;
    LAS int* cntL = (LAS int*)(lds + 40960 + 65536); LAS int* baseL = cntL + 64;
    const float bias_e = bias[lane];
    for (int grp = blockIdx.x; grp < T / 128; grp += gridDim.x) {
        if (tid < 64) cntL[tid] = 0;
        const int tok0 = grp * 128 + wave * 16;
#pragma unroll 1
        for (int rb = 0; rb < 16; rb += 4) {
            f32x4 v[4][4];
#pragma unroll
            for (int r = 0; r < 4; ++r)
#pragma unroll
                for (int j = 0; j < 4; ++j) { typedef unsigned u2v_ __attribute__((ext_vector_type(2))); const u2v_ d = __builtin_nontemporal_load((const u2v_*)((const bf16*)V32 + (size_t)(tok0 + rb + r) * D) + lane + 64 * j);
                    v[r][j] = (f32x4){__uint_as_float(d[0] << 16), __uint_as_float(d[0] & 0xffff0000u), __uint_as_float(d[1] << 16), __uint_as_float(d[1] & 0xffff0000u)}; }
#pragma unroll
            for (int r = 0; r < 4; ++r) {
                float sm = 0.f;
#pragma unroll
                for (int j = 0; j < 4; ++j) sm += (v[r][j][0] + v[r][j][1]) + (v[r][j][2] + v[r][j][3]);
                const float mean = wsumf_(sm) * (1.f / D); float q = 0.f;
#pragma unroll
                for (int j = 0; j < 4; ++j) { v[r][j] = v[r][j] - mean; q += (v[r][j][0] * v[r][j][0] + v[r][j][1] * v[r][j][1]) + (v[r][j][2] * v[r][j][2] + v[r][j][3] * v[r][j][3]); }
                const float rstd = __builtin_amdgcn_rsqf(wsumf_(q) * (1.f / D) + LN_EPS);
#pragma unroll
                for (int j = 0; j < 4; ++j) {
                    const f32x4 g4 = ((const f32x4*)lg)[lane + 64 * j], b4 = ((const f32x4*)lb)[lane + 64 * j];
                    const f32x4 o = v[r][j] * rstd * g4 + b4;
                    uint2 ob; ob.x = pk2(o[0], o[1]); ob.y = pk2(o[2], o[3]); ((uint2*)(Xb + (size_t)(tok0 + rb + r) * D))[lane + 64 * j] = ob;
                }
            }
        }
        asm volatile("s_waitcnt vmcnt(0)" ::: "memory");
        f32x4_ acc[4];
#pragma unroll
        for (int nb = 0; nb < 4; ++nb) acc[nb] = (f32x4_){0.f, 0.f, 0.f, 0.f};
        const bf16* xa = Xb + (size_t)(tok0 + (lane & 15)) * D + 8 * (lane >> 4);
        const bf16* wsrc = WrHL + (size_t)(tid >> 8) * NE * D + (size_t)((tid >> 2) & 63) * D + (tid & 3) * 16;
        const int wdst = ((tid >> 8) * 64 + ((tid >> 2) & 63)) * WP + (tid & 3) * 32;
        v4u w0 = *(const v4u*)(wsrc), w1 = *(const v4u*)(wsrc + 8);
        v4u xa0 = *(const v4u*)(xa), xa1 = *(const v4u*)(xa + 32);
        *(LAS v4u*)(wt + wdst) = w0; *(LAS v4u*)(wt + wdst + 16) = w1;
        __syncthreads();
#pragma unroll 1
        for (int kb = 0; kb < 16; ++kb) {
            const int cur = kb & 1;
            v4u xn0, xn1;
            if (kb + 1 < 16) { w0 = *(const v4u*)(wsrc + (kb + 1) * 64); w1 = *(const v4u*)(wsrc + (kb + 1) * 64 + 8);
                xn0 = *(const v4u*)(xa + (kb + 1) * 64); xn1 = *(const v4u*)(xa + (kb + 1) * 64 + 32); }
#pragma unroll
            for (int ss = 0; ss < 2; ++ss) {
                const v4u ah = ss ? xa1 : xa0;
                const LAS unsigned char* wp = wt + cur * (2 * 64 * WP) + (lane & 15) * WP + (ss * 32 + 8 * (lane >> 4)) * 2;
#pragma unroll
                for (int nb = 0; nb < 4; ++nb) {
                    const v4u bh = *(const LAS v4u*)(wp + nb * 16 * WP), bl = *(const LAS v4u*)(wp + 64 * WP + nb * 16 * WP);
                    acc[nb] = __builtin_amdgcn_mfma_f32_16x16x32_bf16(__builtin_bit_cast(bf16x8r, ah), __builtin_bit_cast(bf16x8r, bh), acc[nb], 0, 0, 0);
                    acc[nb] = __builtin_amdgcn_mfma_f32_16x16x32_bf16(__builtin_bit_cast(bf16x8r, ah), __builtin_bit_cast(bf16x8r, bl), acc[nb], 0, 0, 0);
                }
            }
            if (kb + 1 < 16) { *(LAS v4u*)(wt + (cur ^ 1) * (2 * 64 * WP) + wdst) = w0; *(LAS v4u*)(wt + (cur ^ 1) * (2 * 64 * WP) + wdst + 16) = w1; xa0 = xn0; xa1 = xn1; }
            __syncthreads();
        }
#pragma unroll
        for (int nb = 0; nb < 4; ++nb)
#pragma unroll
            for (int r = 0; r < 4; ++r) logitS[(4 * (lane >> 4) + r) * 64 + 16 * nb + (lane & 15)] = acc[nb][r];
        asm volatile("s_waitcnt lgkmcnt(0)" ::: "memory");
        int mycount = 0;
#pragma unroll 1
        for (int t = 0; t < 16; ++t) {
            const float logit = logitS[t * 64 + lane];
            const float s = sigmoidf_(logit), c = s + bias_e;
            const int kc = fkey_(c);
            const int k1 = gmax8i_(kc);
            const unsigned long long eq = __ballot(kc == k1);
            const int g = lane >> 3; const unsigned gm = (unsigned)((eq >> (g * 8)) & 0xFFull); const int first = __ffs(gm) - 1;
            const int k2 = gmax8i_(((lane & 7) == first) ? KEY_NEG_INF : kc);
            const float gs = fkey_inv_(k1) + fkey_inv_(k2);
            int grank = 0;
#pragma unroll
            for (int gp = 0; gp < 8; ++gp) { const float og = __uint_as_float((unsigned)__builtin_amdgcn_readlane((int)__float_as_uint(gs), gp * 8)); grank += (og > gs || (og == gs && gp < g)) ? 1 : 0; }
            int work = (grank < 4) ? kc : KEY_NEG_INF; unsigned long long selm = 0ull;
#pragma unroll
            for (int r = 0; r < TOPK; ++r) {
                const int mx = wmaxi_(work);
                const unsigned long long e = __ballot(work == mx);
                const int l = __builtin_ctzll(e);
                selm |= 1ull << l;
                work = (lane == l) ? KEY_NEG_INF : work;
            }
            const bool sel = ((selm >> lane) & 1ull) != 0ull;
            const float ssum = wsumf_(sel ? s : 0.f);
            selw[t * 64 + lane] = sel ? s * __builtin_amdgcn_rcpf(ssum + 1e-20f) * ROUTED_SCALE : -1.f;
            mycount += sel ? 1 : 0;
        }
        const int localbase = __hip_atomic_fetch_add(&cntL[lane], mycount, __ATOMIC_RELAXED, __HIP_MEMORY_SCOPE_WORKGROUP);
        __syncthreads();
        if (wave == 0) { const int c = cntL[lane]; baseL[lane] = c > 0 ? atomicAdd(&cnt[lane * CNT_STRIDE], c) : 0; }
        __syncthreads();
        int slot = baseL[lane] + localbase;
#pragma unroll 1
        for (int t = 0; t < 16; ++t) {
            const float wv = selw[t * 64 + lane]; const bool sel = wv >= 0.f;
            const unsigned long long sm = __ballot(sel);
            if (sel) {
                rowlist[(size_t)lane * T + slot] = tok0 + t;
                const int j = __popcll(sm & ((1ull << lane) - 1ull));
                tok_es[(size_t)(tok0 + t) * 8 + j] = (lane << 16) | slot; tok_w[(size_t)(tok0 + t) * 8 + j] = wv;
                ++slot;
            }
        }
        __syncthreads();
    }
}
__device__ __forceinline__ void combine_phase(const unsigned char* Y, const int* tok_es, const float* tok_w, pg8::MoeTabs tb, const bf16* Xin, float* X32, bf16* Xb, const float* g, const float* b, const int* poison) {
    int tid_l = threadIdx.x; asm volatile("" : "+v"(tid_l));
    const int lane = tid_l & 63, gw = blockIdx.x * NWAVES + (tid_l >> 6), ngw = gridDim.x * NWAVES;
    const bool bad = poison[0] != 0;
    for (int row = gw; row < T; row += ngw) {
        const int es = lane < 8 ? tok_es[(size_t)row * 8 + lane] : 0; const float ew = lane < 8 ? tok_w[(size_t)row * 8 + lane] : 0.f;
        const bf16* xin = Xin + (size_t)row * D;
        f32x4 v[4];
#pragma unroll
        for (int j = 0; j < 4; ++j) { const uint2 d = ((const uint2*)xin)[lane + 64 * j];
            v[j] = (f32x4){__uint_as_float(d.x << 16), __uint_as_float(d.x & 0xffff0000u), __uint_as_float(d.y << 16), __uint_as_float(d.y & 0xffff0000u)} * ALPHA; }
#pragma unroll
        for (int jj = 0; jj < 9; ++jj) {
            size_t pos; float gt = 1.f;
            if (jj < 8) { const int p = __shfl(es, jj); gt = __shfl(ew, jj); pos = (size_t)tb.toff[p >> 16] * 256 + (p & 0xffff); } else pos = (size_t)tb.toff[64] * 256 + row;
            const unsigned* yr = (const unsigned*)(Y + pos * 1024); gt *= (1.f / 64.f);
            typedef float f2_ __attribute__((ext_vector_type(2)));
#pragma unroll
            for (int j = 0; j < 4; ++j) { const unsigned d = __builtin_nontemporal_load(yr + lane + 64 * j);
                const f2_ a = __builtin_amdgcn_cvt_pk_f32_fp8((int)d, false), c = __builtin_amdgcn_cvt_pk_f32_fp8((int)d, true);
                v[j][0] += gt * a[0]; v[j][1] += gt * a[1]; v[j][2] += gt * c[0]; v[j][3] += gt * c[1]; }
        }
        float s = 0.f;
#pragma unroll
        for (int j = 0; j < 4; ++j) s += (v[j][0] + v[j][1]) + (v[j][2] + v[j][3]);
        const float mean = wsumf_(s) * (1.f / D); float q = 0.f;
#pragma unroll
        for (int j = 0; j < 4; ++j) { v[j] = v[j] - mean; q += (v[j][0] * v[j][0] + v[j][1] * v[j][1]) + (v[j][2] * v[j][2] + v[j][3] * v[j][3]); }
        const float rstd = __builtin_amdgcn_rsqf(wsumf_(q) * (1.f / D) + LN_EPS);
#pragma unroll
        for (int j = 0; j < 4; ++j) {
            const f32x4 g4 = ((const f32x4*)g)[lane + 64 * j], b4 = ((const f32x4*)b)[lane + 64 * j];
            f32x4 o = v[j] * rstd * g4 + b4;
            if (bad) { const float qn = __builtin_nanf(""); o = (f32x4){qn, qn, qn, qn}; }
            if (X32) ((f32x4*)(X32 + (size_t)row * D))[lane + 64 * j] = o;
            if (!X32) { uint2 ob; ob.x = pk2(o[0], o[1]); ob.y = pk2(o[2], o[3]); ((uint2*)(Xb + (size_t)row * D))[lane + 64 * j] = ob; }
        }
    }
}
namespace attn {
typedef float f32x16 __attribute__((ext_vector_type(16)));
typedef unsigned u32x4 __attribute__((ext_vector_type(4)));
typedef int v8i __attribute__((ext_vector_type(8)));
constexpr int SLOTB = 16384, NSLOT = 4, WSF_OFF = 65536;
constexpr float THR = 2.f;
constexpr int ONE = 0x7F7F7F7F; constexpr int STG_OFF = 69632;
__device__ __forceinline__ int crow(int r, int hi) { return (r & 3) + 8 * (r >> 2) + 4 * hi; }
__device__ __forceinline__ void glds16(const void* gsrc, unsigned lds_dst) { unsigned keep;
    asm volatile("s_mov_b32 %0, m0\n\ts_mov_b32 m0, %2\n\ts_nop 0\n\tglobal_load_lds_dwordx4 %1, off\n\ts_mov_b32 m0, %0" : "=&s"(keep) : "v"(gsrc), "s"(lds_dst) : "memory"); }
#define ATT_WAIT_BAR(N) asm volatile("s_waitcnt vmcnt(" #N ") lgkmcnt(0)\n\ts_barrier" ::: "memory")
typedef short v4i16_t __attribute__((ext_vector_type(4)));
typedef short s16x4 __attribute__((ext_vector_type(4)));
__device__ __forceinline__ s16x4 vtr(const LAS unsigned char* p) { return __builtin_bit_cast(s16x4, __builtin_amdgcn_ds_read_tr16_b64_v4i16((LAS v4i16_t*)p)); }
__device__ __forceinline__ unsigned cvtpk(float lo, float hi) { typedef float f2 __attribute__((ext_vector_type(2))); typedef __bf16 b2 __attribute__((ext_vector_type(2))); f2 v = {lo, hi}; b2 b = __builtin_convertvector(v, b2); return __builtin_bit_cast(unsigned, b); }
__device__ __forceinline__ float max3f(float a, float b, float c) { float r; asm("v_max3_f32 %0, %1, %2, %3" : "=v"(r) : "v"(a), "v"(b), "v"(c)); return r; }
__device__ __forceinline__ float xhalf_max(float m) { auto rr = __builtin_amdgcn_permlane32_swap(__float_as_uint(m), __float_as_uint(m), false, false); float r; asm("v_max_f32 %0, %1, %2" : "=v"(r) : "v"(rr[0]), "v"(rr[1])); return r; }
__device__ __forceinline__ float xhalf_sum(float m) { auto rr = __builtin_amdgcn_permlane32_swap(__float_as_uint(m), __float_as_uint(m), false, false); return __uint_as_float(rr[0]) + __uint_as_float(rr[1]); }
__device__ __forceinline__ v8i mk8(const u32x4& a, const u32x4& b) { return (v8i){(int)a[0], (int)a[1], (int)a[2], (int)a[3], (int)b[0], (int)b[1], (int)b[2], (int)b[3]}; }

template <int VAR>
__device__ __forceinline__ void attn_unit(int b, int h, int qb, const unsigned char* __restrict__ Q8, const unsigned char* __restrict__ K8, const unsigned char* __restrict__ VT, bf16* Og,
                                          float lam, const float* __restrict__ subg, float oscale, LAS unsigned char* lds) {
    int tid_l = threadIdx.x; asm volatile("" : "+v"(tid_l));
    const int tid = tid_l, lane = tid & 63, r32 = lane & 31, hi = lane >> 5;
    const int wid = __builtin_amdgcn_readfirstlane(tid >> 6), mp = wid >> 2, wq = wid & 3;
    const size_t rowbase = (size_t)b * SEQ; const int q0 = qb * 128;
    const unsigned lds0 = (unsigned)(uintptr_t)lds;
    LAS float* wsf = (LAS float*)(lds + WSF_OFF) + wid * 64;
    const int kkey = 16 * wq + (lane >> 2), kcc = lane & 3;
    const unsigned char* ksrc = K8 + (rowbase + kkey) * 1024 + (h * 2 + mp) * 64 + 16 * (kcc ^ ((kkey >> 2) & 3));
    const unsigned char* vsrc = VT + ((size_t)((b * 8 + h) * 256)) * 8192 + wid * 1024 + lane * 16;
#define ATT_DMA_K(t, slot) glds16(ksrc + (size_t)(t) * 64 * 1024, (unsigned)__builtin_amdgcn_readfirstlane(lds0 + (unsigned)(slot) * SLOTB + wid * 1024))
#define ATT_DMA_V(t, slot) glds16(vsrc + (size_t)(t) * 8192, (unsigned)__builtin_amdgcn_readfirstlane(lds0 + (unsigned)(slot) * SLOTB + 8192 + wid * 1024))
    const unsigned char* Qw = Q8 + (rowbase + q0 + wq * 32 + r32) * 1024 + (h * 2 + mp) * 64 + hi * 32;
    const u32x4 qa = *(const u32x4*)(Qw), qb_ = *(const u32x4*)(Qw + 16);
    const v8i qf = mk8(qa, qb_);
    const int NT = 2 * qb + 2, tlast = 2 * qb + (wq >> 1);
    constexpr int KSL = 8192, VBASE = 4 * 8192;
#undef ATT_DMA_K
#undef ATT_DMA_V
#define ATT_DMA_K(t) glds16(ksrc + (size_t)(t) * 64 * 1024, (unsigned)__builtin_amdgcn_readfirstlane(lds0 + (unsigned)((t) & 3) * KSL + wid * 1024))
#define ATT_DMA_V(t) glds16(vsrc + (size_t)(t) * 8192, (unsigned)__builtin_amdgcn_readfirstlane(lds0 + VBASE + (unsigned)((t) & 3) * KSL + wid * 1024))
    ATT_DMA_K(0); if (NT > 1) ATT_DMA_K(1); ATT_DMA_V(0);
    int nlast = 0; if (NT > 2) { ATT_DMA_K(2); nlast += 1; } if (NT > 1) { ATT_DMA_V(1); nlast += 1; }
    f32x16 o[4];
    float zero_ = 0.f; asm volatile("" : "+v"(zero_));
#pragma unroll
    for (int d = 0; d < 4; ++d)
#pragma unroll
        for (int r = 0; r < 16; ++r) o[d][r] = zero_;
    const int sw = (r32 >> 2) & 3;
    const unsigned fua = (unsigned)(((2 * hi) ^ sw) * 16), fub = (unsigned)(((2 * hi + 1) ^ sw) * 16);
    const LAS unsigned char* kaddr0 = lds + mp * 4096 + r32 * 64; const LAS unsigned char* vaddr0 = lds + VBASE + r32 * 64;
    u32x4 kf[2][2], vf[4][2];
#define ATT_DSR128(dst, addr, off) dst = *(const LAS u32x4*)((addr) + (off))
#define ATT_KISSUE(t) do { const LAS unsigned char* ka_ = kaddr0 + ((t) & 3) * KSL; \
        ATT_DSR128(kf[0][0], ka_ + fua, 0); ATT_DSR128(kf[0][1], ka_ + fub, 0); ATT_DSR128(kf[1][0], ka_ + fua, 2048); ATT_DSR128(kf[1][1], ka_ + fub, 2048); } while (0)
#define ATT_VISSUE(t) do { const LAS unsigned char* va_ = vaddr0 + ((t) & 3) * KSL; \
        _Pragma("unroll") for (int d0 = 0; d0 < 4; ++d0) { ATT_DSR128(vf[d0][0], va_ + fua, d0 * 2048); ATT_DSR128(vf[d0][1], va_ + fub, d0 * 2048); } } while (0)
#define ATT_WB(N) asm volatile("s_waitcnt vmcnt(" #N ") lgkmcnt(0)\n\ts_barrier" ::: "memory")
#define ATT_WAITN(n) do { if ((n) == 2) { ATT_WB(2); } else if ((n) == 1) { ATT_WB(1); } else { ATT_WB(0); } __builtin_amdgcn_sched_barrier(0); } while (0)
#define ATT_SB() __builtin_amdgcn_sched_barrier(0)
#define ATT_QKM(P, blk) do { P = __builtin_amdgcn_mfma_scale_f32_32x32x64_f8f6f4(mk8(kf[blk][0], kf[blk][1]), qf, negm, 0, 0, 0, ONE, 0, ONE); if constexpr (VAR & 64) P = __builtin_amdgcn_mfma_scale_f32_32x32x64_f8f6f4(mk8(kf[blk][0], kf[blk][1]), qf, P, 0, 0, 0, ONE, 0, ONE); } while (0)
#define ATT_PVM(d0) do { o[d0] = __builtin_amdgcn_mfma_scale_f32_32x32x64_f8f6f4(pw, mk8(vf[d0][0], vf[d0][1]), o[d0], 0, 0, 0, ONE, 0, ONE); if constexpr (VAR & 64) o[d0] = __builtin_amdgcn_mfma_scale_f32_32x32x64_f8f6f4(pw, mk8(vf[d0][0], vf[d0][1]), o[d0], 0, 0, 0, ONE, 0, ONE); } while (0)
#define ATT_EXP8(P, b0) do { _Pragma("unroll") for (int r = (b0); r < (b0) + 8; ++r) P[r] = __builtin_amdgcn_exp2f(P[r]); } while (0)
#define ATT_MAXDEC(P0, P1, first) do { \
        float rm; { float ra_; \
        asm volatile("s_nop 15\n\ts_nop 7\n\t"     \
            "v_max3_f32 %0, %2, %3, %4\n\tv_max3_f32 %0, %0, %5, %6\n\tv_max3_f32 %0, %0, %7, %8\n\tv_max3_f32 %0, %0, %9, %10\n\t" \
            "v_max3_f32 %0, %0, %11, %12\n\tv_max3_f32 %0, %0, %13, %14\n\tv_max3_f32 %0, %0, %15, %16\n\tv_max3_f32 %0, %0, %17, %17" \
            : "=&v"(ra_), "+v"(P1) : "v"(P0[0]), "v"(P0[1]), "v"(P0[2]), "v"(P0[3]), "v"(P0[4]), "v"(P0[5]), "v"(P0[6]), "v"(P0[7]), "v"(P0[8]), "v"(P0[9]), "v"(P0[10]), "v"(P0[11]), "v"(P0[12]), "v"(P0[13]), "v"(P0[14]), "v"(P0[15])); \
        asm volatile("v_max3_f32 %0, %1, %2, %3\n\tv_max3_f32 %0, %0, %4, %5\n\tv_max3_f32 %0, %0, %6, %7\n\tv_max3_f32 %0, %0, %8, %9\n\t" \
            "v_max3_f32 %0, %0, %10, %11\n\tv_max3_f32 %0, %0, %12, %13\n\tv_max3_f32 %0, %0, %14, %15\n\tv_max3_f32 %0, %0, %16, %17" \
            : "=&v"(rm) : "v"(ra_), "v"(P1[0]), "v"(P1[1]), "v"(P1[2]), "v"(P1[3]), "v"(P1[4]), "v"(P1[5]), "v"(P1[6]), "v"(P1[7]), "v"(P1[8]), "v"(P1[9]), "v"(P1[10]), "v"(P1[11]), "v"(P1[12]), "v"(P1[13]), "v"(P1[14]), "v"(P1[15])); } \
        rm = xhalf_max(rm) - 6.f; \
        if (first) { _Pragma("unroll") for (int r = 0; r < 16; ++r) { P0[r] -= rm; P1[r] -= rm; negm[r] = 6.f - rm; } } \
        else if (__any(rm > THR)) { const float dl = fmaxf(rm, 0.f); const float nm_ = negm[0] - dl; \
            _Pragma("unroll") for (int r = 0; r < 16; ++r) { P0[r] -= dl; P1[r] -= dl; negm[r] = nm_; } \
            const float f = __builtin_amdgcn_exp2f(-dl); la *= f; lb *= f; if (hi == 0) wsf[r32] = f; resc = true; } } while (0)
    f32x16 pc0, pc1, negm; v8i pw; bool resc = false; float e[32]; float la = 0.f, lb = 0.f;
#pragma unroll
    for (int w = 0; w < 8; ++w) pw[w] = 0;
    ATT_WAITN(nlast);
    ATT_KISSUE(0);
    asm volatile("s_waitcnt lgkmcnt(0)\n\ts_barrier" ::: "memory"); ATT_SB();
#pragma unroll
    for (int r = 0; r < 16; ++r) negm[r] = 6.f;
    ATT_QKM(pc0, 0); ATT_QKM(pc1, 1);
    ATT_MAXDEC(pc0, pc1, true);
#define ATT_ES8(P, b0, eo, L) do { _Pragma("unroll") for (int r = 0; r < 8; ++r) { e[(eo) + r] = __builtin_amdgcn_exp2f(P[(b0) + r]); L += e[(eo) + r]; } \
        asm volatile("" : "+v"(e[(eo)]), "+v"(e[(eo) + 1]), "+v"(e[(eo) + 2]), "+v"(e[(eo) + 3]), "+v"(e[(eo) + 4]), "+v"(e[(eo) + 5]), "+v"(e[(eo) + 6]), "+v"(e[(eo) + 7]), "+v"(L)); } while (0)
#define ATT_CVT16(eo, w0) do { _Pragma("unroll") for (int w = 0; w < 4; ++w) { int x; asm volatile("" : "=v"(x)); x = __builtin_amdgcn_cvt_pk_fp8_f32(e[(eo) + 4 * w], e[(eo) + 4 * w + 1], x, false); x = __builtin_amdgcn_cvt_pk_fp8_f32(e[(eo) + 4 * w + 2], e[(eo) + 4 * w + 3], x, true); pw[(w0) + w] = x; } \
        asm volatile("" : "+v"(pw)); } while (0)
#define ATT_ISSUE_DMA(t) do { nlast = 0; if ((t) + 3 < NT) { ATT_DMA_K((t) + 3); nlast += 1; } if ((t) + 2 < NT) { ATT_DMA_V((t) + 2); nlast += 1; } } while (0)
#define ATT_PV_EXP() do { \
        ATT_PVM(0); ATT_SB(); ATT_ES8(pc0, 0, 0, la); ATT_SB(); \
        ATT_PVM(1); ATT_SB(); ATT_ES8(pc0, 8, 8, lb); ATT_SB(); \
        ATT_PVM(2); ATT_SB(); ATT_ES8(pc1, 0, 16, la); ATT_SB(); \
        ATT_PVM(3); ATT_SB(); ATT_ES8(pc1, 8, 24, lb); ATT_SB(); } while (0)
#define ATT_PV_EXP_D(t) do { \
        ATT_PVM(0); ATT_SB(); if (mp == 0) ATT_DMA_K((t) + 3); ATT_ES8(pc0, 0, 0, la); ATT_SB(); \
        ATT_PVM(1); ATT_SB(); if (mp == 1) ATT_DMA_K((t) + 3); ATT_ES8(pc0, 8, 8, lb); ATT_SB(); \
        ATT_PVM(2); ATT_SB(); if (mp == 0) ATT_DMA_V((t) + 2); ATT_ES8(pc1, 0, 16, la); ATT_SB(); \
        ATT_PVM(3); ATT_SB(); if (mp == 1) ATT_DMA_V((t) + 2); ATT_ES8(pc1, 8, 24, lb); ATT_SB(); } while (0)
#define ATT_RESC() do { if (resc) { resc = false; \
        _Pragma("unroll") for (int r = 0; r < 16; ++r) { const float fr = wsf[crow(r, hi)]; \
            _Pragma("unroll") for (int d = 0; d < 4; ++d) o[d][r] *= fr; } } } while (0)
#define ATT_CVT_ASM(eo, w0, TIE) do { int x0_, x1_, x2_, x3_; \
        asm volatile("v_cvt_pk_fp8_f32 %0, %5, %6\n\tv_cvt_pk_fp8_f32 %1, %9, %10\n\tv_cvt_pk_fp8_f32 %2, %13, %14\n\tv_cvt_pk_fp8_f32 %3, %17, %18\n\tv_cvt_pk_fp8_f32 %0, %7, %8 op_sel:[0,0,1]\n\tv_cvt_pk_fp8_f32 %1, %11, %12 op_sel:[0,0,1]\n\tv_cvt_pk_fp8_f32 %2, %15, %16 op_sel:[0,0,1]\n\tv_cvt_pk_fp8_f32 %3, %19, %20 op_sel:[0,0,1]" \
            : "=&v"(x0_), "=&v"(x1_), "=&v"(x2_), "=&v"(x3_), "+v"(TIE) : "v"(e[(eo) + 0]), "v"(e[(eo) + 1]), "v"(e[(eo) + 2]), "v"(e[(eo) + 3]), "v"(e[(eo) + 4]), "v"(e[(eo) + 5]), "v"(e[(eo) + 6]), "v"(e[(eo) + 7]), "v"(e[(eo) + 8]), "v"(e[(eo) + 9]), "v"(e[(eo) + 10]), "v"(e[(eo) + 11]), "v"(e[(eo) + 12]), "v"(e[(eo) + 13]), "v"(e[(eo) + 14]), "v"(e[(eo) + 15])); \
        pw[(w0)] = x0_; pw[(w0) + 1] = x1_; pw[(w0) + 2] = x2_; pw[(w0) + 3] = x3_; } while (0)
#define ATT_MAXDEC2(P0, P1) do { \
        ATT_CVT_ASM(0, 0, P1); ATT_CVT_ASM(16, 4, P1); \
        float rmr_; { float ra_; \
        asm volatile("s_nop 1\n\tv_max3_f32 %0, %2, %3, %4\n\tv_max3_f32 %0, %0, %5, %6\n\tv_max3_f32 %0, %0, %7, %8\n\tv_max3_f32 %0, %0, %9, %10\n\tv_max3_f32 %0, %0, %11, %12\n\tv_max3_f32 %0, %0, %13, %14\n\tv_max3_f32 %0, %0, %15, %16\n\tv_max3_f32 %0, %0, %17, %17" \
            : "=&v"(ra_), "+v"(P1) : "v"(P0[0]), "v"(P0[1]), "v"(P0[2]), "v"(P0[3]), "v"(P0[4]), "v"(P0[5]), "v"(P0[6]), "v"(P0[7]), "v"(P0[8]), "v"(P0[9]), "v"(P0[10]), "v"(P0[11]), "v"(P0[12]), "v"(P0[13]), "v"(P0[14]), "v"(P0[15])); \
        asm volatile("v_max3_f32 %0, %1, %2, %3\n\tv_max3_f32 %0, %0, %4, %5\n\tv_max3_f32 %0, %0, %6, %7\n\tv_max3_f32 %0, %0, %8, %9\n\tv_max3_f32 %0, %0, %10, %11\n\tv_max3_f32 %0, %0, %12, %13\n\tv_max3_f32 %0, %0, %14, %15\n\tv_max3_f32 %0, %0, %16, %17\n\tv_mov_b32 %1, %0\n\ts_nop 1\n\tv_permlane32_swap_b32 %0, %1\n\tv_max_f32 %0, %0, %1" \
            : "=&v"(rmr_), "+v"(ra_) : "v"(P1[0]), "v"(P1[1]), "v"(P1[2]), "v"(P1[3]), "v"(P1[4]), "v"(P1[5]), "v"(P1[6]), "v"(P1[7]), "v"(P1[8]), "v"(P1[9]), "v"(P1[10]), "v"(P1[11]), "v"(P1[12]), "v"(P1[13]), "v"(P1[14]), "v"(P1[15])); } \
        if (__any(rmr_ > THR + 6.f)) { const float dl = fmaxf(rmr_ - 6.f, 0.f); const float nm_ = negm[0] - dl;     \
            _Pragma("unroll") for (int r = 0; r < 16; ++r) { P0[r] -= dl; P1[r] -= dl; negm[r] = nm_; } \
            const float f = __builtin_amdgcn_exp2f(-dl); la *= f; lb *= f; if (hi == 0) wsf[r32] = f; resc = true; } } while (0)
#define ATT_QK_NEXT(t) do { \
        ATT_QKM(pc0, 0); ATT_SB(); \
        ATT_QKM(pc1, 1); ATT_SB(); \
        ATT_MAXDEC2(pc0, pc1); } while (0)
    {
        ATT_ISSUE_DMA(0);
        if (1 <= tlast) ATT_KISSUE(1);
        ATT_ES8(pc0, 0, 0, la); ATT_ES8(pc0, 8, 8, lb); ATT_ES8(pc1, 0, 16, la); ATT_ES8(pc1, 8, 24, lb);
        ATT_VISSUE(0);
        if (1 <= tlast) ATT_QK_NEXT(0); else { ATT_CVT16(0, 0); ATT_CVT16(16, 4); }
        ATT_WAITN(nlast);
    }
    int t = 1;
#define ATT_KISSUE_S(sl) do { const LAS unsigned char* ka_ = kaddr0 + (sl) * KSL; \
        ATT_DSR128(kf[0][0], ka_ + fua, 0); ATT_DSR128(kf[0][1], ka_ + fub, 0); ATT_DSR128(kf[1][0], ka_ + fua, 2048); ATT_DSR128(kf[1][1], ka_ + fub, 2048); } while (0)
#define ATT_VISSUE_S(sl) do { const LAS unsigned char* va_ = vaddr0 + (sl) * KSL; \
        _Pragma("unroll") for (int d0 = 0; d0 < 4; ++d0) { ATT_DSR128(vf[d0][0], va_ + fua, d0 * 2048); ATT_DSR128(vf[d0][1], va_ + fub, d0 * 2048); } } while (0)
#define ATT_DMA_K_S(tt, sl) glds16(ksrc + (size_t)(tt) * 64 * 1024, (unsigned)__builtin_amdgcn_readfirstlane(lds0 + (unsigned)(sl) * KSL + wid * 1024))
#define ATT_DMA_V_S(tt, sl) glds16(vsrc + (size_t)(tt) * 8192, (unsigned)__builtin_amdgcn_readfirstlane(lds0 + VBASE + (unsigned)(sl) * KSL + wid * 1024))
#define ATT_STEP_S(tt, c) do { \
        ATT_KISSUE_S(((c) + 1) & 3); ATT_SB(); \
        ATT_PVM(0); ATT_SB(); ATT_DMA_K_S((tt) + 3, ((c) + 3) & 3); ATT_ES8(pc0, 0, 0, la); ATT_SB(); \
        ATT_PVM(1); ATT_SB(); ATT_ES8(pc0, 8, 8, lb); ATT_SB(); \
        ATT_PVM(2); ATT_SB(); ATT_DMA_V_S((tt) + 2, ((c) + 2) & 3); ATT_ES8(pc1, 0, 16, la); ATT_SB(); \
        ATT_PVM(3); ATT_SB(); ATT_ES8(pc1, 8, 24, lb); ATT_SB(); \
        ATT_RESC(); \
        ATT_VISSUE_S((c) & 3); \
        ATT_QK_NEXT(tt); \
        ATT_WB(2); ATT_SB(); } while (0)
    const int nst = tlast < NT - 3 ? tlast : NT - 3;
#pragma unroll 1
    for (; t + 3 < nst; t += 4) { ATT_STEP_S(t, 1); ATT_STEP_S(t + 1, 2); ATT_STEP_S(t + 2, 3); ATT_STEP_S(t + 3, 0); }
    for (; t < tlast && t + 3 < NT; ++t) {
        ATT_KISSUE(t + 1); ATT_SB();
        ATT_PV_EXP_D(t);
        ATT_RESC();
        ATT_VISSUE(t);
        ATT_QK_NEXT(t);
        ATT_WB(2); ATT_SB();
    }
    for (; t < tlast; ++t) {
        ATT_ISSUE_DMA(t);
        ATT_KISSUE(t + 1); ATT_SB();
        ATT_PV_EXP();
        ATT_RESC();
        ATT_VISSUE(t);
        ATT_QK_NEXT(t);
        ATT_WAITN(nlast);
    }
    if (tlast >= 1) {
        ATT_ISSUE_DMA(tlast);
        ATT_PV_EXP();
        ATT_RESC();
        ATT_VISSUE(tlast);
        ATT_CVT16(0, 0); ATT_CVT16(16, 4);
        ATT_WAITN(nlast);
    }
    if (tlast + 1 < NT) {
        ATT_ISSUE_DMA(tlast + 1);
        ATT_PVM(0); ATT_PVM(1); ATT_PVM(2); ATT_PVM(3);
        ATT_WAITN(nlast);
    } else { ATT_PVM(0); ATT_PVM(1); ATT_PVM(2); ATT_PVM(3); }
    float l_reg = xhalf_sum(la + lb);
    if (hi == 0) wsf[32 + r32] = l_reg;
    asm volatile("s_waitcnt lgkmcnt(0)" ::: "memory");
    float rli[16];
#pragma unroll
    for (int r = 0; r < 16; ++r) rli[r] = 0.0625f * __builtin_amdgcn_rcpf(wsf[32 + crow(r, hi)]);
    ATT_WAIT_BAR(0);
    LAS float* xo = (LAS float*)(lds + wq * 16384) + lane;
    if (mp == 1) {
#pragma unroll
        for (int d = 0; d < 4; ++d)
#pragma unroll
            for (int r = 0; r < 16; ++r) xo[(d * 16 + r) * 64] = o[d][r] * rli[r];
    }
    ATT_WAIT_BAR(0);
    float ss[16];
#pragma unroll
    for (int r = 0; r < 16; ++r) ss[r] = 0.f;
    if (mp == 0) {
#pragma unroll
        for (int d = 0; d < 4; ++d)
#pragma unroll
            for (int r = 0; r < 16; ++r) { const float v = o[d][r] * rli[r] - lam * xo[(d * 16 + r) * 64]; o[d][r] = v; ss[r] += v * v; }
#pragma unroll
        for (int r = 0; r < 16; ++r) { float s = ss[r]; s += __shfl_xor(s, 1); s += __shfl_xor(s, 2); s += __shfl_xor(s, 4); s += __shfl_xor(s, 8); s += __shfl_xor(s, 16);
            ss[r] = oscale * __builtin_amdgcn_rsqf(s * (1.f / 128.f) + LN_EPS); }
        asm volatile("s_waitcnt lgkmcnt(0)" ::: "memory");
    }
    ATT_WAIT_BAR(0);
    if (mp == 0) {
        LAS unsigned short* stg = (LAS unsigned short*)(lds + STG_OFF + wq * 8192);
#pragma unroll
        for (int d = 0; d < 4; ++d) { const float gsc = subg[d * 32 + r32];
#pragma unroll
            for (int r = 0; r < 16; ++r) stg[crow(r, hi) * 128 + d * 32 + r32] = (unsigned short)f2bf(o[d][r] * ss[r] * gsc); }
        asm volatile("s_waitcnt lgkmcnt(0)" ::: "memory");
        bf16* Ow = Og + (rowbase + q0 + wq * 32) * 1024 + h * 128;
#pragma unroll
        for (int i = 0; i < 8; ++i) { const int row = 4 * i + (lane >> 4), ch = lane & 15;
            const u32x4 v = *(const LAS u32x4*)(stg + row * 128 + ch * 8);
            *(u32x4*)(Ow + (size_t)row * 1024 + ch * 8) = v; }
    }
#undef ATT_DMA_K
#undef ATT_DMA_V
}
template <int VAR = 0>
__device__ __forceinline__ void attn_phase(const unsigned char* Q8, const unsigned char* K8, const unsigned char* VT, bf16* Og, float lam, const float* subg, float oscale, LAS unsigned char* lds) {
    const int G = gridDim.x, bx = blockIdx.x, vcu = (G % 8 == 0) ? (bx % 8) * (G / 8) + bx / 8 : bx;
    for (int v = vcu; v < 256; v += G) {
        const int bh = v >> 4, s = v & 15;
#pragma unroll 1
        for (int i = 0; i < 8; ++i) {
            const int qb = (i >> 1) * 32 + ((i & 1) ? 31 - s : s);
            attn_unit<VAR>(bh >> 3, bh & 7, qb, Q8, K8, VT, Og, lam, subg, oscale, lds);
        }
    }
}
}

namespace hgrn {
typedef short bf16x8 __attribute__((ext_vector_type(8)));
typedef short s16x4 __attribute__((ext_vector_type(4)));
typedef float f32x16 __attribute__((ext_vector_type(16)));
typedef unsigned u32x4 __attribute__((ext_vector_type(4)));
typedef unsigned u32x2 __attribute__((ext_vector_type(2)));
constexpr int L_WT = 0, L_BM = 4096, L_KT = 8192, L_VT = 24576, L_QB = 40960, L_KB = 57344, L_QT = 73728, L_SSQ = 90624;
constexpr int QT_PITCH = 264;
using attn::crow; using attn::vtr; using attn::cvtpk;

__device__ __forceinline__ void chunk_cumsum(float (&v)[16], int lane, int wave, int seg, LAS unsigned char* lds) {
    LAS float* WT = (LAS float*)(lds + L_WT);
#pragma unroll
    for (int off = 8; off < 64; off <<= 1)
#pragma unroll
        for (int i = 0; i < 16; ++i) { const float n = __shfl_up(v[i], off); if (lane >= off) v[i] += n; }
    if (lane >= 56) {
#pragma unroll
        for (int i = 0; i < 16; ++i) WT[wave * 128 + seg * 16 + i] = v[i];
    }
    __syncthreads();
    for (int w = 0; w < wave; ++w) {
#pragma unroll
        for (int i = 0; i < 16; i += 4) { const f32x4 a = *(const LAS f32x4*)(WT + w * 128 + seg * 16 + i); v[i] += a[0]; v[i + 1] += a[1]; v[i + 2] += a[2]; v[i + 3] += a[3]; }
    }
}
__device__ __forceinline__ void unpack16(const u32x4& a, const u32x4& b, float (&o)[16]) {
#pragma unroll
    for (int i = 0; i < 4; ++i) { o[2 * i] = __uint_as_float(a[i] << 16); o[2 * i + 1] = __uint_as_float(a[i] & 0xffff0000u); o[8 + 2 * i] = __uint_as_float(b[i] << 16); o[8 + 2 * i + 1] = __uint_as_float(b[i] & 0xffff0000u); }
}
__device__ __forceinline__ void pack16(const float (&v)[16], u32x4& a, u32x4& b) {
#pragma unroll
    for (int i = 0; i < 4; ++i) { a[i] = cvtpk(v[2 * i], v[2 * i + 1]); b[i] = cvtpk(v[8 + 2 * i], v[8 + 2 * i + 1]); }
}
__device__ __forceinline__ int tr_off(int s, int seg) { return ((seg >> 1) * 4 + (s >> 4)) * 1024 + (s & 15) * 64 + (seg & 1) * 32; }

__device__ __forceinline__ void passA(const bf16* Kh, const bf16* LG, const bf16* Vh, bf16* Ufrag, float* Dbuf, LAS unsigned char* lds) {
    int tid_l = threadIdx.x; asm volatile("" : "+v"(tid_l));
    const int tid = tid_l, lane = tid & 63, wave = __builtin_amdgcn_readfirstlane(tid >> 6), t = tid >> 3, seg = tid & 7, hi = lane >> 5;
    LAS float* BL = (LAS float*)(lds + L_BM);
    for (int unit = blockIdx.x; unit < 4096; unit += gridDim.x) {
        const int bh = unit >> 8, c = unit & 255;
        const size_t ro = ((size_t)(bh >> 3) * SEQ + c * 64 + t) * 1024 + (bh & 7) * 128 + seg * 16;
        float b[16];
        { const u32x4 l0 = *(const u32x4*)(LG + ro), l1 = *(const u32x4*)(LG + ro + 8); unpack16(l0, l1, b); }
        const u32x4 k0 = *(const u32x4*)(Kh + ro), k1 = *(const u32x4*)(Kh + ro + 8), v0 = *(const u32x4*)(Vh + ro), v1 = *(const u32x4*)(Vh + ro + 8);
        chunk_cumsum(b, lane, wave, seg, lds);
        if (t == 63) {
#pragma unroll
            for (int i = 0; i < 16; ++i) { BL[seg * 16 + i] = b[i]; Dbuf[(size_t)unit * 128 + seg * 16 + i] = __expf(b[i]); }
        }
        __syncthreads();
        float kk[16]; unpack16(k0, k1, kk);
#pragma unroll
        for (int i = 0; i < 16; ++i) kk[i] *= __expf(BL[seg * 16 + i] - b[i]);
        u32x4 ka, kb_; pack16(kk, ka, kb_);
        const int to = tr_off(t, seg);
        *(LAS u32x4*)(lds + L_KT + to) = ka; *(LAS u32x4*)(lds + L_KT + to + 16) = kb_;
        *(LAS u32x4*)(lds + L_VT + to) = v0; *(LAS u32x4*)(lds + L_VT + to + 16) = v1;
        __syncthreads();
        const int db = wave >> 1, eb0 = (wave & 1) * 2;
        const int fo = ((lane >> 4) & 1) * 32 + (lane & 3) * 8 + (4 * hi + ((lane & 15) >> 2)) * 64;
        f32x16 u[2];
#pragma unroll
        for (int x = 0; x < 2; ++x)
#pragma unroll
            for (int r = 0; r < 16; ++r) u[x][r] = 0.f;
#pragma unroll
        for (int ks = 0; ks < 4; ++ks) {
            const LAS unsigned char* ap = lds + L_KT + (db * 4 + ks) * 1024 + fo;
            const s16x4 al = vtr(ap), ah = vtr(ap + 512);
            const bf16x8 af = (bf16x8){al[0], al[1], al[2], al[3], ah[0], ah[1], ah[2], ah[3]};
#pragma unroll
            for (int x = 0; x < 2; ++x) {
                const LAS unsigned char* bp = lds + L_VT + ((eb0 + x) * 4 + ks) * 1024 + fo;
                const s16x4 bl = vtr(bp), bhh = vtr(bp + 512);
                const bf16x8 bfr = (bf16x8){bl[0], bl[1], bl[2], bl[3], bhh[0], bhh[1], bhh[2], bhh[3]};
                u[x] = __builtin_amdgcn_mfma_f32_32x32x16_bf16(af, bfr, u[x], 0, 0, 0);
            }
        }
#pragma unroll
        for (int x = 0; x < 2; ++x) {
            u32x4 a, b2;
#pragma unroll
            for (int i = 0; i < 4; ++i) { a[i] = cvtpk(u[x][2 * i], u[x][2 * i + 1]); b2[i] = cvtpk(u[x][8 + 2 * i], u[x][8 + 2 * i + 1]); }
            bf16* up = Ufrag + (((size_t)unit * 16 + db * 4 + eb0 + x) * 64 + lane) * 16;
            *(u32x4*)up = a; *(u32x4*)(up + 8) = b2;
        }
        __syncthreads();
    }
}
__device__ __forceinline__ void passB(const bf16* Ufrag, const float* Dbuf, bf16* Sfrag) {
    int tid_l = threadIdx.x; asm volatile("" : "+v"(tid_l));
    const int tid = tid_l;
    if (tid >= 256) return;
    for (int i = blockIdx.x * 256 + tid; i < 65536; i += gridDim.x * 256) {
        const int seq = i >> 12, rem = i & 4095, tile = rem >> 8, lane = (rem >> 2) & 63, g = rem & 3;
        const int d0 = 32 * (tile >> 2) + 8 * g + 4 * (lane >> 5);
        const size_t eo = (((size_t)seq * 256 * 16 + tile) * 64 + lane) * 16 + 4 * g;
        const float* dp = Dbuf + (size_t)seq * 256 * 128 + d0;
        float s0 = 0.f, s1 = 0.f, s2 = 0.f, s3 = 0.f;
        for (int c0 = 0; c0 < 256; c0 += 8) {
            u32x2 uu[8]; f32x4 dd[8];
#pragma unroll
            for (int j = 0; j < 8; ++j) { uu[j] = *(const u32x2*)(Ufrag + eo + (size_t)(c0 + j) * 16384); dd[j] = *(const f32x4*)(dp + (size_t)(c0 + j) * 128); }
#pragma unroll
            for (int j = 0; j < 8; ++j) {
                u32x2 so; so[0] = cvtpk(s0, s1); so[1] = cvtpk(s2, s3);
                *(u32x2*)(Sfrag + eo + (size_t)(c0 + j) * 16384) = so;
                s0 = dd[j][0] * s0 + __uint_as_float(uu[j][0] << 16); s1 = dd[j][1] * s1 + __uint_as_float(uu[j][0] & 0xffff0000u);
                s2 = dd[j][2] * s2 + __uint_as_float(uu[j][1] << 16); s3 = dd[j][3] * s3 + __uint_as_float(uu[j][1] & 0xffff0000u);
            }
        }
    }
}
template <int PARTS = 7>
__device__ __forceinline__ void passC(const bf16* Qh, const bf16* Kh, const bf16* LG, const bf16* Vh, const bf16* Gh, const bf16* Sfrag, const float* ng, bf16* Oh, LAS unsigned char* lds) {
    int tid_l = threadIdx.x; asm volatile("" : "+v"(tid_l));
    const int tid = tid_l, lane = tid & 63, wave = __builtin_amdgcn_readfirstlane(tid >> 6), t = tid >> 3, seg = tid & 7, hi = lane >> 5, r32 = lane & 31;
    const int tb = wave >> 2, eb = wave & 3;
    LAS float* BM = (LAS float*)(lds + L_BM); LAS float* SSQ = (LAS float*)(lds + L_SSQ);
    const float ngl = ng[eb * 32 + r32];
    for (int unit = blockIdx.x; unit < 4096; unit += gridDim.x) {
        const int bh = unit >> 8, c = unit & 255;
        const size_t rb = ((size_t)(bh >> 3) * SEQ + c * 64) * 1024 + (bh & 7) * 128;
        const size_t ro = rb + (size_t)t * 1024 + seg * 16;
        float b[16];
        { const u32x4 l0 = *(const u32x4*)(LG + ro), l1 = *(const u32x4*)(LG + ro + 8); unpack16(l0, l1, b); }
        const u32x4 q0 = *(const u32x4*)(Qh + ro), q1 = *(const u32x4*)(Qh + ro + 8), k0 = *(const u32x4*)(Kh + ro), k1 = *(const u32x4*)(Kh + ro + 8);
        const u32x4 v0 = *(const u32x4*)(Vh + ro), v1 = *(const u32x4*)(Vh + ro + 8);
        u32x4 sf[4][2];
#pragma unroll
        for (int db = 0; db < 4; ++db) { const bf16* sp = Sfrag + (((size_t)unit * 16 + db * 4 + eb) * 64 + lane) * 16; sf[db][0] = *(const u32x4*)sp; sf[db][1] = *(const u32x4*)(sp + 8); }
        float gate[16];
#pragma unroll
        for (int r = 0; r < 16; ++r) gate[r] = bf2f(Gh[rb + (size_t)(32 * tb + crow(r, hi)) * 1024 + eb * 32 + r32]);
        chunk_cumsum(b, lane, wave, seg, lds);
        if (t == 31) {
#pragma unroll
            for (int i = 0; i < 16; ++i) BM[seg * 16 + i] = b[i];
        }
        __syncthreads();
        {
            float qq[16], kk[16], qt[16]; unpack16(q0, q1, qq); unpack16(k0, k1, kk);
#pragma unroll
            for (int i = 0; i < 16; ++i) { const float bm = BM[seg * 16 + i]; qt[i] = qq[i] * __expf(b[i]); qq[i] *= __expf(b[i] - bm); kk[i] *= __expf(bm - b[i]); }
            u32x4 a0, a1; pack16(qq, a0, a1);
            *(LAS u32x4*)(lds + L_QB + (seg * 2) * 1024 + t * 16) = a0; *(LAS u32x4*)(lds + L_QB + (seg * 2 + 1) * 1024 + t * 16) = a1;
            pack16(kk, a0, a1);
            *(LAS u32x4*)(lds + L_KB + (seg * 2) * 1024 + t * 16) = a0; *(LAS u32x4*)(lds + L_KB + (seg * 2 + 1) * 1024 + t * 16) = a1;
            pack16(qt, a0, a1);
            LAS unsigned char* qp = lds + L_QT + t * QT_PITCH + seg * 32;
            *(LAS u32x2*)(qp) = (u32x2){a0[0], a0[1]}; *(LAS u32x2*)(qp + 8) = (u32x2){a0[2], a0[3]}; *(LAS u32x2*)(qp + 16) = (u32x2){a1[0], a1[1]}; *(LAS u32x2*)(qp + 24) = (u32x2){a1[2], a1[3]};
            const int to = tr_off(t, seg);
            *(LAS u32x4*)(lds + L_VT + to) = v0; *(LAS u32x4*)(lds + L_VT + to + 16) = v1;
        }
        __syncthreads();
        if constexpr ((PARTS & 2) == 0) { if (b[0] == 12345.678f) Oh[rb] = 1; __syncthreads(); continue; }
        f32x16 p[2];
#pragma unroll
        for (int x = 0; x < 2; ++x)
#pragma unroll
            for (int r = 0; r < 16; ++r) p[x][r] = 0.f;
#pragma unroll
        for (int sb = 0; sb < 2; ++sb) {
            if (sb <= tb) {
#pragma unroll
                for (int d0 = 0; d0 < 8; ++d0) {
                    const bf16x8 ka = *(const LAS bf16x8*)(lds + L_KB + (2 * d0 + hi) * 1024 + (32 * sb + r32) * 16);
                    const bf16x8 qb_ = *(const LAS bf16x8*)(lds + L_QB + (2 * d0 + hi) * 1024 + (32 * tb + r32) * 16);
                    p[sb] = __builtin_amdgcn_mfma_f32_32x32x16_bf16(ka, qb_, p[sb], 0, 0, 0);
                }
            }
        }
        if (tb == 0) {
#pragma unroll
            for (int r = 0; r < 16; ++r) if (crow(r, hi) > r32) p[0][r] = 0.f;
        } else {
#pragma unroll
            for (int r = 0; r < 16; ++r) if (crow(r, hi) > r32) p[1][r] = 0.f;
        }
        u32x4 pw[4];
#pragma unroll
        for (int i = 0; i < 4; ++i) { pw[0][i] = cvtpk(p[0][2 * i], p[0][2 * i + 1]); pw[1][i] = cvtpk(p[0][8 + 2 * i], p[0][8 + 2 * i + 1]); pw[2][i] = cvtpk(p[1][2 * i], p[1][2 * i + 1]); pw[3][i] = cvtpk(p[1][8 + 2 * i], p[1][8 + 2 * i + 1]); }
        f32x16 o;
#pragma unroll
        for (int r = 0; r < 16; ++r) o[r] = 0.f;
        const int fo = ((lane >> 4) & 1) * 32 + (lane & 3) * 8 + (4 * hi + ((lane & 15) >> 2)) * 64;
#pragma unroll
        for (int ks = 0; ks < 4; ++ks) {
            if (ks < 2 * (tb + 1)) {
                const LAS unsigned char* bp = lds + L_VT + (eb * 4 + ks) * 1024 + fo;
                const s16x4 bl = vtr(bp), bhh = vtr(bp + 512);
                const bf16x8 vf = (bf16x8){bl[0], bl[1], bl[2], bl[3], bhh[0], bhh[1], bhh[2], bhh[3]};
                o = __builtin_amdgcn_mfma_f32_32x32x16_bf16(__builtin_bit_cast(bf16x8, pw[ks]), vf, o, 0, 0, 0);
            }
        }
#pragma unroll
        for (int s8 = 0; s8 < 8; ++s8) {
            const int db = s8 >> 1, half = s8 & 1;
            const LAS unsigned char* qp = lds + L_QT + (32 * tb + r32) * QT_PITCH + (32 * db + 16 * half + 4 * hi) * 2;
            const u32x2 lo = *(const LAS u32x2*)qp, hh = *(const LAS u32x2*)(qp + 16);
            const u32x4 af = (u32x4){lo[0], lo[1], hh[0], hh[1]};
            o = __builtin_amdgcn_mfma_f32_32x32x16_bf16(__builtin_bit_cast(bf16x8, af), __builtin_bit_cast(bf16x8, sf[db][half]), o, 0, 0, 0);
        }
        if constexpr ((PARTS & 4) == 0) { if (o[0] == 12345.678f) Oh[rb] = 1; __syncthreads(); continue; }
        float ssr[16];
#pragma unroll
        for (int r = 0; r < 16; ++r) { float s = o[r] * o[r]; s += __shfl_xor(s, 1); s += __shfl_xor(s, 2); s += __shfl_xor(s, 4); s += __shfl_xor(s, 8); s += __shfl_xor(s, 16); ssr[r] = s; }
        if (r32 == 0) {
#pragma unroll
            for (int r = 0; r < 16; ++r) SSQ[wave * 32 + crow(r, hi)] = ssr[r];
        }
        __syncthreads();
        bf16* op = Oh + rb + (size_t)(32 * tb) * 1024 + eb * 32 + r32;
#pragma unroll
        for (int r = 0; r < 16; ++r) {
            const int row = crow(r, hi);
            const float tot = SSQ[(tb * 4 + 0) * 32 + row] + SSQ[(tb * 4 + 1) * 32 + row] + SSQ[(tb * 4 + 2) * 32 + row] + SSQ[(tb * 4 + 3) * 32 + row];
            const float rstd = __builtin_amdgcn_rsqf(tot * (1.f / 128.f) + LN_EPS);
            op[(size_t)row * 1024] = (bf16)f2bf(o[r] * rstd * ngl * gate[r]);
        }
        __syncthreads();
    }
}
}


#define XB_TMO      128
#define XB_XCNT(j)  (256  + 64 * (j))
#define XB_XSUB(j)  (1280 + 64 * (j))
#define XB_XGEN(j)  (2304 + 64 * (j))
#define XB_TOP      3328
#define XB_TOPGEN   3392
#define XCD_BAR_WORDS 3456
#define XB_SPIN_CAP (1u << 18)

__device__ __forceinline__ unsigned xb_ld(unsigned* p)              { return __hip_atomic_load(p, __ATOMIC_RELAXED, __HIP_MEMORY_SCOPE_AGENT); }
__device__ __forceinline__ unsigned xb_add(unsigned* p, unsigned v) { return __hip_atomic_fetch_add(p, v, __ATOMIC_RELAXED, __HIP_MEMORY_SCOPE_AGENT); }
__device__ __forceinline__ unsigned xb_xcc_id() { return (unsigned)__builtin_amdgcn_s_getreg((3 << 11) | 20) & 0xFu; }
#define XB_SPIN(cond, bar) do { unsigned _sp = 0; while (cond) { __builtin_amdgcn_s_sleep(1); \
    if ((++_sp & 255u) == 0u) { if (xb_ld(&(bar)[XB_TMO])) break; if (_sp > XB_SPIN_CAP) { atomicAdd(&(bar)[XB_TMO], 1u); break; } } } } while (0)

struct XcdBarrier {
    unsigned* bar; unsigned x;
    volatile LAS unsigned* st;
};

__device__ __forceinline__ XcdBarrier xcd_barrier_post(unsigned* bar, volatile LAS unsigned* st) {
    XcdBarrier b; b.bar = bar; b.x = xb_xcc_id(); b.st = st;
    if (threadIdx.x == 0) (void)xb_add(&bar[XB_XCNT(b.x)], 1u);
    return b;
}
__device__ __forceinline__ void xcd_barrier_complete(unsigned* bar, unsigned x, unsigned& nloc, unsigned& nx) {
    const unsigned G = gridDim.x * gridDim.y * gridDim.z;
    unsigned sum, cnt, mine, sp = 0u;
    for (;;) {
        sum = 0u; cnt = 0u; mine = 0u;
#pragma unroll
        for (unsigned j = 0; j < 16; ++j) { const unsigned c = xb_ld(&bar[XB_XCNT(j)]); sum += c; cnt += (c > 0u) ? 1u : 0u; mine = (j == x) ? c : mine; }
        if (sum == G) break;
        __builtin_amdgcn_s_sleep(1);
        if ((++sp & 255u) == 0u) { if (xb_ld(&bar[XB_TMO])) break; if (sp > XB_SPIN_CAP) { atomicAdd(&bar[XB_TMO], 1u); break; } }
    }
    nloc = mine > 0u ? mine : 1u; nx = cnt > 0u ? cnt : 1u;
}

__device__ __forceinline__ void xcd_barrier(const XcdBarrier& b) {
    asm volatile("s_waitcnt vmcnt(0)" ::: "memory");
    __syncthreads();
    if (threadIdx.x == 0) {
        unsigned* bar = b.bar;
        __builtin_amdgcn_s_waitcnt(0);
        unsigned nloc = b.st[0], nx = b.st[1];
        if (nloc == 0u) { xcd_barrier_complete(bar, b.x, nloc, nx); b.st[0] = nloc; b.st[1] = nx; }
        const unsigned old = xb_add(&bar[XB_XSUB(b.x)], 1u);
        const unsigned gen = old / nloc;
        if (old + 1u == (gen + 1u) * nloc) {
            __builtin_amdgcn_fence(__ATOMIC_RELEASE, "agent");
            asm volatile("s_waitcnt vmcnt(0)" ::: "memory");
            const unsigned og = xb_add(&bar[XB_TOP], 1u);
            const unsigned tg = og / nx;
            if (og + 1u == (tg + 1u) * nx) xb_add(&bar[XB_TOPGEN], 1u);
            else XB_SPIN(xb_ld(&bar[XB_TOPGEN]) == tg, bar);
            __builtin_amdgcn_fence(__ATOMIC_ACQUIRE, "agent");
            xb_add(&bar[XB_XGEN(b.x)], 1u);
            asm volatile("s_waitcnt vmcnt(0)" ::: "memory");
        } else {
            XB_SPIN(xb_ld(&bar[XB_XGEN(b.x)]) == gen, bar);
            __builtin_amdgcn_fence(__ATOMIC_ACQUIRE, "agent");
            asm volatile("s_waitcnt vmcnt(0)" ::: "memory");
        }
    }
    __syncthreads();
}

constexpr int BAR_LDS_OFF = LDS_BYTES - 64;
constexpr int CTL_BAR = 4096;

#ifndef HGC_PROBE_PARTS
#define HGC_PROBE_PARTS 7
#endif
#ifndef PROBE_MASK
#define PROBE_MASK 0
#endif
#define PROBE_REP(bit) for (int rep_ = 0; rep_ < (((PROBE_MASK) & (bit)) ? 2 : 1); ++rep_)
struct Params { Inputs in; WS w; float* X; };
typedef const __attribute__((address_space(4))) Params CParams;
template <int MODE>
__device__ __forceinline__ void mv_probe(int* ctl, int lane) {
    v8i_ A, B;
#pragma unroll
    for (int w = 0; w < 8; ++w) { A[w] = 0x30303030 + (lane & 7) * 0x01010101; B[w] = 0x31313131 + (lane & 3) * 0x01010101; }
    v16f_ acc[4];
#pragma unroll
    for (int d = 0; d < 4; ++d)
#pragma unroll
        for (int r = 0; r < 16; ++r) acc[d][r] = 0.f;
    float x[8];
#pragma unroll
    for (int i = 0; i < 8; ++i) x[i] = -(float)(lane + i) * 0.01f;
    float s = 0.f;
#pragma unroll 1
    for (int it = 0; it < 2048; ++it) {
#pragma unroll
        for (int d = 0; d < 4; ++d) {
            if constexpr ((MODE & 1) != 0) { acc[d] = __builtin_amdgcn_mfma_scale_f32_32x32x64_f8f6f4(A, B, acc[d], 0, 0, 0, 0x7F7F7F7F, 0, 0x7F7F7F7F); __builtin_amdgcn_sched_barrier(0); }
            if constexpr ((MODE & 2) != 0) {
                asm volatile("" : "+v"(x[0]), "+v"(x[1]), "+v"(x[2]), "+v"(x[3]), "+v"(x[4]), "+v"(x[5]), "+v"(x[6]), "+v"(x[7]));
                float e[8];
#pragma unroll
                for (int i = 0; i < 8; ++i) { e[i] = __builtin_amdgcn_exp2f(x[i]); s += e[i]; }
                asm volatile("" : "+v"(e[0]), "+v"(e[1]), "+v"(e[2]), "+v"(e[3]), "+v"(e[4]), "+v"(e[5]), "+v"(e[6]), "+v"(e[7]), "+v"(s));
                __builtin_amdgcn_sched_barrier(0);
            }
        }
    }
    float t = s;
#pragma unroll
    for (int d = 0; d < 4; ++d)
#pragma unroll
        for (int r = 0; r < 16; ++r) t += acc[d][r];
    if (t == 12345.678f) ctl[CTL_POISON + 8] = 1;
}
#define KP() ({ CParams* kp_ = (CParams*)__builtin_amdgcn_kernarg_segment_ptr(); asm volatile("" : "+s"(kp_)); kp_; })

__global__ void __launch_bounds__(NTHREADS, 2) k_fwd(Params unused_by_name) {
#if defined(__HIP_DEVICE_COMPILE__)
    extern __shared__ __attribute__((aligned(16))) unsigned char lds_raw[];
    LAS unsigned char* lds = (LAS unsigned char*)lds_raw;
    const int tid = threadIdx.x;
    volatile LAS unsigned* bst = (volatile LAS unsigned*)(lds + BAR_LDS_OFF);
    if (tid == 0) { bst[0] = 0u; bst[1] = 0u; }
    __syncthreads();
    (void)xcd_barrier_post((unsigned*)(KP()->w.ctl + CTL_BAR), bst);
#define GRID_BAR() do { XcdBarrier b_; b_.bar = (unsigned*)(KP()->w.ctl + CTL_BAR); b_.x = xb_xcc_id(); b_.st = bst; xcd_barrier(b_); } while (0)
    if constexpr (((PROBE_MASK) & 2048) != 0) { mv_probe<((PROBE_MASK) >> 12) & 3>(KP()->w.ctl, tid & 63); }
    PROBE_REP(256) { CParams* kp = KP(); const Inputs in = kp->in; const WS w = kp->w; prologue_phase(in, w, kp->X, lds); }
    GRID_BAR();
#pragma unroll 1
    for (int layer = 0; layer < DEPTH; ++layer) {
        const int j = layer >> 1;
        if ((layer & 1) == 0) {
            {
                CParams* kp = KP();
                pg8::Gemm g{kp->w.Xb, kp->w.Wqkv_t + (size_t)j * 3072 * D, T, 2048, D}; pg8::StaticOrder S; S.init(T, 2048, gridDim.x, blockIdx.x);
                pg8::EpiQK8 E{(unsigned char*)kp->w.Qb, kp->w.rot};
                pg8::gemm_phase<pg8::EpiQK8, pg8::StaticOrder, true, true>(lds, g, S, E);
            }
            {
                CParams* kp = KP();
                pg8::Gemm g{kp->w.Wqkv_t + (size_t)j * 3072 * D + (size_t)2048 * D, kp->w.Xb, D, T, D}; pg8::StaticOrder S; S.init(D, T, gridDim.x, blockIdx.x);
                pg8::EpiVT E{(unsigned char*)kp->w.Vb};
                pg8::gemm_phase<pg8::EpiVT, pg8::StaticOrder, true, true>(lds, g, S, E);
            }
            GRID_BAR();
#ifdef ATT_PROBE_VAR
            {
                CParams* kp = KP();
                attn::attn_phase<ATT_PROBE_VAR>((const unsigned char*)kp->w.Qb, (const unsigned char*)kp->w.Qb + (size_t)T * 1024, (const unsigned char*)kp->w.Vb, (bf16*)kp->w.V32, kp->w.lbtab[2048 + j], kp->in.p[4] + (size_t)j * 128, 1.f, lds);
            }
            GRID_BAR();
#endif
            PROBE_REP(1) {
                CParams* kp = KP();
                attn::attn_phase((const unsigned char*)kp->w.Qb, (const unsigned char*)kp->w.Qb + (size_t)T * 1024, (const unsigned char*)kp->w.Vb, kp->w.Ob, kp->w.lbtab[2048 + j], kp->in.p[4] + (size_t)j * 128, 1.f - (0.8f - 0.6f * __expf(-0.3f * (float)layer)), lds);
            }
            GRID_BAR();
        } else {
            PROBE_REP(8) {
                CParams* kp = KP();
                pg8::Gemm g{kp->w.Xb, kp->w.Hin_t + (size_t)j * 4096 * D, T, 4096, D}; pg8::StaticOrder S; S.init(T, 4096, gridDim.x, blockIdx.x);
                pg8::EpiHin E{kp->w.Qb, (bf16*)kp->w.LG, kp->w.lbtab + j * 1024};
                pg8::gemm_phase<pg8::EpiHin, pg8::StaticOrder, true, true>(lds, g, S, E);
            }
            GRID_BAR();
            PROBE_REP(16) { CParams* kp = KP(); hgrn::passA(kp->w.Kb, (const bf16*)kp->w.LG, kp->w.Vb, kp->w.Uf, kp->w.Dbuf, lds); }
            GRID_BAR();
            PROBE_REP(16) { CParams* kp = KP(); hgrn::passB(kp->w.Uf, kp->w.Dbuf, kp->w.Sf); }
            GRID_BAR();
            if constexpr (((PROBE_MASK) & 4096) != 0) { CParams* kp = KP(); hgrn::passC<HGC_PROBE_PARTS>(kp->w.Qb, kp->w.Kb, (const bf16*)kp->w.LG, kp->w.Vb, kp->w.Gb, kp->w.Sf, kp->in.p[8] + (size_t)j * 128, (bf16*)kp->w.V32, lds); GRID_BAR(); }
            PROBE_REP(16) { CParams* kp = KP(); hgrn::passC(kp->w.Qb, kp->w.Kb, (const bf16*)kp->w.LG, kp->w.Vb, kp->w.Gb, kp->w.Sf, kp->in.p[8] + (size_t)j * 128, kp->w.Ob, lds); }
            GRID_BAR();
        }
        PROBE_REP(4) {
            CParams* kp = KP();
            const bf16* Wt = ((layer & 1) == 0) ? kp->w.Wo_t + (size_t)j * D * D : kp->w.Hout_t + (size_t)j * D * D;
            pg8::Gemm g{kp->w.Ob, Wt, T, D, D}; pg8::StaticOrder S; S.init(T, D, gridDim.x, blockIdx.x);
            pg8::EpiRes E{kp->w.Xb, (bf16*)kp->w.V32};
            pg8::gemm_phase<pg8::EpiRes, pg8::StaticOrder, true, true>(lds, g, S, E);
        }
        GRID_BAR();
        if constexpr (((PROBE_MASK) & 32) != 0) {
            CParams* kp = KP();
            lnroute_phase(kp->w.V32, kp->X, kp->w.Xb, kp->in.p[15] + (size_t)(layer * 2) * D, kp->in.p[16] + (size_t)(layer * 2) * D, (const bf16*)kp->w.Wr_t + (size_t)layer * 2 * NE * D,
                          kp->in.p[10] + (size_t)layer * NE, kp->w.ctl + CNT_BASE + (4 + layer) * 64 * CNT_STRIDE, (int*)kp->w.H1, (float*)((char*)kp->w.H1 + (16u << 20)), (int*)((char*)kp->w.H1 + (32u << 20)), lds);
            GRID_BAR();
        }
        {
            CParams* kp = KP();
            lnroute_phase(kp->w.V32, kp->X, kp->w.Xb, kp->in.p[15] + (size_t)(layer * 2) * D, kp->in.p[16] + (size_t)(layer * 2) * D, (const bf16*)kp->w.Wr_t + (size_t)layer * 2 * NE * D,
                          kp->in.p[10] + (size_t)layer * NE, kp->w.ctl + CNT_BASE + layer * 64 * CNT_STRIDE, kp->w.rowlist, kp->w.tok_w, kp->w.tok_es, lds);
        }
        GRID_BAR();
        const pg8::MoeTabs tb = moe_tables(KP()->w.ctl + CNT_BASE + layer * 64 * CNT_STRIDE, lds, tid);
        PROBE_REP(64) {
            CParams* kp = KP();
            pg8::Gemm g{kp->w.Xb, kp->w.Wgu_t + (size_t)layer * 65 * 512 * D, 0, 0, D};
            pg8::MoeOrder<2> S{tb, (int)gridDim.x, (int)blockIdx.x, kp->w.rowlist};
            pg8::EpiSwiglu E{kp->w.H1};
            pg8::gemm_phase_g<pg8::EpiSwiglu, pg8::MoeOrder<2>, true, true>(lds, g, S, E);
        }
        GRID_BAR();
        PROBE_REP(128) {
            CParams* kp = KP();
            int kdim = 256; asm volatile("" : "+s"(kdim));
            pg8::Gemm g{kp->w.H1, kp->w.Wd_t + (size_t)layer * 65 * D * 256, 0, 0, kdim};
            pg8::MoeOrder<4> S{tb, (int)gridDim.x, (int)blockIdx.x, kp->w.rowlist};
            pg8::EpiDown E{(unsigned char*)kp->w.Y};
            pg8::gemm_phase<pg8::EpiDown, pg8::MoeOrder<4>, true, true>(lds, g, S, E);
        }
        GRID_BAR();
        if ((PROBE_MASK) & 1024) { CParams* kp = KP(); combine_phase((const unsigned char*)kp->w.Y, kp->w.tok_es, kp->w.tok_w, tb, kp->w.Xb, kp->w.V32, kp->w.Qb, kp->in.p[15], kp->in.p[16], kp->w.ctl + CTL_POISON); GRID_BAR(); }
        { CParams* kp = KP(); combine_phase((const unsigned char*)kp->w.Y, kp->w.tok_es, kp->w.tok_w, tb, kp->w.Xb, (layer + 1 < DEPTH) ? (float*)nullptr : kp->X, kp->w.Xb, kp->in.p[15] + (size_t)(layer * 2 + 1) * D, kp->in.p[16] + (size_t)(layer * 2 + 1) * D, kp->w.ctl + CTL_POISON); }
        if (layer + 1 < DEPTH) GRID_BAR();
    }
#endif
}
}

extern "C" void kernel_launch(void* const* d_in, const int* in_sizes, int n_in, void* d_out, int out_size, void* d_ws, size_t ws_size, hipStream_t stream) {
    Inputs in{}; for (int i = 0; i < 17; ++i) in.p[i] = (const float*)d_in[i];
    float* X = (float*)d_out;
    char* ws = (char*)d_ws; size_t o = 0;
    auto carve = [&](size_t bytes) { char* p = ws + o; o += (bytes + 255) & ~(size_t)255; return p; };
    WS w{};
    w.ctl = (int*)carve(1 << 20);
    w.Wqkv_t = (bf16*)carve((size_t)2 * 3072 * D * 2); w.Wo_t = (bf16*)carve((size_t)2 * D * D * 2);
    w.Hin_t = (bf16*)carve((size_t)2 * 4096 * D * 2); w.Hout_t = (bf16*)carve((size_t)2 * D * D * 2);
    w.rot = (float*)carve((size_t)SEQ * 16 * 4); w.lbtab = (float*)carve(4 * 1024 * 4);
    w.V32 = (float*)carve((size_t)T * D * 4);
    w.Xb = (bf16*)carve((size_t)T * D * 2); w.Qb = (bf16*)carve((size_t)T * D * 2); w.Kb = (bf16*)carve((size_t)T * D * 2);
    w.Vb = (bf16*)carve((size_t)T * D * 2); w.Gb = (bf16*)carve((size_t)T * D * 2); w.Ob = (bf16*)carve((size_t)T * D * 2);
    w.LG = (float*)carve((size_t)T * D * 4); w.Dbuf = (float*)carve((size_t)4096 * 128 * 4);
    w.Wgu_t = (bf16*)carve((size_t)DEPTH * 65 * 512 * D * 2); w.Wd_t = (bf16*)carve((size_t)DEPTH * 65 * D * 256 * 2);
    w.Wr_t = (float*)carve((size_t)DEPTH * NE * D * 4);
    w.H1 = (bf16*)carve((size_t)NROWS * 256 * 2); w.Y = (bf16*)carve((size_t)NROWS * 1024 * 2);
    w.Uf = w.Y; w.Sf = w.Y + (size_t)4096 * 16384;
    w.rowlist = (int*)carve((size_t)(NE + 1) * T * 4); w.tok_w = (float*)carve((size_t)T * 8 * 4); w.tok_es = (int*)carve((size_t)T * 8 * 4);
    if (o > ws_size || n_in != 17) { fprintf(stderr, "kernel_launch: workspace too small (need %zu, have %zu) or n_in %d != 17; nothing launched\n", o, ws_size, n_in); return; }
    static int grid = 0;
    if (grid == 0) {
        int dev = 0, cus = 0;
        if (hipGetDevice(&dev) != hipSuccess || hipDeviceGetAttribute(&cus, hipDeviceAttributeMultiprocessorCount, dev) != hipSuccess) { grid = -1; return; }
        if (hipFuncSetAttribute((const void*)k_fwd, hipFuncAttributeMaxDynamicSharedMemorySize, LDS_BYTES) != hipSuccess) { fprintf(stderr, "kernel_launch: hipFuncSetAttribute failed\n"); grid = -1; return; }
        int per_cu = 0;
        if (hipOccupancyMaxActiveBlocksPerMultiprocessor(&per_cu, (const void*)k_fwd, NTHREADS, LDS_BYTES) != hipSuccess || per_cu < 1) { fprintf(stderr, "kernel_launch: occupancy query says %d blocks per CU\n", per_cu); }
        (void)hipGetLastError();
        grid = cus < 256 ? cus : 256;
    }
    if (grid < 0) return;
    (void)hipMemsetAsync(w.ctl, 0, 1 << 20, stream);
    Params prm{}; prm.in = in; prm.w = w; prm.X = X;
    hipLaunchKernelGGL(k_fwd, dim3(grid), dim3(NTHREADS), LDS_BYTES, stream, prm);
}
```
